# Optimizing an MI355X kernel written in HIP

```python
import math
import jax, jax.numpy as jnp
from jax import lax
import numpy as np

D_MODEL = 2048
BATCH = 1
SEQ = 16384
DEPTH = 2

CHUNK = 64
QBLK = 128
D_MIX = D_MODEL

A_HEADS = 6
A_DHALF = 64
A_DV = 2 * A_DHALF
A_WIDTH = A_HEADS * A_DV

B_WIDTH = 512
CONV_W = 3

C_HEADS = 6
C_NOPE = 64
C_ROPE = 32
C_DV = 128
C_WIDTH = C_HEADS * C_DV
C_Q_RANK = 512
C_KV_RANK = 256
ROPE_THETA = 10000.0

D_FF = 5632

ALPHA = (2.0 * DEPTH) ** 0.25
BETA = (8.0 * DEPTH) ** -0.25

LN_EPS = 1e-5
RMS_EPS = 1e-6
NEG = -1e30

A_Q_COLS = A_HEADS * 2 * A_DHALF
A_K_COLS = A_HEADS * 2 * A_DHALF
A_V_COLS = A_HEADS * A_DV
IN_SIZES = (A_Q_COLS, A_K_COLS, A_V_COLS, B_WIDTH, B_WIDTH, B_WIDTH, C_Q_RANK, C_KV_RANK, C_ROPE)
IN_SPLITS = (768, 1536, 2304, 2816, 3328, 3840, 4352, 4608)
P_IN = 4640

kernel_name = "hymba_style_diffattn_shortconv_mla_convffn_deepnorm"


def layer_norm(x, g, b):
    xf = x.astype(jnp.float32)
    mu = xf.mean(-1, keepdims=True)
    var = jnp.square(xf - mu).mean(-1, keepdims=True)
    return ((xf - mu) * lax.rsqrt(var + LN_EPS) * g.astype(jnp.float32) + b.astype(jnp.float32)).astype(x.dtype)


def rms_norm(x, g):
    xf = x.astype(jnp.float32)
    r = lax.rsqrt(jnp.mean(jnp.square(xf), -1, keepdims=True) + RMS_EPS)
    return (xf * r * g.astype(jnp.float32)).astype(x.dtype)


def causal_dwconv3(x, w):
    s = x.shape[1]
    xp = jnp.pad(x, ((0, 0), (CONV_W - 1, 0), (0, 0)))
    return sum(w[i] * xp[:, i:i + s] for i in range(CONV_W))


def rope(x, pos):
    d = x.shape[-1]
    inv_freq = ROPE_THETA ** (-jnp.arange(0, d, 2, dtype=jnp.float32) / d)
    ang = pos.astype(jnp.float32)[..., None] * inv_freq
    cos = jnp.cos(ang)[:, :, None, :]
    sin = jnp.sin(ang)[:, :, None, :]
    xf = x.astype(jnp.float32)
    x1, x2 = xf[..., : d // 2], xf[..., d // 2:]
    return jnp.concatenate([x1 * cos - x2 * sin, x1 * sin + x2 * cos], -1).astype(x.dtype)


def chunk_mask(q_idx, s):
    return (q_idx[:, None] // CHUNK) >= (jnp.arange(s)[None, :] // CHUNK)


def to_qblocks(a):
    b, h, s = a.shape[:3]
    return jnp.moveaxis(a.reshape((b, h, s // QBLK, QBLK) + a.shape[3:]), 2, 0)


def from_qblocks(a):
    nq, b, h, q, d = a.shape
    return jnp.moveaxis(a, 0, 2).reshape(b, h, nq * q, d)


def diff_attention(q, k, v, lam, pos, slopes):
    b, h, s = q.shape[:3]
    nq = s // QBLK
    scale = A_DHALF ** -0.5
    k1, k2 = k[..., 0, :], k[..., 1, :]
    pos_k = pos[:, None, None, :]
    qb = to_qblocks(q)
    pos_q = jnp.moveaxis(pos.reshape(b, nq, QBLK), 1, 0)
    idx_q = jnp.arange(s).reshape(nq, QBLK)

    def one(blk):
        qblk, pq, iq = blk
        dist = jnp.abs(pq[:, None, :, None] - pos_k).astype(jnp.float32)
        bias = -slopes[None, :, None, None] * dist
        mask = chunk_mask(iq, s)

        def probs(qh, kh):
            sc = jnp.einsum('bhqd,bhkd->bhqk', qh, kh).astype(jnp.float32) * scale + bias
            return jax.nn.softmax(jnp.where(mask, sc, NEG), axis=-1)

        p = probs(qblk[..., 0, :], k1) - lam * probs(qblk[..., 1, :], k2)
        return jnp.einsum('bhqk,bhkd->bhqd', p.astype(v.dtype), v)

    return from_qblocks(lax.map(one, (qb, pos_q, idx_q)))


def mla_attention(q, k, v):
    b, h, s = q.shape[:3]
    nq = s // QBLK
    scale = (C_NOPE + C_ROPE) ** -0.5
    qb = to_qblocks(q)
    idx_q = jnp.arange(s).reshape(nq, QBLK)

    def one(blk):
        qblk, iq = blk
        sc = jnp.einsum('bhqd,bhkd->bhqk', qblk, k).astype(jnp.float32) * scale
        p = jax.nn.softmax(jnp.where(chunk_mask(iq, s), sc, NEG), axis=-1)
        return jnp.einsum('bhqk,bhkd->bhqd', p.astype(v.dtype), v)

    return from_qblocks(lax.map(one, (qb, idx_q)))


def mixer(h, pos, lam_init, w_in, diff_lambda, diff_norm_g, conv_w,
          mla_q_norm_g, mla_kv_norm_g, w_uq, w_ukv, w_o):
    b, s, _ = h.shape
    proj = h @ w_in
    a_q, a_k, a_v, b_h, b_b, b_c, c_q, c_kv, c_kr = jnp.split(proj, IN_SPLITS, axis=-1)

    q = a_q.reshape(b, s, A_HEADS, 2, A_DHALF).transpose(0, 2, 1, 3, 4)
    k = a_k.reshape(b, s, A_HEADS, 2, A_DHALF).transpose(0, 2, 1, 3, 4)
    v = a_v.reshape(b, s, A_HEADS, A_DV).transpose(0, 2, 1, 3)
    lf = diff_lambda.astype(jnp.float32)
    lam = jnp.exp(jnp.sum(lf[0] * lf[1])) - jnp.exp(jnp.sum(lf[2] * lf[3])) + lam_init
    slopes = 2.0 ** (-8.0 * (jnp.arange(A_HEADS, dtype=jnp.float32) + 1.0) / A_HEADS)
    o_a = diff_attention(q, k, v, lam, pos, slopes)
    o_a = rms_norm(o_a, diff_norm_g) * (1.0 - lam_init)
    o_a = o_a.transpose(0, 2, 1, 3).reshape(b, s, A_WIDTH)

    o_b = b_b * causal_dwconv3(b_c * b_h, conv_w)

    cq = rms_norm(c_q, mla_q_norm_g)
    qc = (cq @ w_uq).reshape(b, s, C_HEADS, C_NOPE + C_ROPE)
    q_nope, q_pe = qc[..., :C_NOPE], rope(qc[..., C_NOPE:], pos)
    ckv = rms_norm(c_kv, mla_kv_norm_g)
    kv = (ckv @ w_ukv).reshape(b, s, C_HEADS, C_NOPE + C_DV)
    k_nope, v_c = kv[..., :C_NOPE], kv[..., C_NOPE:]
    k_pe = jnp.broadcast_to(rope(c_kr[:, :, None, :], pos), (b, s, C_HEADS, C_ROPE))
    qm = jnp.concatenate([q_nope, q_pe], -1).transpose(0, 2, 1, 3)
    km = jnp.concatenate([k_nope, k_pe], -1).transpose(0, 2, 1, 3)
    o_c = mla_attention(qm, km, v_c.transpose(0, 2, 1, 3))
    o_c = o_c.transpose(0, 2, 1, 3).reshape(b, s, C_WIDTH)

    return jnp.concatenate([o_a, o_b, o_c], -1) @ w_o


def conv_ffn(h, w_gate, w_up, conv_w, w_down):
    g = causal_dwconv3(h @ w_gate, conv_w)
    return (jax.nn.silu(g) * (h @ w_up)) @ w_down


def setup_inputs(seed: int = 0) -> dict:
    key = jax.random.key(seed)
    ks = jax.random.split(key, 24)
    n = jax.random.normal
    f32 = jnp.float32
    L = DEPTH
    x = n(ks[0], (BATCH, SEQ, D_MODEL), f32)
    offset = jax.random.randint(ks[1], (BATCH, 1), 0, 64, dtype=jnp.int32) * CHUNK
    positions = (offset + jnp.arange(SEQ, dtype=jnp.int32)[None, :]).astype(jnp.int32)
    return {
        "x": x,
        "positions": positions,
        "ln_in_g": 1.0 + 0.02 * n(ks[2], (D_MODEL,), f32),
        "ln_in_b": 0.02 * n(ks[3], (D_MODEL,), f32),
        "w_in": n(ks[4], (L, D_MODEL, P_IN), f32) * D_MODEL ** -0.5,
        "diff_lambda": 0.1 * n(ks[5], (L, 4, A_DHALF), f32),
        "diff_norm_g": 1.0 + 0.02 * n(ks[6], (L, A_DV), f32),
        "conv_w": n(ks[7], (L, CONV_W, B_WIDTH), f32) * CONV_W ** -0.5,
        "mla_q_norm_g": 1.0 + 0.02 * n(ks[8], (L, C_Q_RANK), f32),
        "mla_kv_norm_g": 1.0 + 0.02 * n(ks[9], (L, C_KV_RANK), f32),
        "w_uq": n(ks[10], (L, C_Q_RANK, C_HEADS * (C_NOPE + C_ROPE)), f32) * C_Q_RANK ** -0.5,
        "w_ukv": n(ks[11], (L, C_KV_RANK, C_HEADS * (C_NOPE + C_DV)), f32) * C_KV_RANK ** -0.5,
        "w_o": n(ks[12], (L, D_MIX, D_MODEL), f32) * (D_MIX ** -0.5 * BETA),
        "ln1_g": 1.0 + 0.02 * n(ks[13], (L, D_MODEL), f32),
        "ln1_b": 0.02 * n(ks[14], (L, D_MODEL), f32),
        "ffn_w_gate": n(ks[15], (L, D_MODEL, D_FF), f32) * D_MODEL ** -0.5,
        "ffn_w_up": n(ks[16], (L, D_MODEL, D_FF), f32) * D_MODEL ** -0.5,
        "ffn_conv_w": n(ks[17], (L, CONV_W, D_FF), f32) * CONV_W ** -0.5,
        "ffn_w_down": n(ks[18], (L, D_FF, D_MODEL), f32) * (D_FF ** -0.5 * BETA),
        "ln2_g": 1.0 + 0.02 * n(ks[19], (L, D_MODEL), f32),
        "ln2_b": 0.02 * n(ks[20], (L, D_MODEL), f32),
    }


def reference(x, positions, ln_in_g, ln_in_b, w_in, diff_lambda, diff_norm_g, conv_w,
              mla_q_norm_g, mla_kv_norm_g, w_uq, w_ukv, w_o, ln1_g, ln1_b,
              ffn_w_gate, ffn_w_up, ffn_conv_w, ffn_w_down, ln2_g, ln2_b):
    h = layer_norm(x, ln_in_g, ln_in_b)
    for l in range(DEPTH):
        lam_init = 0.8 - 0.6 * math.exp(-0.3 * l)
        m = mixer(h, positions, lam_init, w_in[l], diff_lambda[l], diff_norm_g[l], conv_w[l],
                  mla_q_norm_g[l], mla_kv_norm_g[l], w_uq[l], w_ukv[l], w_o[l])
        h = layer_norm(ALPHA * h + m, ln1_g[l], ln1_b[l])
        f = conv_ffn(h, ffn_w_gate[l], ffn_w_up[l], ffn_conv_w[l], ffn_w_down[l])
        h = layer_norm(ALPHA * h + f, ln2_g[l], ln2_b[l])
    return h
```

```cpp
#include <hip/hip_runtime.h>
#include <hip/hip_cooperative_groups.h>
#include <cstdio>
#include <cstdint>
namespace cg = cooperative_groups;

constexpr int S = 16384, DM = 2048, NLAYER = 2, PIN = 4640, PINP = 4864, DFF = 5632;
constexpr int CQR = 512, CKVR = 256, NUQ = 576, NUQP = 768, NUKV = 1152, NUKVP = 1280;
constexpr float LN_EPS = 1e-5f, RMS_EPS = 1e-6f;
constexpr float ALPHA_DN = 1.4142135623730951f;
constexpr float LOG2E = 1.4426950408889634f;
constexpr float QSCALE_A = 0.125f * LOG2E;
constexpr float QSCALE_C = 0.10206207261596577f * LOG2E;
__device__ __forceinline__ int lane_id_v() { int l; asm volatile("v_mbcnt_lo_u32_b32 %0, -1, 0\n\tv_mbcnt_hi_u32_b32 %0, -1, %0" : "=v"(l)); return l; }
namespace pg8 {
#define PG8_LAS __attribute__((address_space(3)))
typedef unsigned short bf16_t;
typedef short bf16x8 __attribute__((ext_vector_type(8)));
typedef float f32x4 __attribute__((ext_vector_type(4)));
typedef unsigned u32x4 __attribute__((ext_vector_type(4)));
constexpr int BM = 256, BK = 64, HALF = 128, HTB = HALF * BK * 2  , STAGE_BYTES = 8 * HTB, NXCD = 8, WGM = 8;

__host__ __device__ __forceinline__ int lds_byte(int r, int c) { const int st = (r >> 4) * 2 + (c >> 5), rr = r & 15, cc = c & 31, ob = rr * 64 + cc * 2; return st * 1024 + (ob ^ (((ob >> 9) & 1) << 5)); }
__host__ __device__ __forceinline__ void stage_rc(int b, int& R, int& C) { const int st = b / 1024, sb = b % 1024, swz = sb ^ (((sb >> 9) & 1) << 5); R = (st >> 1) * 16 + swz / 64; C = (st & 1) * 32 + (swz % 64) / 2; }
__host__ __device__ __forceinline__ int perm32(int rho) { const int n = rho >> 4, i = rho & 15; return 8 * (i >> 2) + 4 * n + (i & 3); }

struct Unit { int pm, pn; };
struct Gemm { const bf16_t* A; const bf16_t* Bt; int M, N, K; };

struct StaticOrder {
    int nM, nN, nwg, G, c;
    __host__ __device__ void init(int M, int N, int G_, int c_) { nM = M / BM; nN = N / BM; nwg = nM * nN; G = G_; c = c_; }
    __host__ __device__ bool next(int i, Unit& u) const {
        const long L = (long)i * G + c; if (L >= nwg) return false;
        int wgid = (int)L; { const int q = nwg / NXCD, r = nwg % NXCD, xcd = wgid % NXCD, off = wgid / NXCD; wgid = (xcd < r ? xcd * (q + 1) : r * (q + 1) + (xcd - r) * q) + off; }
        const int nig = WGM * nN, gid = wgid / nig, fm = gid * WGM, gsz = (nM - fm) < WGM ? (nM - fm) : WGM;
        u.pm = fm + ((wgid % nig) % gsz); u.pn = (wgid % nig) / gsz; return true;
    }
    __device__ __forceinline__ void a_ready(const Unit&) const {}
    __device__ __forceinline__ void done(const Unit&) const {}
};

__device__ __forceinline__ unsigned cvt_pk_bf16(float lo, float hi) { unsigned r; asm volatile("v_cvt_pk_bf16_f32 %0, %1, %2" : "=v"(r) : "v"(lo), "v"(hi)); return r; }
typedef float f32x2 __attribute__((ext_vector_type(2)));
template <class Epi, class Sched, bool ALIGN_EPI = false, bool SP2 = false>
__device__ __forceinline__ void gemm_phase(PG8_LAS unsigned char* lds, const Gemm g, const Sched& S, const Epi& E) {
    int tid_ = threadIdx.x; asm volatile("" : "+v"(tid_));
    const int tid = tid_, wid = __builtin_amdgcn_readfirstlane(tid >> 6), lane = tid & 63, wr = wid >> 2, wc = wid & 3, fr = lane & 15, fq = lane >> 4;
    const int K = g.K, nt = K / BK;
    unsigned voffA[2], voffB[2];
#pragma unroll
    for (int i = 0; i < 2; ++i) { int R, C; stage_rc(tid * 16 + i * 8192, R, C); const int Rb = Epi::PERM ? ((R & ~31) + perm32(R & 31)) : R;
        voffA[i] = (unsigned)(R * K + C) * 2u; voffB[i] = (unsigned)(Rb * K + C) * 2u; }
    const size_t kstep = (size_t)(BK * 2);
    const size_t hstep = (size_t)HALF * K * 2;
    const size_t tstep = 2 * hstep;
    const unsigned ldsw = (unsigned)wid * 1024u;
    const int aoff = lds_byte(wr * 64 + fr, fq * 8), boff = lds_byte(wc * 32 + fr, fq * 8);
#define PG8_SA(b, h) (((b) * 2 + (h)) * HTB)
#define PG8_SB(b, h) ((4 + (b) * 2 + (h)) * HTB)
#define PG8_STAGE(bufoff, gbase, voff) do { _Pragma("unroll") for (int _i = 0; _i < 2; ++_i) \
        __builtin_amdgcn_global_load_lds((const unsigned*)((const char*)(gbase) + (voff)[_i]), (PG8_LAS unsigned*)(lds + (bufoff) + ldsw + _i * 8192), 16, 0, 0); } while (0)
#define PG8_LDA(dst, b, h) do { _Pragma("unroll") for (int m = 0; m < 4; ++m) _Pragma("unroll") for (int k = 0; k < 2; ++k) dst[m][k] = *(const PG8_LAS bf16x8*)(lds + PG8_SA(b, h) + aoff + m * 2048 + k * 1024); } while (0)
#define PG8_LDB(dst, b, h) do { _Pragma("unroll") for (int n = 0; n < 2; ++n) _Pragma("unroll") for (int k = 0; k < 2; ++k) dst[n][k] = *(const PG8_LAS bf16x8*)(lds + PG8_SB(b, h) + boff + n * 2048 + k * 1024); } while (0)
#define PG8_MMA(ai, bj, At, Bt) do { __builtin_amdgcn_s_setprio(1); _Pragma("unroll") for (int m = 0; m < 4; ++m) _Pragma("unroll") for (int n = 0; n < 2; ++n) _Pragma("unroll") for (int k = 0; k < 2; ++k) \
        acc[ai][bj][m][n] = __builtin_amdgcn_mfma_f32_16x16x32_bf16(Bt[n][k], At[m][k], acc[ai][bj][m][n], 0, 0, 0); __builtin_amdgcn_s_setprio(0); } while (0)
#define PG8_WAIT_V(n) asm volatile("s_waitcnt vmcnt(" #n ")" ::: "memory")
#define PG8_WAIT_L(n) asm volatile("s_waitcnt lgkmcnt(" #n ")" ::: "memory")
#define PG8_BAR __builtin_amdgcn_s_barrier()
#define PG8_SCHED __builtin_amdgcn_sched_barrier(0)
    Unit cur, nxt; int ui = 0;
    if (!S.next(0, cur)) return;
    f32x4 acc[2][2][4][2];
#pragma unroll
    for (int a = 0; a < 2; ++a)
#pragma unroll
        for (int b = 0; b < 2; ++b)
#pragma unroll
            for (int m = 0; m < 4; ++m)
#pragma unroll
                for (int n = 0; n < 2; ++n) acc[a][b][m][n] = (f32x4){0.f, 0.f, 0.f, 0.f};
    bf16x8 At[4][2], B0[2][2], B1[2][2];
    const char* cA = (const char*)g.A + (size_t)cur.pm * tstep; const char* cB = (const char*)g.Bt + (size_t)cur.pn * tstep;
    S.a_ready(cur);
    if constexpr (SP2) {
        PG8_STAGE(PG8_SB(0, 0), cB, voffB); PG8_STAGE(PG8_SB(0, 1), cB + hstep, voffB); PG8_STAGE(PG8_SA(0, 0), cA, voffA); PG8_STAGE(PG8_SA(0, 1), cA + hstep, voffA);
        if (wr == 1) PG8_BAR;
        PG8_WAIT_V(2); PG8_BAR;
        PG8_STAGE(PG8_SB(1, 0), cB + kstep, voffB); PG8_STAGE(PG8_SA(1, 0), cA + kstep, voffA); PG8_STAGE(PG8_SB(1, 1), cB + hstep + kstep, voffB);
        PG8_WAIT_V(6); PG8_BAR;
    } else {
        PG8_STAGE(PG8_SB(0, 0), cB, voffB); PG8_STAGE(PG8_SA(0, 0), cA, voffA); PG8_STAGE(PG8_SB(0, 1), cB + hstep, voffB); PG8_STAGE(PG8_SA(0, 1), cA + hstep, voffA);
        if (wr == 1) PG8_BAR;
        PG8_WAIT_V(4); PG8_BAR;
        PG8_STAGE(PG8_SB(1, 0), cB + kstep, voffB); PG8_STAGE(PG8_SA(1, 0), cA + kstep, voffA); PG8_STAGE(PG8_SB(1, 1), cB + hstep + kstep, voffB);
        PG8_WAIT_V(6); PG8_BAR;
    }
    for (;;) {
        const bool has_next = S.next(ui + 1, nxt);
        const char* nA = has_next ? (const char*)g.A + (size_t)nxt.pm * tstep : cA; const char* nB = has_next ? (const char*)g.Bt + (size_t)nxt.pn * tstep : cB;
        for (int t = 0; t < nt; t += 2) {
            const bool last = (t == nt - 2);
            const char* a1 = cA + (size_t)(t + 1) * kstep;
            const char* a2 = last ? nA : cA + (size_t)(t + 2) * kstep; const char* b2 = last ? nB : cB + (size_t)(t + 2) * kstep;
            const char* a3 = a2 + kstep; const char* b3 = b2 + kstep;
            if (last && has_next) S.a_ready(nxt);
            if constexpr (SP2) {
            PG8_LDB(B0, 0, 0); PG8_LDB(B1, 0, 1); PG8_SCHED; PG8_LDA(At, 0, 0); PG8_STAGE(PG8_SA(1, 1), a1 + hstep, voffA);
            PG8_WAIT_V(8); PG8_WAIT_L(0); PG8_BAR; PG8_MMA(0, 0, At, B0); PG8_MMA(0, 1, At, B1); PG8_BAR; PG8_SCHED;
            PG8_LDA(At, 0, 1); PG8_STAGE(PG8_SB(0, 0), b2, voffB); PG8_STAGE(PG8_SB(0, 1), b2 + hstep, voffB); PG8_STAGE(PG8_SA(0, 0), a2, voffA);
            PG8_WAIT_V(8); PG8_WAIT_L(0); PG8_BAR; PG8_MMA(1, 0, At, B0); PG8_MMA(1, 1, At, B1); PG8_BAR; PG8_SCHED;
            PG8_LDB(B0, 1, 0); PG8_LDB(B1, 1, 1); PG8_SCHED; PG8_LDA(At, 1, 0); PG8_STAGE(PG8_SA(0, 1), a2 + hstep, voffA);
            PG8_WAIT_V(8); PG8_WAIT_L(0); PG8_BAR; PG8_MMA(0, 0, At, B0); PG8_MMA(0, 1, At, B1); PG8_BAR; PG8_SCHED;
            PG8_LDA(At, 1, 1); PG8_STAGE(PG8_SB(1, 0), b3, voffB); PG8_STAGE(PG8_SB(1, 1), b3 + hstep, voffB); PG8_STAGE(PG8_SA(1, 0), a3, voffA);
            PG8_WAIT_V(8); PG8_WAIT_L(0); PG8_BAR; PG8_MMA(1, 0, At, B0); PG8_MMA(1, 1, At, B1); PG8_BAR; PG8_SCHED;
            } else {
            PG8_LDB(B0, 0, 0); PG8_SCHED; PG8_LDA(At, 0, 0); PG8_STAGE(PG8_SA(1, 1), a1 + hstep, voffA);
            PG8_WAIT_L(8); PG8_BAR; PG8_WAIT_L(0); PG8_MMA(0, 0, At, B0); PG8_BAR; PG8_SCHED;
            PG8_LDB(B1, 0, 1); PG8_STAGE(PG8_SB(0, 0), b2, voffB);
            PG8_BAR; PG8_WAIT_L(0); PG8_MMA(0, 1, At, B1); PG8_BAR;
            PG8_LDA(At, 0, 1); PG8_STAGE(PG8_SA(0, 0), a2, voffA);
            PG8_BAR; PG8_WAIT_L(0); PG8_MMA(1, 0, At, B0); PG8_BAR; PG8_SCHED;
            PG8_STAGE(PG8_SB(0, 1), b2 + hstep, voffB);
            PG8_WAIT_V(6); PG8_BAR; PG8_MMA(1, 1, At, B1); PG8_BAR;
            PG8_LDB(B0, 1, 0); PG8_SCHED; PG8_LDA(At, 1, 0); PG8_STAGE(PG8_SA(0, 1), a2 + hstep, voffA);
            PG8_WAIT_L(8); PG8_BAR; PG8_WAIT_L(0); PG8_MMA(0, 0, At, B0); PG8_BAR; PG8_SCHED;
            PG8_LDB(B1, 1, 1); PG8_STAGE(PG8_SB(1, 0), b3, voffB);
            PG8_BAR; PG8_WAIT_L(0); PG8_MMA(0, 1, At, B1); PG8_BAR;
            PG8_LDA(At, 1, 1); PG8_STAGE(PG8_SA(1, 0), a3, voffA);
            PG8_BAR; PG8_WAIT_L(0); PG8_MMA(1, 0, At, B0); PG8_BAR; PG8_SCHED;
            PG8_STAGE(PG8_SB(1, 1), b3 + hstep, voffB);
            PG8_WAIT_V(6); PG8_BAR; PG8_MMA(1, 1, At, B1); PG8_BAR;
            }
        }
        if constexpr (ALIGN_EPI) { if (wr == 0) PG8_BAR; }
        if constexpr (!Epi::AFTER_DRAIN) { E(acc, cur, wr, wc, fr, fq); S.done(cur); }
        if (!has_next) break;
#pragma unroll
        for (int a = 0; a < 2; ++a)
#pragma unroll
            for (int b = 0; b < 2; ++b)
#pragma unroll
                for (int m = 0; m < 4; ++m)
#pragma unroll
                    for (int n = 0; n < 2; ++n) acc[a][b][m][n] = (f32x4){0.f, 0.f, 0.f, 0.f};
        cur = nxt; cA = nA; cB = nB; ++ui;
        if constexpr (ALIGN_EPI) { if (wr == 1) PG8_BAR; }
    }
    PG8_WAIT_V(0);
    if constexpr (!ALIGN_EPI) { if (wr == 0) PG8_BAR; }
    PG8_BAR;
    if constexpr (Epi::AFTER_DRAIN) { E.fused(acc, cur, wr, wc, fr, fq, lds, wid, lane); S.done(cur); }
#undef PG8_SA
#undef PG8_SB
#undef PG8_STAGE
#undef PG8_LDA
#undef PG8_LDB
#undef PG8_MMA
#undef PG8_WAIT_V
#undef PG8_WAIT_L
#undef PG8_BAR
#undef PG8_SCHED
}
}

namespace pg8 {
__device__ __forceinline__ u32x4 pack8(const f32x4 a, const f32x4 b, float sc) {
    u32x4 w; w.x = cvt_pk_bf16(a[0] * sc, a[1] * sc); w.y = cvt_pk_bf16(a[2] * sc, a[3] * sc); w.z = cvt_pk_bf16(b[0] * sc, b[1] * sc); w.w = cvt_pk_bf16(b[2] * sc, b[3] * sc); return w;
}
struct EpiProj {
    static constexpr bool PERM = true, AFTER_DRAIN = false;
    bf16_t *Aq, *Ak, *Av, *Bh, *Bb, *Bc, *cq, *ckv, *ckr; float* ssq;
    __device__ __forceinline__ void operator()(const f32x4 (&acc)[2][2][4][2], const Unit& u, int wr, int wc, int fr_, int fq_) const {
        const int ln_ = lane_id_v(), fr = ln_ & 15, fq = ln_ >> 4; (void)fr_; (void)fq_;
        const int pn = u.pn; bf16_t* base; int ldc, colt, ssqi = -1, valid = 256; float sc = 1.f;
        if (pn < 3) { base = Aq; ldc = 768; colt = pn * 256; sc = QSCALE_A; }
        else if (pn < 6) { base = Ak; ldc = 768; colt = (pn - 3) * 256; }
        else if (pn < 9) { base = Av; ldc = 768; colt = (pn - 6) * 256; }
        else if (pn < 11) { base = Bh; ldc = 512; colt = (pn - 9) * 256; }
        else if (pn < 13) { base = Bb; ldc = 512; colt = (pn - 11) * 256; }
        else if (pn < 15) { base = Bc; ldc = 512; colt = (pn - 13) * 256; }
        else if (pn < 17) { base = cq; ldc = 512; colt = (pn - 15) * 256; ssqi = (pn - 15) * 4 + wc; }
        else if (pn < 18) { base = ckv; ldc = 256; colt = 0; ssqi = 8 + wc; }
        else { base = ckr; ldc = 32; colt = 0; valid = 32; }
        const int row0 = u.pm * BM + wr * 64 + fr, cl = wc * 32 + 8 * fq;
#pragma unroll
        for (int ai = 0; ai < 2; ++ai)
#pragma unroll
            for (int m = 0; m < 4; ++m) {
                const int row = row0 + ai * HALF + m * 16; bf16_t* rowp = base + (size_t)row * ldc + colt + cl;
                float q = 0.f;
#pragma unroll
                for (int bj = 0; bj < 2; ++bj) {
                    const f32x4 v0 = acc[ai][bj][m][0], v1 = acc[ai][bj][m][1];
                    q += (v0[0] * v0[0] + v0[1] * v0[1]) + (v0[2] * v0[2] + v0[3] * v0[3]) + (v1[0] * v1[0] + v1[1] * v1[1]) + (v1[2] * v1[2] + v1[3] * v1[3]);
                    if (cl + bj * HALF < valid) *(u32x4*)(rowp + bj * HALF) = pack8(v0, v1, sc);
                }
                if (ssqi >= 0) { q += __shfl_xor(q, 16); q += __shfl_xor(q, 32); if (fq == 0) ssq[(size_t)row * 12 + ssqi] = q; }
            }
    }
};
struct EpiQm {
    static constexpr bool PERM = true, AFTER_DRAIN = false;
    bf16_t* qm; const float* ssq; const float* cost; const float* sint;
    __device__ __forceinline__ void operator()(const f32x4 (&acc)[2][2][4][2], const Unit& u, int wr, int wc, int fr_, int fq_) const {
        const int ln_ = lane_id_v(), fr = ln_ & 15, fq = ln_ >> 4; (void)fr_; (void)fq_;
        const int row0 = u.pm * BM + wr * 64 + fr;
#pragma unroll
        for (int ai = 0; ai < 2; ++ai)
#pragma unroll
            for (int m = 0; m < 4; ++m) {
                const int row = row0 + ai * HALF + m * 16;
                const f32x4 s0 = *(const f32x4*)(ssq + (size_t)row * 12), s1 = *(const f32x4*)(ssq + (size_t)row * 12 + 4);
                const float rq = 1.0f / sqrtf((((s0[0] + s0[1]) + (s0[2] + s0[3])) + ((s1[0] + s1[1]) + (s1[2] + s1[3]))) * (1.0f / CQR) + RMS_EPS);
#pragma unroll
                for (int bj = 0; bj < 2; ++bj) {
                    const int g32 = u.pn * 8 + bj * 4 + wc;
                    if (g32 >= NUQ / 32) continue;
                    f32x4 v0 = acc[ai][bj][m][0] * rq, v1 = acc[ai][bj][m][1] * rq;
                    if (g32 % 3 == 2) {
                        f32x4 p0, p1;
#pragma unroll
                        for (int i = 0; i < 4; ++i) { p0[i] = __shfl_xor(v0[i], 32); p1[i] = __shfl_xor(v1[i], 32); }
                        const int j0 = (fq & 1) * 8;
                        const f32x4 c0 = *(const f32x4*)(cost + (size_t)row * 16 + j0), c1 = *(const f32x4*)(cost + (size_t)row * 16 + j0 + 4);
                        f32x4 n0 = *(const f32x4*)(sint + (size_t)row * 16 + j0), n1 = *(const f32x4*)(sint + (size_t)row * 16 + j0 + 4);
                        if (fq < 2) { n0 = -n0; n1 = -n1; }
                        v0 = v0 * c0 + p0 * n0; v1 = v1 * c1 + p1 * n1;
                    }
                    *(u32x4*)(qm + (size_t)row * NUQ + g32 * 32 + 8 * fq) = pack8(v0, v1, QSCALE_C);
                }
            }
    }
};
struct EpiKv {
    static constexpr bool PERM = true, AFTER_DRAIN = false;
    bf16_t* km; bf16_t* vc; const float* ssq;
    __device__ __forceinline__ void operator()(const f32x4 (&acc)[2][2][4][2], const Unit& u, int wr, int wc, int fr_, int fq_) const {
        const int ln_ = lane_id_v(), fr = ln_ & 15, fq = ln_ >> 4; (void)fr_; (void)fq_;
        const int row0 = u.pm * BM + wr * 64 + fr;
#pragma unroll
        for (int ai = 0; ai < 2; ++ai)
#pragma unroll
            for (int m = 0; m < 4; ++m) {
                const int row = row0 + ai * HALF + m * 16;
                const f32x4 s0 = *(const f32x4*)(ssq + (size_t)row * 12 + 8);
                const float rk = 1.0f / sqrtf(((s0[0] + s0[1]) + (s0[2] + s0[3])) * (1.0f / CKVR) + RMS_EPS);
#pragma unroll
                for (int bj = 0; bj < 2; ++bj) {
                    const int c8 = u.pn * 256 + bj * HALF + wc * 32 + 8 * fq;
                    if (c8 >= NUKV) continue;
                    bf16_t* dst = (c8 < 384) ? km + (size_t)row * NUQ + (c8 >> 6) * 96 + (c8 & 63) : vc + (size_t)row * 768 + (c8 - 384);
                    *(u32x4*)dst = pack8(acc[ai][bj][m][0], acc[ai][bj][m][1], rk);
                }
            }
    }
};
struct EpiResid {
    static constexpr bool PERM = false, AFTER_DRAIN = false;
    float* h;
    __device__ __forceinline__ void operator()(const f32x4 (&acc)[2][2][4][2], const Unit& u, int wr, int wc, int fr_, int fq_) const {
        const int ln_ = lane_id_v(), fr = ln_ & 15, fq = ln_ >> 4; (void)fr_; (void)fq_;
        const int row0 = u.pm * BM + wr * 64 + fr, col0 = u.pn * BM + wc * 32 + 4 * fq;
#pragma unroll
        for (int ai = 0; ai < 2; ++ai)
#pragma unroll
            for (int m = 0; m < 4; ++m) {
                float* rowp = h + (size_t)(row0 + ai * HALF + m * 16) * DM + col0;
                f32x4 t[2][2];
#pragma unroll
                for (int bj = 0; bj < 2; ++bj)
#pragma unroll
                    for (int n = 0; n < 2; ++n) t[bj][n] = *(const f32x4*)(rowp + bj * HALF + n * 16);
#pragma unroll
                for (int bj = 0; bj < 2; ++bj)
#pragma unroll
                    for (int n = 0; n < 2; ++n) *(f32x4*)(rowp + bj * HALF + n * 16) = t[bj][n] * ALPHA_DN + acc[ai][bj][m][n];
                asm volatile("" ::: "memory");
            }
    }
};
struct EpiGateUp {
    static constexpr bool PERM = true, AFTER_DRAIN = false;
    bf16_t* a; const float* cw; float* GS; float* US;
    __device__ __forceinline__ void operator()(const f32x4 (&acc)[2][2][4][2], const Unit& u, int wr, int wc, int fr_, int fq_) const {
        const int ln_ = lane_id_v(), fr = ln_ & 15, fq = ln_ >> 4; (void)fr_; (void)fq_;
        const int ch0 = u.pn * 128 + wc * 32 + 8 * fq, lane = fq * 16 + fr;
        const int src1 = (lane & 48) | ((fr - 1) & 15), src2 = (lane & 48) | ((fr - 2) & 15);
        f32x4 w0[2], w1[2], w2[2];
#pragma unroll
        for (int n = 0; n < 2; ++n) { w0[n] = *(const f32x4*)(cw + ch0 + 4 * n); w1[n] = *(const f32x4*)(cw + DFF + ch0 + 4 * n); w2[n] = *(const f32x4*)(cw + 2 * DFF + ch0 + 4 * n); }
#pragma unroll
        for (int ai = 0; ai < 2; ++ai) {
            const int span = u.pm * 4 + ai * 2 + wr;
            f32x4 q1[2] = {(f32x4){0.f, 0.f, 0.f, 0.f}, (f32x4){0.f, 0.f, 0.f, 0.f}}, q2[2] = {(f32x4){0.f, 0.f, 0.f, 0.f}, (f32x4){0.f, 0.f, 0.f, 0.f}};
#pragma unroll
            for (int m = 0; m < 4; ++m) {
                f32x4 o[2];
#pragma unroll
                for (int n = 0; n < 2; ++n) {
                    const f32x4 g = acc[ai][0][m][n], up = acc[ai][1][m][n]; f32x4 s1, s2;
#pragma unroll
                    for (int i = 0; i < 4; ++i) { s1[i] = __shfl(g[i], src1); s2[i] = __shfl(g[i], src2); }
                    f32x4 p1, p2;
#pragma unroll
                    for (int i = 0; i < 4; ++i) { p1[i] = fr >= 1 ? s1[i] : q1[n][i]; p2[i] = fr >= 2 ? s2[i] : q2[n][i]; }
                    q1[n] = s1; q2[n] = s2;
                    const f32x4 cv = w0[n] * p2 + w1[n] * p1 + w2[n] * g;
#pragma unroll
                    for (int i = 0; i < 4; ++i) o[n][i] = cv[i] * up[i] * __builtin_amdgcn_rcpf(1.0f + __builtin_amdgcn_exp2f(-LOG2E * cv[i]));
                    if (m == 0 && fr < 2) { *(f32x4*)(GS + ((size_t)span * 4 + fr) * DFF + ch0 + 4 * n) = g; *(f32x4*)(US + ((size_t)span * 2 + fr) * DFF + ch0 + 4 * n) = up; }
                    if (m == 3 && fr >= 14) *(f32x4*)(GS + ((size_t)span * 4 + fr - 12) * DFF + ch0 + 4 * n) = g;
                }
                const int row = u.pm * BM + ai * HALF + wr * 64 + m * 16 + fr;
                *(u32x4*)(a + (size_t)row * DFF + ch0) = pack8(o[0], o[1], 1.0f);
            }
        }
    }
};
}

namespace att {
typedef unsigned short bf16_t;
typedef short bf16x8 __attribute__((ext_vector_type(8)));
typedef short s16x4 __attribute__((ext_vector_type(4)));
typedef float f32x16 __attribute__((ext_vector_type(16)));
typedef float f32x4 __attribute__((ext_vector_type(4)));
typedef unsigned u32x4 __attribute__((ext_vector_type(4)));
#define SBAR() __builtin_amdgcn_sched_barrier(0)
#define ALAS __attribute__((address_space(3)))
constexpr int SHM_V = 64 * 128 * 2, SHM_KMAX = 64 * (96 * 2 + 16);
constexpr int L_V = 0, L_K = 2 * SHM_V, L_POS = L_K + 2 * SHM_KMAX, L_WS = L_POS + 2 * 64 * 4, L_END = L_WS + 8 * 64 * 4;
constexpr float THR = 8.f;
__device__ __forceinline__ int v_st(int k, int c) { const int kk = (k & ~0xC) | ((k & 4) << 1) | ((k & 8) >> 1); return ((kk >> 3) * 4 + (c >> 5)) * 512 + ((kk & 7) * 32 + (c & 31)) * 2; }
__device__ __forceinline__ int v_rd_base(int lane) { return ((lane & 3) << 3) | (((lane >> 2) & 3) << 6) | (((lane >> 4) & 1) << 5) | (((lane >> 5) & 1) << 8); }
constexpr int v_rd_off(int d0, int ks, int half) { return d0 * 512 + ks * 4096 + half * 2048; }
__device__ __forceinline__ int crow(int r, int hi) { return (r & 3) + 8 * (r >> 2) + 4 * hi; }
__device__ __forceinline__ unsigned cvtpk(float lo, float hi) { unsigned r; asm volatile("v_cvt_pk_bf16_f32 %0, %1, %2" : "=v"(r) : "v"(lo), "v"(hi)); return r; }

__device__ __forceinline__ void partialSM(f32x16& p0, f32x16& p1, float& m_reg, float& alpha) {
    float pmax = p0[0];
#pragma unroll
    for (int r = 1; r < 16; ++r) pmax = fmaxf(pmax, p0[r]);
#pragma unroll
    for (int r = 0; r < 16; ++r) pmax = fmaxf(pmax, p1[r]);
    { auto rr = __builtin_amdgcn_permlane32_swap(__float_as_uint(pmax), __float_as_uint(pmax), false, false);
      pmax = fmaxf(__uint_as_float(rr[0]), __uint_as_float(rr[1])); }
    float mn;
    if (__builtin_expect(__all((pmax - m_reg) <= THR), 1)) { mn = m_reg; alpha = 1.f; }
    else { mn = fmaxf(m_reg, pmax); alpha = __builtin_amdgcn_exp2f(m_reg - mn); m_reg = mn; }
#pragma unroll
    for (int r = 0; r < 16; ++r) { p0[r] -= mn; p1[r] -= mn; }
#pragma unroll
    for (int r = 0; r < 16; ++r) p0[r] = __builtin_amdgcn_exp2f(p0[r]);
}
__device__ __forceinline__ void finishSM(f32x16& p0, f32x16& p1, float alpha, float& l_reg, bf16x8& pa0, bf16x8& pa1, bf16x8& pa2, bf16x8& pa3) {
#pragma unroll
    for (int r = 0; r < 16; ++r) p1[r] = __builtin_amdgcn_exp2f(p1[r]);
    float ps = 0;
#pragma unroll
    for (int r = 0; r < 16; ++r) ps += p0[r];
#pragma unroll
    for (int r = 0; r < 16; ++r) ps += p1[r];
    { auto rr = __builtin_amdgcn_permlane32_swap(__float_as_uint(ps), __float_as_uint(ps), false, false);
      ps = __uint_as_float(rr[0]) + __uint_as_float(rr[1]); }
    l_reg = l_reg * alpha + ps;
#define PK4(P, B_, OUT) do { unsigned a0 = cvtpk(P[B_+0], P[B_+1]), a1 = cvtpk(P[B_+2], P[B_+3]);                          \
        unsigned b0 = cvtpk(P[B_+4], P[B_+5]), b1 = cvtpk(P[B_+6], P[B_+7]);                                             \
        auto r0 = __builtin_amdgcn_permlane32_swap(a0, b0, false, false); auto r1 = __builtin_amdgcn_permlane32_swap(a1, b1, false, false); \
        u32x4 w = {r0[0], r1[0], r0[1], r1[1]}; OUT = *reinterpret_cast<bf16x8*>(&w); } while (0)
    PK4(p0, 0, pa0); PK4(p0, 8, pa1); PK4(p1, 0, pa2); PK4(p1, 8, pa3);
#undef PK4
}
template <int DQK, bool ALIBI>
__device__ __forceinline__ void qkt(f32x16& p0, f32x16& p1, const ALAS char* kb, const bf16x8* qr, bool act, const ALAS float* pk, float posq, float nslope, int hi) {
    constexpr int KP = DQK * 2 + 16;
    if (!act) { const float NEG = -__builtin_inff();
#pragma unroll
        for (int r = 0; r < 16; ++r) { p0[r] = NEG; p1[r] = NEG; } return; }
    if (ALIBI) {
#pragma unroll
        for (int g = 0; g < 4; ++g) {
            const f32x4 k0 = *(const ALAS f32x4*)(pk + 8 * g + 4 * hi), k1 = *(const ALAS f32x4*)(pk + 32 + 8 * g + 4 * hi);
#pragma unroll
            for (int i = 0; i < 4; ++i) { p0[4 * g + i] = fabsf(posq - k0[i]) * nslope; p1[4 * g + i] = fabsf(posq - k1[i]) * nslope; }
        }
    } else { p0 = f32x16{}; p1 = f32x16{}; }
#pragma unroll
    for (int d0 = 0; d0 < DQK / 16; ++d0) {
        const bf16x8 b0 = *(const ALAS bf16x8*)(kb + d0 * 32);
        const bf16x8 b1 = *(const ALAS bf16x8*)(kb + 32 * KP + d0 * 32);
        p0 = __builtin_amdgcn_mfma_f32_32x32x16_bf16(b0, qr[d0], p0, 0, 0, 0);
        p1 = __builtin_amdgcn_mfma_f32_32x32x16_bf16(b1, qr[d0], p1, 0, 0, 0); }
}
template <int VB>
__device__ __forceinline__ void pv_tile(f32x16* o, int vb0, bf16x8 pa0, bf16x8 pa1, bf16x8 pa2, bf16x8 pa3, bool act) {
    if (!act) return;
#define TRRD(dst, off) asm volatile("ds_read_b64_tr_b16 %0, %1 offset:%2" : "=&v"(dst) : "v"(vb0), "i"(off) : "memory")
#define PV_D0(d0) do { s16x4 l0, l1, l2, l3, h0, h1, h2, h3; constexpr int b_ = VB * SHM_V + v_rd_off(d0, 0, 0); \
        TRRD(l0, b_); TRRD(h0, b_ + 2048); TRRD(l1, b_ + 4096); TRRD(h1, b_ + 6144); TRRD(l2, b_ + 8192); TRRD(h2, b_ + 10240); TRRD(l3, b_ + 12288); TRRD(h3, b_ + 14336); \
        asm volatile("s_waitcnt lgkmcnt(0)" ::: "memory"); SBAR();   \
        o[d0] = __builtin_amdgcn_mfma_f32_32x32x16_bf16(pa0, (bf16x8){l0[0], l0[1], l0[2], l0[3], h0[0], h0[1], h0[2], h0[3]}, o[d0], 0, 0, 0);   \
        o[d0] = __builtin_amdgcn_mfma_f32_32x32x16_bf16(pa1, (bf16x8){l1[0], l1[1], l1[2], l1[3], h1[0], h1[1], h1[2], h1[3]}, o[d0], 0, 0, 0);   \
        o[d0] = __builtin_amdgcn_mfma_f32_32x32x16_bf16(pa2, (bf16x8){l2[0], l2[1], l2[2], l2[3], h2[0], h2[1], h2[2], h2[3]}, o[d0], 0, 0, 0);   \
        o[d0] = __builtin_amdgcn_mfma_f32_32x32x16_bf16(pa3, (bf16x8){l3[0], l3[1], l3[2], l3[3], h3[0], h3[1], h3[2], h3[3]}, o[d0], 0, 0, 0); } while (0)
    PV_D0(0); PV_D0(1); PV_D0(2); PV_D0(3);
#undef PV_D0
#undef TRRD
}
__device__ __forceinline__ void alibi(f32x16& p0, f32x16& p1, const float* pk, float posq, float nslope, int hi) {
#pragma unroll
    for (int g = 0; g < 4; ++g) {
        const f32x4 k0 = *(const f32x4*)(pk + 8 * g + 4 * hi), k1 = *(const f32x4*)(pk + 32 + 8 * g + 4 * hi);
#pragma unroll
        for (int i = 0; i < 4; ++i) { p0[4 * g + i] = fmaf(fabsf(posq - k0[i]), nslope, p0[4 * g + i]); p1[4 * g + i] = fmaf(fabsf(posq - k1[i]), nslope, p1[4 * g + i]); }
    }
}
template <int DQK, bool ALIBI>
__device__ __forceinline__ void attn_pass(ALAS char* lds, const bf16_t* __restrict__ Qh, int ldq, const bf16_t* __restrict__ Kh, int ldk, const bf16_t* __restrict__ Vh, int ldv,
                                          const float* __restrict__ posf, int q0, float nslope, f32x16 (&o)[4]) {
    constexpr int ND = DQK / 16, CH = DQK / 8, KP = DQK * 2 + 16, SHM_K = 64 * KP;
    int tid_ = threadIdx.x; asm volatile("" : "+v"(tid_));
    const int tid = tid_, wid = __builtin_amdgcn_readfirstlane(tid >> 6), lane = tid & 63, r32 = lane & 31, hi = lane >> 5;
    const int NT = (q0 + 256) / 64, nact = q0 / 64 + (wid >> 1) + 1;
    ALAS char* V_lds = lds + L_V; ALAS char* K_lds = lds + L_K; ALAS float* pos_lds = (ALAS float*)(lds + L_POS); ALAS float* ws = (ALAS float*)(lds + L_WS) + wid * 64; ALAS float* li_l = ws; ALAS float* al_l = ws + 32;
    bf16x8 qr[ND];
#pragma unroll
    for (int d0 = 0; d0 < ND; ++d0) qr[d0] = *(const bf16x8*)(Qh + (size_t)(q0 + wid * 32 + r32) * ldq + d0 * 16 + hi * 8);
    const float posq = ALIBI ? posf[q0 + wid * 32 + r32] : 0.f;
    const int k0key = tid / CH, k0ch = tid - k0key * CH; const int i1 = tid + 512; const bool has1 = (CH == 12) && (tid < 256); const int k1key = i1 / CH, k1ch = i1 - k1key * CH;
    const int sr = tid >> 4, sc = (tid & 15) * 8, vst0 = v_st(sr, sc), vst1 = v_st(32 + sr, sc);
    const int vb0 = (int)(unsigned)(uintptr_t)V_lds + v_rd_base(lane);
    const ALAS char* kfr = K_lds + r32 * KP + hi * 16;
    bf16x8 st_k0, st_k1 = {}, st_v0, st_v1; float st_p = 0.f;
#define VMW() asm volatile("s_waitcnt vmcnt(0)" ::: "memory")
#define SLOAD(t) do { const int kb_ = (t) * 64; st_k0 = *(const bf16x8*)(Kh + (size_t)(kb_ + k0key) * ldk + k0ch * 8); if (CH == 12) { if (has1) st_k1 = *(const bf16x8*)(Kh + (size_t)(kb_ + k1key) * ldk + k1ch * 8); } \
        st_v0 = *(const bf16x8*)(Vh + (size_t)(kb_ + sr) * ldv + sc); st_v1 = *(const bf16x8*)(Vh + (size_t)(kb_ + 32 + sr) * ldv + sc); if (ALIBI) { if (tid < 64) st_p = posf[kb_ + tid]; } } while (0)
#define SWRITE(bf) do { *(ALAS bf16x8*)(K_lds + (bf) * SHM_K + k0key * KP + k0ch * 16) = st_k0; if (CH == 12) { if (has1) *(ALAS bf16x8*)(K_lds + (bf) * SHM_K + k1key * KP + k1ch * 16) = st_k1; } \
        *(ALAS bf16x8*)(V_lds + (bf) * SHM_V + vst0) = st_v0; *(ALAS bf16x8*)(V_lds + (bf) * SHM_V + vst1) = st_v1; if (ALIBI) { if (tid < 64) pos_lds[(bf) * 64 + tid] = st_p; } } while (0)
#define RESC(a) do { if (__any((a) < 1.f)) { if (hi == 0) al_l[r32] = (a); asm volatile("s_waitcnt lgkmcnt(0)" ::: "memory");              \
                     _Pragma("unroll") for (int d_ = 0; d_ < 4; ++d_) _Pragma("unroll") for (int r = 0; r < 16; ++r) o[d_][r] *= al_l[crow(r, hi)]; } } while (0)
#define ACT(t) ((t) < nact)
    float m_reg = -1e30f, l_reg = 0.f;
#pragma unroll
    for (int d0 = 0; d0 < 4; ++d0) o[d0] = f32x16{};
    f32x16 pA0, pA1, pB0, pB1; float alA, alB; bf16x8 pa0, pa1, pa2, pa3;
    SLOAD(0); VMW(); SWRITE(0); __syncthreads();
    SLOAD(1);
    SBAR(); qkt<DQK, ALIBI>(pA0, pA1, kfr, qr, true, pos_lds, posq, nslope, hi);
    partialSM(pA0, pA1, m_reg, alA);
    VMW(); SWRITE(1); __syncthreads();
#define HALF_STEP(PX0, PX1, alX, PY0, PY1, alY, t, KB, VB, SB) do {                                                      \
        SBAR(); qkt<DQK, ALIBI>(PX0, PX1, kfr + (KB) * SHM_K, qr, ACT(t), pos_lds + (KB) * 64, posq, nslope, hi);              \
        finishSM(PY0, PY1, alY, l_reg, pa0, pa1, pa2, pa3); SBAR();                                                      \
        SLOAD((t) + 1); SBAR();                                                                                          \
        pv_tile<VB>(o, vb0, pa0, pa1, pa2, pa3, ACT((t) - 1));                                                          \
        partialSM(PX0, PX1, m_reg, alX);                                                                                 \
        __syncthreads();                                                                                                 \
        VMW(); SWRITE(SB);                                                                                               \
        RESC(alX); __syncthreads(); } while (0)
    for (int t = 1; t + 1 < NT; t += 2) {
        HALF_STEP(pB0, pB1, alB, pA0, pA1, alA, t, 1, 0, 0);
        HALF_STEP(pA0, pA1, alA, pB0, pB1, alB, t + 1, 0, 1, 1);
    }
    SBAR(); qkt<DQK, ALIBI>(pB0, pB1, kfr + SHM_K, qr, ACT(NT - 1), pos_lds + 64, posq, nslope, hi);
    finishSM(pA0, pA1, alA, l_reg, pa0, pa1, pa2, pa3); SBAR();
    pv_tile<0>(o, vb0, pa0, pa1, pa2, pa3, ACT(NT - 2));
    partialSM(pB0, pB1, m_reg, alB); RESC(alB);
    finishSM(pB0, pB1, alB, l_reg, pa0, pa1, pa2, pa3); SBAR();
    pv_tile<1>(o, vb0, pa0, pa1, pa2, pa3, ACT(NT - 1));
    if (hi == 0) li_l[r32] = l_reg; asm volatile("s_waitcnt lgkmcnt(0)" ::: "memory");
#pragma unroll
    for (int r = 0; r < 16; ++r) { const float rl = __builtin_amdgcn_rcpf(li_l[crow(r, hi)]);
#pragma unroll
        for (int d0 = 0; d0 < 4; ++d0) o[d0][r] *= rl; }
    __syncthreads();
#undef HALF_STEP
#undef ACT
#undef RESC
#undef SWRITE
#undef SLOAD
#undef VMW
}
__device__ __forceinline__ void store_o_bf16(const f32x16 (&o)[4], bf16_t* Ow  , int ldo, int r32, int hi) {
#pragma unroll
    for (int r = 0; r < 16; ++r) { const int orow = crow(r, hi);
#pragma unroll
        for (int d0 = 0; d0 < 4; ++d0) { const float v = o[d0][r]; const float vn = __shfl_xor(v, 1);
            if ((r32 & 1) == 0) *(unsigned*)(Ow + (size_t)orow * ldo + d0 * 32 + r32) = cvtpk(v, vn); } }
}
#undef SBAR
}

#define LAS __attribute__((address_space(3)))
typedef unsigned short bf16;
typedef unsigned v4u __attribute__((ext_vector_type(4)));
typedef unsigned v2u __attribute__((ext_vector_type(2)));
typedef float f32x4 __attribute__((ext_vector_type(4)));
#ifndef ATT_NO_DIFF
#define ATT_NO_DIFF 0
#endif
#ifndef ATT_NO_MLA
#define ATT_NO_MLA 0
#endif
#ifndef ALIBI_ON
#define ALIBI_ON true
#endif
#ifndef PHMASK
#define PHMASK 0x1ff
#endif
#define EN(k) (((PHMASK) >> (k)) & 1)
constexpr int NWAVES = 8;
constexpr int RING_BYTES = 131072, MISC_OFF = RING_BYTES, LDS_BYTES = 147456;
static_assert(att::L_END <= RING_BYTES, "attention LDS");
constexpr size_t MiB = 1u << 20;
constexpr size_t WS_CTL = 0, WS_WIN = 1 * MiB, WS_WUQ = 20 * MiB, WS_WUKV = 21 * MiB, WS_WO = 22 * MiB, WS_WGU = 30 * MiB, WS_WDN = 74 * MiB;
constexpr size_t WS_POSF = 96 * MiB, WS_COS = 97 * MiB, WS_SIN = 98 * MiB, WS_SSQ = 99 * MiB, WS_HB = 100 * MiB, WS_SCR = 164 * MiB;
constexpr size_t WS_AQ = WS_SCR, WS_AK = WS_SCR + 24 * MiB, WS_AV = WS_SCR + 48 * MiB, WS_BH = WS_SCR + 72 * MiB, WS_BB = WS_SCR + 88 * MiB, WS_BC = WS_SCR + 104 * MiB,
                 WS_CQ = WS_SCR + 120 * MiB, WS_CKV = WS_SCR + 136 * MiB, WS_CKR = WS_SCR + 144 * MiB, WS_QM = WS_SCR + 146 * MiB, WS_KM = WS_SCR + 164 * MiB, WS_VC = WS_SCR + 182 * MiB,
                 WS_STASH = WS_SCR + 206 * MiB;
constexpr size_t WS_A = WS_SCR, WS_GS = WS_SCR + 176 * MiB, WS_US = WS_SCR + 198 * MiB;
constexpr size_t WS_END = WS_SCR + 238 * MiB;
static_assert(WS_WIN + (size_t)PINP * DM * 2 <= WS_WUQ && WS_WGU + (size_t)2 * DFF * DM * 2 <= WS_WDN && WS_WDN + (size_t)DM * DFF * 2 <= WS_POSF, "weight map");
static_assert((size_t)S * DFF * 2 <= 176 * MiB && (size_t)(S / 64) * 4 * DFF * 4 <= 22 * MiB && (size_t)(S / 64) * 2 * DFF * 4 <= 11 * MiB, "ffn map");

__device__ __forceinline__ unsigned f2bf(float f) { unsigned u = __builtin_bit_cast(unsigned, f); return (u + 0x7fffu + ((u >> 16) & 1u)) >> 16; }
__device__ __forceinline__ unsigned pk2(float lo, float hi) { return f2bf(lo) | (f2bf(hi) << 16); }
__device__ __forceinline__ float bf2f(unsigned short b) { return __builtin_bit_cast(float, (unsigned)b << 16); }
__device__ __forceinline__ float bflo(unsigned w) { return __builtin_bit_cast(float, w << 16); }
__device__ __forceinline__ float bfhi(unsigned w) { return __builtin_bit_cast(float, w & 0xffff0000u); }
__device__ __forceinline__ float wave_sum(float v) {
#pragma unroll
    for (int o = 1; o < 64; o <<= 1) v += __shfl_xor(v, o);
    return v;
}
template <int MODE> __device__ __forceinline__ int dst_row(int n, int up) {
    if (MODE == 1) return ((n >> 7) << 8) + (n & 127) + up * 128;
    if (MODE == 2) { const int h = n / 192, w = n - h * 192; return w < 64 ? h * 64 + w : 384 + h * 128 + (w - 64); }
    return n;
}
template <int MODE> __device__ __forceinline__ void transpose_item(const float* __restrict__ W, int K, int N, bf16* __restrict__ WT, int up, const float* __restrict__ rs, LAS float* scr, int item, int lane) {
    const int nblk = N / 32, kb = item / nblk, nb = item - kb * nblk, k0 = 64 * kb, n0 = 32 * nb;
#pragma unroll 8
    for (int i = 0; i < 32; ++i) { const int kk = 2 * i + (lane >> 5); float v = W[(size_t)(k0 + kk) * N + n0 + (lane & 31)]; if (rs) v *= rs[k0 + kk]; scr[kk * 33 + (lane & 31)] = v; }
    asm volatile("s_waitcnt lgkmcnt(0)" ::: "memory");
    const int c = lane & 7;
#pragma unroll
    for (int j = 0; j < 4; ++j) { const int n = (lane >> 3) + 8 * j; const LAS float* s = scr + (8 * c) * 33 + n;
        v4u o; o.x = pk2(s[0 * 33], s[1 * 33]); o.y = pk2(s[2 * 33], s[3 * 33]); o.z = pk2(s[4 * 33], s[5 * 33]); o.w = pk2(s[6 * 33], s[7 * 33]);
        *(v4u*)(WT + (size_t)dst_row<MODE>(n0 + n, up) * K + k0 + 8 * c) = o; }
    asm volatile("s_waitcnt lgkmcnt(0)" ::: "memory");
}
struct Args {
    const float* x; const int* pos; const float *ln_in_g, *ln_in_b, *w_in, *diff_lambda, *diff_norm_g, *conv_w, *mla_q_norm_g, *mla_kv_norm_g, *w_uq, *w_ukv, *w_o, *ln1_g, *ln1_b,
        *ffn_w_gate, *ffn_w_up, *ffn_conv_w, *ffn_w_down, *ln2_g, *ln2_b;
    float* out; unsigned char* ws; int ph_lo, ph_hi;
};
typedef const __attribute__((address_space(4))) Args* ArgP;
__device__ __forceinline__ void convert_weights(ArgP a, int l, unsigned char* ws, LAS float* scr, int gw, int NGW, int lane) {
    constexpr int I_IN = (DM / 64) * (PIN / 32), I_UQ = (CQR / 64) * (NUQ / 32), I_UKV = (CKVR / 64) * (NUKV / 32), I_O = (DM / 64) * (DM / 32), I_G = (DM / 64) * (DFF / 32), I_D = (DFF / 64) * (DM / 32);
    constexpr int NITEMS = I_IN + I_UQ + I_UKV + I_O + 2 * I_G + I_D;
    for (int it = gw; it < NITEMS; it += NGW) {
        int r = it;
        if (r < I_IN) { transpose_item<0>(a->w_in + (size_t)l * DM * PIN, DM, PIN, (bf16*)(ws + WS_WIN), 0, nullptr, scr, r, lane); continue; } r -= I_IN;
        if (r < I_UQ) { transpose_item<0>(a->w_uq + (size_t)l * CQR * NUQ, CQR, NUQ, (bf16*)(ws + WS_WUQ), 0, a->mla_q_norm_g + l * CQR, scr, r, lane); continue; } r -= I_UQ;
        if (r < I_UKV) { transpose_item<2>(a->w_ukv + (size_t)l * CKVR * NUKV, CKVR, NUKV, (bf16*)(ws + WS_WUKV), 0, a->mla_kv_norm_g + l * CKVR, scr, r, lane); continue; } r -= I_UKV;
        if (r < I_O) { transpose_item<0>(a->w_o + (size_t)l * DM * DM, DM, DM, (bf16*)(ws + WS_WO), 0, nullptr, scr, r, lane); continue; } r -= I_O;
        if (r < I_G) { transpose_item<1>(a->ffn_w_gate + (size_t)l * DM * DFF, DM, DFF, (bf16*)(ws + WS_WGU), 0, nullptr, scr, r, lane); continue; } r -= I_G;
        if (r < I_G) { transpose_item<1>(a->ffn_w_up + (size_t)l * DM * DFF, DM, DFF, (bf16*)(ws + WS_WGU), 1, nullptr, scr, r, lane); continue; } r -= I_G;
        transpose_item<0>(a->ffn_w_down + (size_t)l * DFF * DM, DFF, DM, (bf16*)(ws + WS_WDN), 0, nullptr, scr, r, lane);
    }
}
__device__ __forceinline__ void ln_row(const float* xin, float* hout, bf16* hb, const float* __restrict__ g, const float* __restrict__ b, int lane) {
    const f32x4* xr = (const f32x4*)xin + lane;
    f32x4 v[8]; float s = 0.f;
#pragma unroll
    for (int j = 0; j < 8; ++j) { v[j] = xr[64 * j]; s += (v[j].x + v[j].y) + (v[j].z + v[j].w); }
    const float mean = wave_sum(s) * (1.f / DM); float s2 = 0.f;
#pragma unroll
    for (int j = 0; j < 8; ++j) { v[j] = v[j] - mean; s2 += (v[j].x * v[j].x + v[j].y * v[j].y) + (v[j].z * v[j].z + v[j].w * v[j].w); }
    const float rstd = 1.f / sqrtf(wave_sum(s2) * (1.f / DM) + LN_EPS);
    f32x4* ho = (f32x4*)hout + lane; v2u* o8 = (v2u*)hb + lane;
#pragma unroll
    for (int j = 0; j < 8; ++j) { const f32x4 gg = ((const f32x4*)g)[64 * j + lane], bb = ((const f32x4*)b)[64 * j + lane]; const f32x4 y = v[j] * rstd * gg + bb;
        ho[64 * j] = y; v2u w; w.x = pk2(y.x, y.y); w.y = pk2(y.z, y.w); o8[64 * j] = w; }
}
__device__ __forceinline__ void sincos_f32(float x, float& sn, float& cs) {
    const float k = __builtin_rintf(x * 0.636619772f);
    float y = __builtin_fmaf(-k, 1.570796371e+00f, x); y = __builtin_fmaf(-k, -4.371138829e-08f, y);
    const float y2 = y * y;
    float sp = 2.86567956e-6f; sp = sp * y2 - 1.98559923e-4f; sp = sp * y2 + 8.33338592e-3f; sp = sp * y2 - 1.66666672e-1f; const float sy = __builtin_fmaf(y * y2, sp, y);
    float cp = 2.44677067e-5f; cp = cp * y2 - 1.38877297e-3f; cp = cp * y2 + 4.16666567e-2f; cp = cp * y2 - 0.5f; const float cy = __builtin_fmaf(y2, cp, 1.0f);
    const int q = (int)k & 3;
    const float s_ = (q & 1) ? cy : sy, c_ = (q & 1) ? sy : cy;
    sn = (q & 2) ? -s_ : s_; cs = ((q + 1) & 2) ? -c_ : c_;
}
__device__ __forceinline__ float inv_freq16(int j) {
    float v = 1.000000000e+00f;
    v = j == 1 ? 5.623413324e-01f : v; v = j == 2 ? 3.162277639e-01f : v; v = j == 3 ? 1.778279394e-01f : v; v = j == 4 ? 1.000000015e-01f : v; v = j == 5 ? 5.623413250e-02f : v;
    v = j == 6 ? 3.162277490e-02f : v; v = j == 7 ? 1.778279431e-02f : v; v = j == 8 ? 9.999999776e-03f : v; v = j == 9 ? 5.623413250e-03f : v; v = j == 10 ? 3.162277630e-03f : v;
    v = j == 11 ? 1.778279431e-03f : v; v = j == 12 ? 1.000000047e-03f : v; v = j == 13 ? 5.623413017e-04f : v; v = j == 14 ? 3.162277571e-04f : v; v = j == 15 ? 1.778279402e-04f : v;
    return v;
}

__global__ void __launch_bounds__(NWAVES * 64, 2) mk_fwd(Args a) {
    extern __shared__ __attribute__((aligned(16))) unsigned char lds[];
    cg::grid_group grid = cg::this_grid();
    const int G = gridDim.x, NGW = G * NWAVES, NGT = G * NWAVES * 64;
    LAS unsigned char* ldsl = (LAS unsigned char*)lds;
    volatile LAS unsigned* MISC = (volatile LAS unsigned*)(ldsl + MISC_OFF);

    for (int ph = a.ph_lo; ph < a.ph_hi; ++ph) {
        ArgP ap = (ArgP)__builtin_amdgcn_kernarg_segment_ptr(); asm volatile("" : "+s"(ap));
        unsigned char* ws = ap->ws;
        float* hres = ap->out;
        bf16* hb = (bf16*)(ws + WS_HB);
        float* posf = (float*)(ws + WS_POSF); float* cost = (float*)(ws + WS_COS); float* sint = (float*)(ws + WS_SIN); float* ssq = (float*)(ws + WS_SSQ);
        unsigned* qctr = (unsigned*)(ws + WS_CTL);
        if (ph == 0 && EN(0)) {
            int tid_ = threadIdx.x; asm volatile("" : "+v"(tid_)); const int tid = tid_, lane = tid & 63, wave = __builtin_amdgcn_readfirstlane(tid >> 6), gw = blockIdx.x * NWAVES + wave, gt = blockIdx.x * (NWAVES * 64) + tid; (void)gt; (void)gw; (void)lane;
            if (blockIdx.x == 0 && tid < 2 * NLAYER) __hip_atomic_store(qctr + 64 * tid, 0u, __ATOMIC_RELAXED, __HIP_MEMORY_SCOPE_AGENT);
            convert_weights(ap, 0, ws, (LAS float*)(ldsl + wave * 16384), gw, NGW, lane);
            for (int m = gw; m < S; m += NGW) ln_row(ap->x + (size_t)m * DM, hres + (size_t)m * DM, hb + (size_t)m * DM, ap->ln_in_g, ap->ln_in_b, lane);
            for (int i = gt; i < S * 16; i += NGT) { const int s = i >> 4, j = i & 15; const float p = (float)ap->pos[s];
                float sn, cs; sincos_f32(p * inv_freq16(j), sn, cs); cost[i] = cs; sint[i] = sn; if (j == 0) posf[s] = p; }
        } else {
            const int l = (ph - 1) / 9, sub = (ph - 1) % 9;
            const float lam_init = l == 0 ? 0.2f : 0.35550906759096927f;
            if (sub == 0 && EN(1)) {
                pg8::Gemm g{hb, (const bf16*)(ws + WS_WIN), S, PINP, DM}; pg8::StaticOrder so; so.init(S, PINP, G, (int)blockIdx.x);
                pg8::EpiProj E{(bf16*)(ws + WS_AQ), (bf16*)(ws + WS_AK), (bf16*)(ws + WS_AV), (bf16*)(ws + WS_BH), (bf16*)(ws + WS_BB), (bf16*)(ws + WS_BC), (bf16*)(ws + WS_CQ), (bf16*)(ws + WS_CKV), (bf16*)(ws + WS_CKR), ssq};
                pg8::gemm_phase<pg8::EpiProj, pg8::StaticOrder, true, true>(ldsl, g, so, E);
            } else if (sub == 1 && EN(2)) {
                int tid_ = threadIdx.x; asm volatile("" : "+v"(tid_)); const int tid = tid_, lane = tid & 63, wave = __builtin_amdgcn_readfirstlane(tid >> 6), gw = blockIdx.x * NWAVES + wave, gt = blockIdx.x * (NWAVES * 64) + tid; (void)gt; (void)gw; (void)lane;
                const bf16* ckr = (const bf16*)(ws + WS_CKR); bf16* km = (bf16*)(ws + WS_KM);
                for (int s0 = gw * 4; s0 < S; s0 += NGW * 4) { const int s = s0 + (lane >> 4), j = lane & 15;
                    const float x1 = bf2f(ckr[s * 32 + j]), x2 = bf2f(ckr[s * 32 + 16 + j]), c = cost[s * 16 + j], sn = sint[s * 16 + j];
                    const unsigned short o1 = (unsigned short)f2bf(x1 * c - x2 * sn), o2 = (unsigned short)f2bf(x2 * c + x1 * sn);
#pragma unroll
                    for (int h = 0; h < 6; ++h) { km[(size_t)s * NUQ + h * 96 + 64 + j] = o1; km[(size_t)s * NUQ + h * 96 + 80 + j] = o2; } }
                { const bf16* Bh = (const bf16*)(ws + WS_BH); const bf16* Bb = (const bf16*)(ws + WS_BB); const bf16* Bc = (const bf16*)(ws + WS_BC); const float* cw = ap->conv_w + (size_t)l * 3 * 512;
                  const int c = lane * 8; float w[3][8];
#pragma unroll
                  for (int i = 0; i < 3; ++i) { const f32x4 u0 = *(const f32x4*)(cw + i * 512 + c), u1 = *(const f32x4*)(cw + i * 512 + c + 4); w[i][0] = u0.x; w[i][1] = u0.y; w[i][2] = u0.z; w[i][3] = u0.w; w[i][4] = u1.x; w[i][5] = u1.y; w[i][6] = u1.z; w[i][7] = u1.w; }
                  for (int t = gw; t < S; t += NGW) {
                      float acc[8] = {0.f, 0.f, 0.f, 0.f, 0.f, 0.f, 0.f, 0.f};
#pragma unroll
                      for (int i = 0; i < 3; ++i) { const int tt = t - 2 + i; if (tt < 0) continue;
                          const v4u hv = *(const v4u*)(Bh + (size_t)tt * 512 + c), cv = *(const v4u*)(Bc + (size_t)tt * 512 + c);
                          acc[0] += w[i][0] * bflo(hv.x) * bflo(cv.x); acc[1] += w[i][1] * bfhi(hv.x) * bfhi(cv.x); acc[2] += w[i][2] * bflo(hv.y) * bflo(cv.y); acc[3] += w[i][3] * bfhi(hv.y) * bfhi(cv.y);
                          acc[4] += w[i][4] * bflo(hv.z) * bflo(cv.z); acc[5] += w[i][5] * bfhi(hv.z) * bfhi(cv.z); acc[6] += w[i][6] * bflo(hv.w) * bflo(cv.w); acc[7] += w[i][7] * bfhi(hv.w) * bfhi(cv.w); }
                      const v4u bv = *(const v4u*)(Bb + (size_t)t * 512 + c); v4u o;
                      o.x = pk2(acc[0] * bflo(bv.x), acc[1] * bfhi(bv.x)); o.y = pk2(acc[2] * bflo(bv.y), acc[3] * bfhi(bv.y)); o.z = pk2(acc[4] * bflo(bv.z), acc[5] * bfhi(bv.z)); o.w = pk2(acc[6] * bflo(bv.w), acc[7] * bfhi(bv.w));
                      *(v4u*)(hb + (size_t)t * DM + 768 + c) = o; } }
                { pg8::Gemm g{(const bf16*)(ws + WS_CQ), (const bf16*)(ws + WS_WUQ), S, NUQP, CQR}; pg8::StaticOrder so; so.init(S, NUQP, G, (int)blockIdx.x);
                  pg8::EpiQm E{(bf16*)(ws + WS_QM), ssq, cost, sint};
                  pg8::gemm_phase<pg8::EpiQm, pg8::StaticOrder, true, true>(ldsl, g, so, E); }
                { pg8::Gemm g{(const bf16*)(ws + WS_CKV), (const bf16*)(ws + WS_WUKV), S, NUKVP, CKVR}; pg8::StaticOrder so; so.init(S, NUKVP, G, (int)blockIdx.x);
                  pg8::EpiKv E{km, (bf16*)(ws + WS_VC), ssq};
                  pg8::gemm_phase<pg8::EpiKv, pg8::StaticOrder, true, true>(ldsl, g, so, E); }
            } else if (sub == 2 && EN(3)) {
                float lam; { const int lane = lane_id_v(); const float* dl = ap->diff_lambda + (size_t)l * 256;
                  lam = __expf(wave_sum(dl[lane] * dl[64 + lane])) - __expf(wave_sum(dl[128 + lane] * dl[192 + lane])) + lam_init; }
                if (!ATT_NO_DIFF) for (;;) {
                    if (threadIdx.x == 0) MISC[0] = __hip_atomic_fetch_add(qctr + 64 * (2 * l), 1u, __ATOMIC_RELAXED, __HIP_MEMORY_SCOPE_AGENT);
                    __syncthreads(); const unsigned u = MISC[0]; __syncthreads();
                    if (u >= 384u) break;
                    const int qb = 63 - (int)(u / 6u), h = (int)(u % 6u), q0 = qb * 256;
                    att::f32x16 o[4];
                    const float nslope = -LOG2E * __builtin_amdgcn_exp2f(-8.0f * (float)(h + 1) / 6.0f);
                    for (int mp = 0; mp < 2; ++mp) {
                        att::attn_pass<64, ALIBI_ON>((LAS char*)ldsl, (const bf16*)(ws + WS_AQ) + h * 128 + mp * 64, 768, (const bf16*)(ws + WS_AK) + h * 128 + mp * 64, 768, (const bf16*)(ws + WS_AV) + h * 128, 768, posf, q0, nslope, o);
                        const int ln2 = lane_id_v(), wv2 = __builtin_amdgcn_readfirstlane(threadIdx.x >> 6);
                        float* st = (float*)(ws + WS_STASH) + (((size_t)blockIdx.x * NWAVES + wv2) * 64 + ln2) * 64;
                        if (mp == 0) {
#pragma unroll
                            for (int d0 = 0; d0 < 4; ++d0)
#pragma unroll
                                for (int r = 0; r < 16; r += 4) *(f32x4*)(st + d0 * 16 + r) = (f32x4){o[d0][r], o[d0][r + 1], o[d0][r + 2], o[d0][r + 3]};
                        } else {
                            asm volatile("s_waitcnt vmcnt(0)" ::: "memory");
#pragma unroll
                            for (int d0 = 0; d0 < 4; ++d0)
#pragma unroll
                                for (int r = 0; r < 16; r += 4) { const f32x4 sv = *(const f32x4*)(st + d0 * 16 + r);
#pragma unroll
                                    for (int i = 0; i < 4; ++i) o[d0][r + i] = sv[i] - lam * o[d0][r + i]; }
                        }
                    }
                    const int ln3 = lane_id_v(), r32 = ln3 & 31, hi = ln3 >> 5, wv3 = __builtin_amdgcn_readfirstlane(threadIdx.x >> 6);
                    const float* dng = ap->diff_norm_g + (size_t)l * 128; float gc[4];
#pragma unroll
                    for (int d0 = 0; d0 < 4; ++d0) gc[d0] = dng[d0 * 32 + r32] * (1.0f - lam_init);
#pragma unroll
                    for (int r = 0; r < 16; ++r) { float ss = (o[0][r] * o[0][r] + o[1][r] * o[1][r]) + (o[2][r] * o[2][r] + o[3][r] * o[3][r]);
                        ss += __shfl_xor(ss, 1); ss += __shfl_xor(ss, 2); ss += __shfl_xor(ss, 4); ss += __shfl_xor(ss, 8); ss += __shfl_xor(ss, 16);
                        const float rs = 1.0f / sqrtf(ss * (1.0f / 128.0f) + RMS_EPS);
#pragma unroll
                        for (int d0 = 0; d0 < 4; ++d0) o[d0][r] *= rs * gc[d0]; }
                    att::store_o_bf16(o, hb + (size_t)(q0 + wv3 * 32) * DM + h * 128, DM, r32, hi);
                }
                if (!ATT_NO_MLA) for (;;) {
                    if (threadIdx.x == 0) MISC[0] = __hip_atomic_fetch_add(qctr + 64 * (2 * l + 1), 1u, __ATOMIC_RELAXED, __HIP_MEMORY_SCOPE_AGENT);
                    __syncthreads(); const unsigned u = MISC[0]; __syncthreads();
                    if (u >= 384u) break;
                    const int qb = 63 - (int)(u / 6u), h = (int)(u % 6u), q0 = qb * 256;
                    att::f32x16 o[4];
                    att::attn_pass<96, false>((LAS char*)ldsl, (const bf16*)(ws + WS_QM) + h * 96, NUQ, (const bf16*)(ws + WS_KM) + h * 96, NUQ, (const bf16*)(ws + WS_VC) + h * 128, 768, posf, q0, 0.f, o);
                    const int ln3 = lane_id_v(), r32 = ln3 & 31, hi = ln3 >> 5, wv3 = __builtin_amdgcn_readfirstlane(threadIdx.x >> 6);
                    att::store_o_bf16(o, hb + (size_t)(q0 + wv3 * 32) * DM + 1280 + h * 128, DM, r32, hi);
                }
            } else if (sub == 3 && EN(4)) {
                pg8::Gemm g{hb, (const bf16*)(ws + WS_WO), S, DM, DM}; pg8::StaticOrder so; so.init(S, DM, G, (int)blockIdx.x);
                pg8::EpiResid E{hres};
                pg8::gemm_phase<pg8::EpiResid, pg8::StaticOrder, true, true>(ldsl, g, so, E);
            } else if ((sub == 4 || sub == 8) && EN(5)) {
                int tid_ = threadIdx.x; asm volatile("" : "+v"(tid_)); const int tid = tid_, lane = tid & 63, wave = __builtin_amdgcn_readfirstlane(tid >> 6), gw = blockIdx.x * NWAVES + wave, gt = blockIdx.x * (NWAVES * 64) + tid; (void)gt; (void)gw; (void)lane;
                const float* g_ = (sub == 4 ? ap->ln1_g : ap->ln2_g) + (size_t)l * DM; const float* b_ = (sub == 4 ? ap->ln1_b : ap->ln2_b) + (size_t)l * DM;
                for (int m = gw; m < S; m += NGW) ln_row(hres + (size_t)m * DM, hres + (size_t)m * DM, hb + (size_t)m * DM, g_, b_, lane);
                if (sub == 8 && l + 1 < NLAYER) convert_weights(ap, l + 1, ws, (LAS float*)(ldsl + wave * 16384), gw, NGW, lane);
            } else if (sub == 5 && EN(6)) {
                pg8::Gemm g{hb, (const bf16*)(ws + WS_WGU), S, 2 * DFF, DM}; pg8::StaticOrder so; so.init(S, 2 * DFF, G, (int)blockIdx.x);
                pg8::EpiGateUp E{(bf16*)(ws + WS_A), ap->ffn_conv_w + (size_t)l * 3 * DFF, (float*)(ws + WS_GS), (float*)(ws + WS_US)};
                pg8::gemm_phase<pg8::EpiGateUp, pg8::StaticOrder, true, true>(ldsl, g, so, E);
            } else if (sub == 6 && EN(7)) {
                int tid_ = threadIdx.x; asm volatile("" : "+v"(tid_)); const int tid = tid_, lane = tid & 63, wave = __builtin_amdgcn_readfirstlane(tid >> 6), gw = blockIdx.x * NWAVES + wave, gt = blockIdx.x * (NWAVES * 64) + tid; (void)gt; (void)gw; (void)lane;
                const float* cw = ap->ffn_conv_w + (size_t)l * 3 * DFF; const float* GS = (const float*)(ws + WS_GS); const float* US = (const float*)(ws + WS_US); bf16* A = (bf16*)(ws + WS_A);
                for (int i = gt; i < (S / 64) * DFF; i += NGT) { const int span = i / DFF, ch = i - span * DFF;
                    const float gm2 = span ? GS[((size_t)(span - 1) * 4 + 2) * DFF + ch] : 0.f, gm1 = span ? GS[((size_t)(span - 1) * 4 + 3) * DFF + ch] : 0.f;
                    const float g0 = GS[((size_t)span * 4 + 0) * DFF + ch], g1 = GS[((size_t)span * 4 + 1) * DFF + ch], u0 = US[((size_t)span * 2 + 0) * DFF + ch], u1 = US[((size_t)span * 2 + 1) * DFF + ch];
                    const float w0 = cw[ch], w1 = cw[DFF + ch], w2 = cw[2 * DFF + ch];
                    const float c0 = w0 * gm2 + w1 * gm1 + w2 * g0, c1 = w0 * gm1 + w1 * g0 + w2 * g1;
                    A[(size_t)(span * 64) * DFF + ch] = (bf16)f2bf(c0 * u0 / (1.0f + __expf(-c0)));
                    A[(size_t)(span * 64 + 1) * DFF + ch] = (bf16)f2bf(c1 * u1 / (1.0f + __expf(-c1))); }
            } else if (sub == 7 && EN(8)) {
                pg8::Gemm g{(const bf16*)(ws + WS_A), (const bf16*)(ws + WS_WDN), S, DM, DFF}; pg8::StaticOrder so; so.init(S, DM, G, (int)blockIdx.x);
                pg8::EpiResid E{hres};
                pg8::gemm_phase<pg8::EpiResid, pg8::StaticOrder, true, true>(ldsl, g, so, E);
            }
        }
        if (ph + 1 < a.ph_hi) grid.sync();
    }
}

extern "C" void kernel_launch(void* const* d_in, const int* in_sizes, int n_in, void* d_out, int out_size, void* d_ws, size_t ws_size, hipStream_t stream) {
    static int grid = 0;
    if (grid == 0) {
        if (n_in != 21 || in_sizes[0] != S * DM || out_size != S * DM || ws_size < WS_END) { fprintf(stderr, "kernel_launch: unexpected shapes (n_in %d, in0 %d, out %d, ws %zu < %zu)\n", n_in, n_in > 0 ? in_sizes[0] : -1, out_size, ws_size, (size_t)WS_END); grid = -1; return; }
        int dev = 0, cus = 0, per_cu = 0;
        if (hipGetDevice(&dev) != hipSuccess || hipDeviceGetAttribute(&cus, hipDeviceAttributeMultiprocessorCount, dev) != hipSuccess) { grid = -1; return; }
        if (hipFuncSetAttribute((const void*)mk_fwd, hipFuncAttributeMaxDynamicSharedMemorySize, LDS_BYTES) != hipSuccess) { fprintf(stderr, "kernel_launch: hipFuncSetAttribute failed\n"); grid = -1; return; }
        if (hipOccupancyMaxActiveBlocksPerMultiprocessor(&per_cu, (const void*)mk_fwd, NWAVES * 64, LDS_BYTES) != hipSuccess || per_cu < 1) { fprintf(stderr, "kernel_launch: occupancy query says %d\n", per_cu); per_cu = 1; }
        (void)hipGetLastError();
        grid = cus * per_cu;
    }
    if (grid < 0) return;
    Args a{};
    a.x = (const float*)d_in[0]; a.pos = (const int*)d_in[1]; a.ln_in_g = (const float*)d_in[2]; a.ln_in_b = (const float*)d_in[3]; a.w_in = (const float*)d_in[4]; a.diff_lambda = (const float*)d_in[5];
    a.diff_norm_g = (const float*)d_in[6]; a.conv_w = (const float*)d_in[7]; a.mla_q_norm_g = (const float*)d_in[8]; a.mla_kv_norm_g = (const float*)d_in[9]; a.w_uq = (const float*)d_in[10]; a.w_ukv = (const float*)d_in[11];
    a.w_o = (const float*)d_in[12]; a.ln1_g = (const float*)d_in[13]; a.ln1_b = (const float*)d_in[14]; a.ffn_w_gate = (const float*)d_in[15]; a.ffn_w_up = (const float*)d_in[16]; a.ffn_conv_w = (const float*)d_in[17];
    a.ffn_w_down = (const float*)d_in[18]; a.ln2_g = (const float*)d_in[19]; a.ln2_b = (const float*)d_in[20];
    a.out = (float*)d_out; a.ws = (unsigned char*)d_ws; a.ph_lo = 0; a.ph_hi = 1 + 9 * NLAYER;
    void* args[] = {&a};
    const hipError_t e = hipLaunchCooperativeKernel((const void*)mk_fwd, dim3(grid), dim3(NWAVES * 64), args, LDS_BYTES, stream);
    if (e != hipSuccess) fprintf(stderr, "kernel_launch: cooperative launch failed: %s (grid %d)\n", hipGetErrorString(e), grid);
}
```

```cpp
#define PROBE_SUB -1
#define PROBE_VAR 0
#include <hip/hip_runtime.h>
#include <hip/hip_cooperative_groups.h>
#include <cstdio>
#include <cstdint>
namespace cg = cooperative_groups;

constexpr int S = 16384, DM = 2048, NLAYER = 2, PIN = 4640, PINP = 4864, DFF = 5632;
constexpr int CQR = 512, CKVR = 256, NUQ = 576, NUQP = 768, NUKV = 1152, NUKVP = 1280;
constexpr float LN_EPS = 1e-5f, RMS_EPS = 1e-6f;
constexpr float ALPHA_DN = 1.4142135623730951f;
constexpr float LOG2E = 1.4426950408889634f;
constexpr float QSCALE_A = 0.125f * LOG2E;
constexpr float QSCALE_C = 0.10206207261596577f * LOG2E;
__device__ __forceinline__ int lane_id_v() { int l; asm volatile("v_mbcnt_lo_u32_b32 %0, -1, 0\n\tv_mbcnt_hi_u32_b32 %0, -1, %0" : "=v"(l)); return l; }
namespace pg8 {
#define PG8_LAS __attribute__((address_space(3)))
typedef unsigned short bf16_t;
typedef short bf16x8 __attribute__((ext_vector_type(8)));
typedef float f32x4 __attribute__((ext_vector_type(4)));
typedef unsigned u32x4 __attribute__((ext_vector_type(4)));
constexpr int BM = 256, BK = 64, HALF = 128, HTB = HALF * BK * 2  , STAGE_BYTES = 8 * HTB, NXCD = 8, WGM = 8;

__host__ __device__ __forceinline__ int lds_byte(int r, int c) { const int st = (r >> 4) * 2 + (c >> 5), rr = r & 15, cc = c & 31, ob = rr * 64 + cc * 2; return st * 1024 + (ob ^ (((ob >> 9) & 1) << 5)); }
__host__ __device__ __forceinline__ void stage_rc(int b, int& R, int& C) { const int st = b / 1024, sb = b % 1024, swz = sb ^ (((sb >> 9) & 1) << 5); R = (st >> 1) * 16 + swz / 64; C = (st & 1) * 32 + (swz % 64) / 2; }
__host__ __device__ __forceinline__ int perm32(int rho) { const int n = rho >> 4, i = rho & 15; return 8 * (i >> 2) + 4 * n + (i & 3); }

struct Unit { int pm, pn; };
struct Gemm { const bf16_t* A; const bf16_t* Bt; int M, N, K; };

struct StaticOrder {
    int nM, nN, nwg, G, c;
    __host__ __device__ void init(int M, int N, int G_, int c_) { nM = M / BM; nN = N / BM; nwg = nM * nN; G = G_; c = c_; }
    __host__ __device__ bool next(int i, Unit& u) const {
        const long L = (long)i * G + c; if (L >= nwg) return false;
        int wgid = (int)L; { const int q = nwg / NXCD, r = nwg % NXCD, xcd = wgid % NXCD, off = wgid / NXCD; wgid = (xcd < r ? xcd * (q + 1) : r * (q + 1) + (xcd - r) * q) + off; }
        const int nig = WGM * nN, gid = wgid / nig, fm = gid * WGM, gsz = (nM - fm) < WGM ? (nM - fm) : WGM;
        u.pm = fm + ((wgid % nig) % gsz); u.pn = (wgid % nig) / gsz; return true;
    }
    __device__ __forceinline__ void a_ready(const Unit&) const {}
    __device__ __forceinline__ void done(const Unit&) const {}
};

__device__ __forceinline__ unsigned cvt_pk_bf16(float lo, float hi) { unsigned r; asm volatile("v_cvt_pk_bf16_f32 %0, %1, %2" : "=v"(r) : "v"(lo), "v"(hi)); return r; }
typedef float f32x2 __attribute__((ext_vector_type(2)));
template <class Epi, class Sched, bool ALIGN_EPI = false, bool SP2 = false>
__device__ __forceinline__ void gemm_phase(PG8_LAS unsigned char* lds, const Gemm g, const Sched& S, const Epi& E) {
    int tid_ = threadIdx.x; asm volatile("" : "+v"(tid_));
    const int tid = tid_, wid = __builtin_amdgcn_readfirstlane(tid >> 6), lane = tid & 63, wr = wid >> 2, wc = wid & 3, fr = lane & 15, fq = lane >> 4;
    const int K = g.K, nt = K / BK;
    unsigned voffA[2], voffB[2];
#pragma unroll
    for (int i = 0; i < 2; ++i) { int R, C; stage_rc(tid * 16 + i * 8192, R, C); const int Rb = Epi::PERM ? ((R & ~31) + perm32(R & 31)) : R;
        voffA[i] = (unsigned)(R * K + C) * 2u; voffB[i] = (unsigned)(Rb * K + C) * 2u; }
    const size_t kstep = (size_t)(BK * 2);
    const size_t hstep = (size_t)HALF * K * 2;
    const size_t tstep = 2 * hstep;
    const unsigned ldsw = (unsigned)wid * 1024u;
    const int aoff = lds_byte(wr * 64 + fr, fq * 8), boff = lds_byte(wc * 32 + fr, fq * 8);
#define PG8_SA(b, h) (((b) * 2 + (h)) * HTB)
#define PG8_SB(b, h) ((4 + (b) * 2 + (h)) * HTB)
#define PG8_STAGE(bufoff, gbase, voff) do { _Pragma("unroll") for (int _i = 0; _i < 2; ++_i) \
        __builtin_amdgcn_global_load_lds((const unsigned*)((const char*)(gbase) + (voff)[_i]), (PG8_LAS unsigned*)(lds + (bufoff) + ldsw + _i * 8192), 16, 0, 0); } while (0)
#define PG8_LDA(dst, b, h) do { _Pragma("unroll") for (int m = 0; m < 4; ++m) _Pragma("unroll") for (int k = 0; k < 2; ++k) dst[m][k] = *(const PG8_LAS bf16x8*)(lds + PG8_SA(b, h) + aoff + m * 2048 + k * 1024); } while (0)
#define PG8_LDB(dst, b, h) do { _Pragma("unroll") for (int n = 0; n < 2; ++n) _Pragma("unroll") for (int k = 0; k < 2; ++k) dst[n][k] = *(const PG8_LAS bf16x8*)(lds + PG8_SB(b, h) + boff + n * 2048 + k * 1024); } while (0)
#define PG8_MMA(ai, bj, At, Bt) do { __builtin_amdgcn_s_setprio(1); _Pragma("unroll") for (int m = 0; m < 4; ++m) _Pragma("unroll") for (int n = 0; n < 2; ++n) _Pragma("unroll") for (int k = 0; k < 2; ++k) \
        acc[ai][bj][m][n] = __builtin_amdgcn_mfma_f32_16x16x32_bf16(Bt[n][k], At[m][k], acc[ai][bj][m][n], 0, 0, 0); __builtin_amdgcn_s_setprio(0); } while (0)
#define PG8_WAIT_V(n) asm volatile("s_waitcnt vmcnt(" #n ")" ::: "memory")
#define PG8_WAIT_L(n) asm volatile("s_waitcnt lgkmcnt(" #n ")" ::: "memory")
#define PG8_BAR __builtin_amdgcn_s_barrier()
#define PG8_SCHED __builtin_amdgcn_sched_barrier(0)
    Unit cur, nxt; int ui = 0;
    if (!S.next(0, cur)) return;
    f32x4 acc[2][2][4][2];
#pragma unroll
    for (int a = 0; a < 2; ++a)
#pragma unroll
        for (int b = 0; b < 2; ++b)
#pragma unroll
            for (int m = 0; m < 4; ++m)
#pragma unroll
                for (int n = 0; n < 2; ++n) acc[a][b][m][n] = (f32x4){0.f, 0.f, 0.f, 0.f};
    bf16x8 At[4][2], B0[2][2], B1[2][2];
    const char* cA = (const char*)g.A + (size_t)cur.pm * tstep; const char* cB = (const char*)g.Bt + (size_t)cur.pn * tstep;
    S.a_ready(cur);
    if constexpr (SP2) {
        PG8_STAGE(PG8_SB(0, 0), cB, voffB); PG8_STAGE(PG8_SB(0, 1), cB + hstep, voffB); PG8_STAGE(PG8_SA(0, 0), cA, voffA); PG8_STAGE(PG8_SA(0, 1), cA + hstep, voffA);
        if (wr == 1) PG8_BAR;
        PG8_WAIT_V(2); PG8_BAR;
        PG8_STAGE(PG8_SB(1, 0), cB + kstep, voffB); PG8_STAGE(PG8_SA(1, 0), cA + kstep, voffA); PG8_STAGE(PG8_SB(1, 1), cB + hstep + kstep, voffB);
        PG8_WAIT_V(6); PG8_BAR;
    } else {
        PG8_STAGE(PG8_SB(0, 0), cB, voffB); PG8_STAGE(PG8_SA(0, 0), cA, voffA); PG8_STAGE(PG8_SB(0, 1), cB + hstep, voffB); PG8_STAGE(PG8_SA(0, 1), cA + hstep, voffA);
        if (wr == 1) PG8_BAR;
        PG8_WAIT_V(4); PG8_BAR;
        PG8_STAGE(PG8_SB(1, 0), cB + kstep, voffB); PG8_STAGE(PG8_SA(1, 0), cA + kstep, voffA); PG8_STAGE(PG8_SB(1, 1), cB + hstep + kstep, voffB);
        PG8_WAIT_V(6); PG8_BAR;
    }
    for (;;) {
        const bool has_next = S.next(ui + 1, nxt);
        const char* nA = has_next ? (const char*)g.A + (size_t)nxt.pm * tstep : cA; const char* nB = has_next ? (const char*)g.Bt + (size_t)nxt.pn * tstep : cB;
        for (int t = 0; t < nt; t += 2) {
            const bool last = (t == nt - 2);
            const char* a1 = cA + (size_t)(t + 1) * kstep;
            const char* a2 = last ? nA : cA + (size_t)(t + 2) * kstep; const char* b2 = last ? nB : cB + (size_t)(t + 2) * kstep;
            const char* a3 = a2 + kstep; const char* b3 = b2 + kstep;
            if (last && has_next) S.a_ready(nxt);
            if constexpr (SP2) {
            PG8_LDB(B0, 0, 0); PG8_LDB(B1, 0, 1); PG8_SCHED; PG8_LDA(At, 0, 0); PG8_STAGE(PG8_SA(1, 1), a1 + hstep, voffA);
            PG8_WAIT_V(8); PG8_WAIT_L(0); PG8_BAR; PG8_MMA(0, 0, At, B0); PG8_MMA(0, 1, At, B1); PG8_BAR; PG8_SCHED;
            PG8_LDA(At, 0, 1); PG8_STAGE(PG8_SB(0, 0), b2, voffB); PG8_STAGE(PG8_SB(0, 1), b2 + hstep, voffB); PG8_STAGE(PG8_SA(0, 0), a2, voffA);
            PG8_WAIT_V(8); PG8_WAIT_L(0); PG8_BAR; PG8_MMA(1, 0, At, B0); PG8_MMA(1, 1, At, B1); PG8_BAR; PG8_SCHED;
            PG8_LDB(B0, 1, 0); PG8_LDB(B1, 1, 1); PG8_SCHED; PG8_LDA(At, 1, 0); PG8_STAGE(PG8_SA(0, 1), a2 + hstep, voffA);
            PG8_WAIT_V(8); PG8_WAIT_L(0); PG8_BAR; PG8_MMA(0, 0, At, B0); PG8_MMA(0, 1, At, B1); PG8_BAR; PG8_SCHED;
            PG8_LDA(At, 1, 1); PG8_STAGE(PG8_SB(1, 0), b3, voffB); PG8_STAGE(PG8_SB(1, 1), b3 + hstep, voffB); PG8_STAGE(PG8_SA(1, 0), a3, voffA);
            PG8_WAIT_V(8); PG8_WAIT_L(0); PG8_BAR; PG8_MMA(1, 0, At, B0); PG8_MMA(1, 1, At, B1); PG8_BAR; PG8_SCHED;
            } else {
            PG8_LDB(B0, 0, 0); PG8_SCHED; PG8_LDA(At, 0, 0); PG8_STAGE(PG8_SA(1, 1), a1 + hstep, voffA);
            PG8_WAIT_L(8); PG8_BAR; PG8_WAIT_L(0); PG8_MMA(0, 0, At, B0); PG8_BAR; PG8_SCHED;
            PG8_LDB(B1, 0, 1); PG8_STAGE(PG8_SB(0, 0), b2, voffB);
            PG8_BAR; PG8_WAIT_L(0); PG8_MMA(0, 1, At, B1); PG8_BAR;
            PG8_LDA(At, 0, 1); PG8_STAGE(PG8_SA(0, 0), a2, voffA);
            PG8_BAR; PG8_WAIT_L(0); PG8_MMA(1, 0, At, B0); PG8_BAR; PG8_SCHED;
            PG8_STAGE(PG8_SB(0, 1), b2 + hstep, voffB);
            PG8_WAIT_V(6); PG8_BAR; PG8_MMA(1, 1, At, B1); PG8_BAR;
            PG8_LDB(B0, 1, 0); PG8_SCHED; PG8_LDA(At, 1, 0); PG8_STAGE(PG8_SA(0, 1), a2 + hstep, voffA);
            PG8_WAIT_L(8); PG8_BAR; PG8_WAIT_L(0); PG8_MMA(0, 0, At, B0); PG8_BAR; PG8_SCHED;
            PG8_LDB(B1, 1, 1); PG8_STAGE(PG8_SB(1, 0), b3, voffB);
            PG8_BAR; PG8_WAIT_L(0); PG8_MMA(0, 1, At, B1); PG8_BAR;
            PG8_LDA(At, 1, 1); PG8_STAGE(PG8_SA(1, 0), a3, voffA);
            PG8_BAR; PG8_WAIT_L(0); PG8_MMA(1, 0, At, B0); PG8_BAR; PG8_SCHED;
            PG8_STAGE(PG8_SB(1, 1), b3 + hstep, voffB);
            PG8_WAIT_V(6); PG8_BAR; PG8_MMA(1, 1, At, B1); PG8_BAR;
            }
        }
        if constexpr (ALIGN_EPI) { if (wr == 0) PG8_BAR; }
        if constexpr (!Epi::AFTER_DRAIN) { E(acc, cur, wr, wc, fr, fq); S.done(cur); }
        if (!has_next) break;
#pragma unroll
        for (int a = 0; a < 2; ++a)
#pragma unroll
            for (int b = 0; b < 2; ++b)
#pragma unroll
                for (int m = 0; m < 4; ++m)
#pragma unroll
                    for (int n = 0; n < 2; ++n) acc[a][b][m][n] = (f32x4){0.f, 0.f, 0.f, 0.f};
        cur = nxt; cA = nA; cB = nB; ++ui;
        if constexpr (ALIGN_EPI) { if (wr == 1) PG8_BAR; }
    }
    PG8_WAIT_V(0);
    if constexpr (!ALIGN_EPI) { if (wr == 0) PG8_BAR; }
    PG8_BAR;
    if constexpr (Epi::AFTER_DRAIN) { E.fused(acc, cur, wr, wc, fr, fq, lds, wid, lane); S.done(cur); }
#undef PG8_SA
#undef PG8_SB
#undef PG8_STAGE
#undef PG8_LDA
#undef PG8_LDB
#undef PG8_MMA
#undef PG8_WAIT_V
#undef PG8_WAIT_L
#undef PG8_BAR
#undef PG8_SCHED
}
}

namespace pg8 {
__device__ __forceinline__ u32x4 pack8(const f32x4 a, const f32x4 b, float sc) {
    u32x4 w; w.x = cvt_pk_bf16(a[0] * sc, a[1] * sc); w.y = cvt_pk_bf16(a[2] * sc, a[3] * sc); w.z = cvt_pk_bf16(b[0] * sc, b[1] * sc); w.w = cvt_pk_bf16(b[2] * sc, b[3] * sc); return w;
}
struct EpiProj {
    static constexpr bool PERM = true, AFTER_DRAIN = false;
    bf16_t *Aq, *Ak, *Av, *Bh, *Bb, *Bc, *cq, *ckv, *ckr; float* ssq;
    __device__ __forceinline__ void operator()(const f32x4 (&acc)[2][2][4][2], const Unit& u, int wr, int wc, int fr_, int fq_) const {
        const int ln_ = lane_id_v(), fr = ln_ & 15, fq = ln_ >> 4; (void)fr_; (void)fq_;
        const int pn = u.pn; bf16_t* base; int ldc, colt, ssqi = -1, valid = 256; float sc = 1.f;
        if (pn < 3) { base = Aq; ldc = 768; colt = pn * 256; sc = QSCALE_A; }
        else if (pn < 6) { base = Ak; ldc = 768; colt = (pn - 3) * 256; }
        else if (pn < 9) { base = Av; ldc = 768; colt = (pn - 6) * 256; }
        else if (pn < 11) { base = Bh; ldc = 512; colt = (pn - 9) * 256; }
        else if (pn < 13) { base = Bb; ldc = 512; colt = (pn - 11) * 256; }
        else if (pn < 15) { base = Bc; ldc = 512; colt = (pn - 13) * 256; }
        else if (pn < 17) { base = cq; ldc = 512; colt = (pn - 15) * 256; ssqi = (pn - 15) * 4 + wc; }
        else if (pn < 18) { base = ckv; ldc = 256; colt = 0; ssqi = 8 + wc; }
        else { base = ckr; ldc = 32; colt = 0; valid = 32; }
        const int row0 = u.pm * BM + wr * 64 + fr, cl = wc * 32 + 8 * fq;
#pragma unroll
        for (int ai = 0; ai < 2; ++ai)
#pragma unroll
            for (int m = 0; m < 4; ++m) {
                const int row = row0 + ai * HALF + m * 16; bf16_t* rowp = base + (size_t)row * ldc + colt + cl;
                float q = 0.f;
#pragma unroll
                for (int bj = 0; bj < 2; ++bj) {
                    const f32x4 v0 = acc[ai][bj][m][0], v1 = acc[ai][bj][m][1];
                    q += (v0[0] * v0[0] + v0[1] * v0[1]) + (v0[2] * v0[2] + v0[3] * v0[3]) + (v1[0] * v1[0] + v1[1] * v1[1]) + (v1[2] * v1[2] + v1[3] * v1[3]);
                    if (cl + bj * HALF < valid) *(u32x4*)(rowp + bj * HALF) = pack8(v0, v1, sc);
                }
                if (ssqi >= 0) { q += __shfl_xor(q, 16); q += __shfl_xor(q, 32); if (fq == 0) ssq[(size_t)row * 12 + ssqi] = q; }
            }
    }
};
struct EpiQm {
    static constexpr bool PERM = true, AFTER_DRAIN = false;
    bf16_t* qm; const float* ssq; const float* cost; const float* sint;
    __device__ __forceinline__ void operator()(const f32x4 (&acc)[2][2][4][2], const Unit& u, int wr, int wc, int fr_, int fq_) const {
        const int ln_ = lane_id_v(), fr = ln_ & 15, fq = ln_ >> 4; (void)fr_; (void)fq_;
        const int row0 = u.pm * BM + wr * 64 + fr;
#pragma unroll
        for (int ai = 0; ai < 2; ++ai)
#pragma unroll
            for (int m = 0; m < 4; ++m) {
                const int row = row0 + ai * HALF + m * 16;
                const f32x4 s0 = *(const f32x4*)(ssq + (size_t)row * 12), s1 = *(const f32x4*)(ssq + (size_t)row * 12 + 4);
                const float rq = 1.0f / sqrtf((((s0[0] + s0[1]) + (s0[2] + s0[3])) + ((s1[0] + s1[1]) + (s1[2] + s1[3]))) * (1.0f / CQR) + RMS_EPS);
#pragma unroll
                for (int bj = 0; bj < 2; ++bj) {
                    const int g32 = u.pn * 8 + bj * 4 + wc;
                    if (g32 >= NUQ / 32) continue;
                    f32x4 v0 = acc[ai][bj][m][0] * rq, v1 = acc[ai][bj][m][1] * rq;
                    if (g32 % 3 == 2) {
                        f32x4 p0, p1;
#pragma unroll
                        for (int i = 0; i < 4; ++i) { p0[i] = __shfl_xor(v0[i], 32); p1[i] = __shfl_xor(v1[i], 32); }
                        const int j0 = (fq & 1) * 8;
                        const f32x4 c0 = *(const f32x4*)(cost + (size_t)row * 16 + j0), c1 = *(const f32x4*)(cost + (size_t)row * 16 + j0 + 4);
                        f32x4 n0 = *(const f32x4*)(sint + (size_t)row * 16 + j0), n1 = *(const f32x4*)(sint + (size_t)row * 16 + j0 + 4);
                        if (fq < 2) { n0 = -n0; n1 = -n1; }
                        v0 = v0 * c0 + p0 * n0; v1 = v1 * c1 + p1 * n1;
                    }
                    *(u32x4*)(qm + (size_t)row * NUQ + g32 * 32 + 8 * fq) = pack8(v0, v1, QSCALE_C);
                }
            }
    }
};
struct EpiKv {
    static constexpr bool PERM = true, AFTER_DRAIN = false;
    bf16_t* km; bf16_t* vc; const float* ssq;
    __device__ __forceinline__ void operator()(const f32x4 (&acc)[2][2][4][2], const Unit& u, int wr, int wc, int fr_, int fq_) const {
        const int ln_ = lane_id_v(), fr = ln_ & 15, fq = ln_ >> 4; (void)fr_; (void)fq_;
        const int row0 = u.pm * BM + wr * 64 + fr;
#pragma unroll
        for (int ai = 0; ai < 2; ++ai)
#pragma unroll
            for (int m = 0; m < 4; ++m) {
                const int row = row0 + ai * HALF + m * 16;
                const f32x4 s0 = *(const f32x4*)(ssq + (size_t)row * 12 + 8);
                const float rk = 1.0f / sqrtf(((s0[0] + s0[1]) + (s0[2] + s0[3])) * (1.0f / CKVR) + RMS_EPS);
#pragma unroll
                for (int bj = 0; bj < 2; ++bj) {
                    const int c8 = u.pn * 256 + bj * HALF + wc * 32 + 8 * fq;
                    if (c8 >= NUKV) continue;
                    bf16_t* dst = (c8 < 384) ? km + (size_t)row * NUQ + (c8 >> 6) * 96 + (c8 & 63) : vc + (size_t)row * 768 + (c8 - 384);
                    *(u32x4*)dst = pack8(acc[ai][bj][m][0], acc[ai][bj][m][1], rk);
                }
            }
    }
};
struct EpiResid {
    static constexpr bool PERM = false, AFTER_DRAIN = false;
    float* h;
    __device__ __forceinline__ void operator()(const f32x4 (&acc)[2][2][4][2], const Unit& u, int wr, int wc, int fr_, int fq_) const {
        const int ln_ = lane_id_v(), fr = ln_ & 15, fq = ln_ >> 4; (void)fr_; (void)fq_;
        const int row0 = u.pm * BM + wr * 64 + fr, col0 = u.pn * BM + wc * 32 + 4 * fq;
#pragma unroll
        for (int ai = 0; ai < 2; ++ai)
#pragma unroll
            for (int m = 0; m < 4; ++m) {
                float* rowp = h + (size_t)(row0 + ai * HALF + m * 16) * DM + col0;
                f32x4 t[2][2];
#pragma unroll
                for (int bj = 0; bj < 2; ++bj)
#pragma unroll
                    for (int n = 0; n < 2; ++n) t[bj][n] = *(const f32x4*)(rowp + bj * HALF + n * 16);
#pragma unroll
                for (int bj = 0; bj < 2; ++bj)
#pragma unroll
                    for (int n = 0; n < 2; ++n) *(f32x4*)(rowp + bj * HALF + n * 16) = t[bj][n] * ALPHA_DN + acc[ai][bj][m][n];
                asm volatile("" ::: "memory");
            }
    }
};
struct EpiGateUp {
    static constexpr bool PERM = true, AFTER_DRAIN = false;
    bf16_t* a; const float* cw; float* GS; float* US;
    __device__ __forceinline__ void operator()(const f32x4 (&acc)[2][2][4][2], const Unit& u, int wr, int wc, int fr_, int fq_) const {
        const int ln_ = lane_id_v(), fr = ln_ & 15, fq = ln_ >> 4; (void)fr_; (void)fq_;
        const int ch0 = u.pn * 128 + wc * 32 + 8 * fq, lane = fq * 16 + fr;
        const int src1 = (lane & 48) | ((fr - 1) & 15), src2 = (lane & 48) | ((fr - 2) & 15);
        f32x4 w0[2], w1[2], w2[2];
#pragma unroll
        for (int n = 0; n < 2; ++n) { w0[n] = *(const f32x4*)(cw + ch0 + 4 * n); w1[n] = *(const f32x4*)(cw + DFF + ch0 + 4 * n); w2[n] = *(const f32x4*)(cw + 2 * DFF + ch0 + 4 * n); }
#pragma unroll
        for (int ai = 0; ai < 2; ++ai) {
            const int span = u.pm * 4 + ai * 2 + wr;
            f32x4 q1[2] = {(f32x4){0.f, 0.f, 0.f, 0.f}, (f32x4){0.f, 0.f, 0.f, 0.f}}, q2[2] = {(f32x4){0.f, 0.f, 0.f, 0.f}, (f32x4){0.f, 0.f, 0.f, 0.f}};
#pragma unroll
            for (int m = 0; m < 4; ++m) {
                f32x4 o[2];
#pragma unroll
                for (int n = 0; n < 2; ++n) {
                    const f32x4 g = acc[ai][0][m][n], up = acc[ai][1][m][n]; f32x4 s1, s2;
#pragma unroll
                    for (int i = 0; i < 4; ++i) { s1[i] = __shfl(g[i], src1); s2[i] = __shfl(g[i], src2); }
                    f32x4 p1, p2;
#pragma unroll
                    for (int i = 0; i < 4; ++i) { p1[i] = fr >= 1 ? s1[i] : q1[n][i]; p2[i] = fr >= 2 ? s2[i] : q2[n][i]; }
                    q1[n] = s1; q2[n] = s2;
                    const f32x4 cv = w0[n] * p2 + w1[n] * p1 + w2[n] * g;
#pragma unroll
                    for (int i = 0; i < 4; ++i) o[n][i] = cv[i] * up[i] * __builtin_amdgcn_rcpf(1.0f + __builtin_amdgcn_exp2f(-LOG2E * cv[i]));
                    if (m == 0 && fr < 2) { *(f32x4*)(GS + ((size_t)span * 4 + fr) * DFF + ch0 + 4 * n) = g; *(f32x4*)(US + ((size_t)span * 2 + fr) * DFF + ch0 + 4 * n) = up; }
                    if (m == 3 && fr >= 14) *(f32x4*)(GS + ((size_t)span * 4 + fr - 12) * DFF + ch0 + 4 * n) = g;
                }
                const int row = u.pm * BM + ai * HALF + wr * 64 + m * 16 + fr;
                *(u32x4*)(a + (size_t)row * DFF + ch0) = pack8(o[0], o[1], 1.0f);
            }
        }
    }
};
}

namespace att {
typedef unsigned short bf16_t;
typedef short bf16x8 __attribute__((ext_vector_type(8)));
typedef short s16x4 __attribute__((ext_vector_type(4)));
typedef float f32x16 __attribute__((ext_vector_type(16)));
typedef float f32x4 __attribute__((ext_vector_type(4)));
typedef unsigned u32x4 __attribute__((ext_vector_type(4)));
#define SBAR() __builtin_amdgcn_sched_barrier(0)
#define ALAS __attribute__((address_space(3)))
constexpr int SHM_V = 64 * 128 * 2, SHM_KMAX = 64 * (96 * 2 + 16);
constexpr int L_V = 0, L_K = 2 * SHM_V, L_POS = L_K + 2 * SHM_KMAX, L_WS = L_POS + 2 * 80 * 4, L_END = L_WS + 8 * 64 * 4;
constexpr float THR = 8.f;
__device__ __forceinline__ int v_st(int k, int c) { const int kk = (k & ~0xC) | ((k & 4) << 1) | ((k & 8) >> 1); return ((kk >> 3) * 4 + (c >> 5)) * 512 + ((kk & 7) * 32 + (c & 31)) * 2; }
__device__ __forceinline__ int v_rd_base(int lane) { return ((lane & 3) << 3) | (((lane >> 2) & 3) << 6) | (((lane >> 4) & 1) << 5) | (((lane >> 5) & 1) << 8); }
constexpr int v_rd_off(int d0, int ks, int half) { return d0 * 512 + ks * 4096 + half * 2048; }
__device__ __forceinline__ int crow(int r, int hi) { return (r & 3) + 8 * (r >> 2) + 4 * hi; }
__device__ __forceinline__ unsigned cvtpk(float lo, float hi) { unsigned r; asm volatile("v_cvt_pk_bf16_f32 %0, %1, %2" : "=v"(r) : "v"(lo), "v"(hi)); return r; }

template <int DQK, bool ALIBI>
__device__ __forceinline__ void qkt(f32x16& p0, f32x16& p1, const ALAS char* kb, const bf16x8* qr, const ALAS float* pk, float rowc, float m_reg, float qmin, const f32x16& negm, int hi) {
    constexpr int KP = DQK * 2 + 16;
    if (ALIBI) {
        if (pk[64] <= qmin) {
            const float base = rowc - m_reg;
#pragma unroll
            for (int g = 0; g < 4; ++g) {
                const f32x4 k0 = *(const ALAS f32x4*)(pk + 8 * g + 4 * hi), k1 = *(const ALAS f32x4*)(pk + 32 + 8 * g + 4 * hi);
#pragma unroll
                for (int i = 0; i < 4; ++i) { p0[4 * g + i] = base + k0[i]; p1[4 * g + i] = base + k1[i]; }
            }
        } else {
#pragma unroll
            for (int g = 0; g < 4; ++g) {
                const f32x4 k0 = *(const ALAS f32x4*)(pk + 8 * g + 4 * hi), k1 = *(const ALAS f32x4*)(pk + 32 + 8 * g + 4 * hi);
#pragma unroll
                for (int i = 0; i < 4; ++i) { p0[4 * g + i] = -fabsf(rowc + k0[i]) - m_reg; p1[4 * g + i] = -fabsf(rowc + k1[i]) - m_reg; }
            }
        }
    }
#pragma unroll
    for (int d0 = 0; d0 < DQK / 16; ++d0) {
        const bf16x8 b0 = *(const ALAS bf16x8*)(kb + d0 * 32);
        const bf16x8 b1 = *(const ALAS bf16x8*)(kb + 32 * KP + d0 * 32);
        if (!ALIBI && d0 == 0) { p0 = __builtin_amdgcn_mfma_f32_32x32x16_bf16(b0, qr[0], negm, 0, 0, 0); p1 = __builtin_amdgcn_mfma_f32_32x32x16_bf16(b1, qr[0], negm, 0, 0, 0); }
        else { p0 = __builtin_amdgcn_mfma_f32_32x32x16_bf16(b0, qr[d0], p0, 0, 0, 0); p1 = __builtin_amdgcn_mfma_f32_32x32x16_bf16(b1, qr[d0], p1, 0, 0, 0); } }
}
__device__ __forceinline__ void pv_tile(f32x16* o, int vb, bf16x8 pa0, bf16x8 pa1, bf16x8 pa2, bf16x8 pa3) {
#define TRRD(dst, off) asm volatile("ds_read_b64_tr_b16 %0, %1 offset:%2" : "=&v"(dst) : "v"(vb), "i"(off) : "memory")
#define PV_D0(d0) do { s16x4 l0, l1, l2, l3, h0, h1, h2, h3; constexpr int b_ = v_rd_off(d0, 0, 0); \
        TRRD(l0, b_); TRRD(h0, b_ + 2048); TRRD(l1, b_ + 4096); TRRD(h1, b_ + 6144); TRRD(l2, b_ + 8192); TRRD(h2, b_ + 10240); TRRD(l3, b_ + 12288); TRRD(h3, b_ + 14336); \
        asm volatile("s_waitcnt lgkmcnt(0)" ::: "memory"); SBAR();   \
        o[d0] = __builtin_amdgcn_mfma_f32_32x32x16_bf16(pa0, (bf16x8){l0[0], l0[1], l0[2], l0[3], h0[0], h0[1], h0[2], h0[3]}, o[d0], 0, 0, 0);   \
        o[d0] = __builtin_amdgcn_mfma_f32_32x32x16_bf16(pa1, (bf16x8){l1[0], l1[1], l1[2], l1[3], h1[0], h1[1], h1[2], h1[3]}, o[d0], 0, 0, 0);   \
        o[d0] = __builtin_amdgcn_mfma_f32_32x32x16_bf16(pa2, (bf16x8){l2[0], l2[1], l2[2], l2[3], h2[0], h2[1], h2[2], h2[3]}, o[d0], 0, 0, 0);   \
        o[d0] = __builtin_amdgcn_mfma_f32_32x32x16_bf16(pa3, (bf16x8){l3[0], l3[1], l3[2], l3[3], h3[0], h3[1], h3[2], h3[3]}, o[d0], 0, 0, 0); } while (0)
    PV_D0(0); PV_D0(1); PV_D0(2); PV_D0(3);
#undef PV_D0
#undef TRRD
}
template <int DQK, bool ALIBI, int VAR = 0>
__device__ __forceinline__ void attn_pass(ALAS char* lds, const bf16_t* __restrict__ Qh, int ldq, const bf16_t* __restrict__ Kh, int ldk, const bf16_t* __restrict__ Vh, int ldv,
                                          const float* __restrict__ posf, int q0, float nslope, f32x16 (&o)[4]) {
    constexpr int ND = DQK / 16, CH = DQK / 8, KP = DQK * 2 + 16, SHM_K = 64 * KP;
    int tid_ = threadIdx.x; asm volatile("" : "+v"(tid_));
    const int tid = tid_, wid = __builtin_amdgcn_readfirstlane(tid >> 6), lane = tid & 63, r32 = lane & 31, hi = lane >> 5, grp = wid >> 2;
    const int NT = (q0 + 256) / 64, nact = q0 / 64 + (wid >> 1) + 1, kfirst = NT - nact;
    ALAS char* V_lds = lds + L_V; ALAS char* K_lds = lds + L_K; ALAS float* pos_lds = (ALAS float*)(lds + L_POS); ALAS float* ws = (ALAS float*)(lds + L_WS) + wid * 64; ALAS float* li_l = ws; ALAS float* al_l = ws + 32;
    bf16x8 qr[ND];
#pragma unroll
    for (int d0 = 0; d0 < ND; ++d0) qr[d0] = *(const bf16x8*)(Qh + (size_t)(q0 + wid * 32 + r32) * ldq + d0 * 16 + hi * 8);
    float rowc = 0.f, qmin = 0.f;
    if (ALIBI) { const float pq = posf[q0 + wid * 32 + r32]; rowc = nslope * pq; qmin = pq;
#pragma unroll
        for (int off = 1; off < 32; off <<= 1) qmin = fminf(qmin, __shfl_xor(qmin, off)); }
    const int k0key = tid / CH, k0ch = tid - k0key * CH; const int i1 = tid + 512; const bool has1 = (CH == 12) && (tid < 256); const int k1key = i1 / CH, k1ch = i1 - k1key * CH;
    const int sr = tid >> 4, sc = (tid & 15) * 8, vst0 = v_st(sr, sc), vst1 = v_st(32 + sr, sc);
    const int vb0 = (int)(unsigned)(uintptr_t)V_lds + v_rd_base(lane);
    const ALAS char* kfr = K_lds + r32 * KP + hi * 16;
    bf16x8 st_k0, st_k1 = {}, st_v0, st_v1; float st_p = 0.f;
#define VMW() asm volatile("s_waitcnt vmcnt(0)" ::: "memory")
#define LBAR() asm volatile("s_waitcnt lgkmcnt(0)\n\ts_barrier" ::: "memory")
#define TI(k) (NT - 1 - (k))
#define SLOAD_K(t) do { const int kb_ = (t) * 64; st_k0 = *(const bf16x8*)(Kh + (size_t)(kb_ + k0key) * ldk + k0ch * 8); if (CH == 12) { if (has1) st_k1 = *(const bf16x8*)(Kh + (size_t)(kb_ + k1key) * ldk + k1ch * 8); } \
        if (ALIBI) { if (tid < 64) st_p = posf[kb_ + tid]; } } while (0)
#define SLOAD_V(t) do { const int kb_ = (t) * 64; st_v0 = *(const bf16x8*)(Vh + (size_t)(kb_ + sr) * ldv + sc); st_v1 = *(const bf16x8*)(Vh + (size_t)(kb_ + 32 + sr) * ldv + sc); } while (0)
#define SWRITE_K(bf) do { *(ALAS bf16x8*)(K_lds + (bf) * SHM_K + k0key * KP + k0ch * 16) = st_k0; if (CH == 12) { if (has1) *(ALAS bf16x8*)(K_lds + (bf) * SHM_K + k1key * KP + k1ch * 16) = st_k1; } \
        if (ALIBI) { if (tid < 64) { pos_lds[(bf) * 80 + tid] = -nslope * st_p; float mx = st_p; _Pragma("unroll") for (int off = 1; off < 64; off <<= 1) mx = fmaxf(mx, __shfl_xor(mx, off)); if (tid == 0) pos_lds[(bf) * 80 + 64] = mx; } } } while (0)
#define SWRITE_V(bf) do { *(ALAS bf16x8*)(V_lds + (bf) * SHM_V + vst0) = st_v0; *(ALAS bf16x8*)(V_lds + (bf) * SHM_V + vst1) = st_v1; } while (0)
    float m_reg = 0.f, l_reg = 0.f;
#pragma unroll
    for (int d0 = 0; d0 < 4; ++d0) o[d0] = f32x16{};
    f32x16 p0 = f32x16{}, p1 = f32x16{}, negm = f32x16{}; bf16x8 pa0 = {}, pa1 = {}, pa2 = {}, pa3 = {};
#define MBLOCK(k) do { if (VAR == 2) break; SBAR(); \
        if ((k) >= 1 && (k) - 1 >= kfirst) pv_tile(o, vb0 + (((k) - 1) & 1) * SHM_V, pa0, pa1, pa2, pa3); SBAR(); \
        if ((k) < NT && (k) >= kfirst) qkt<DQK, ALIBI>(p0, p1, kfr + ((k) & 1) * SHM_K, qr, pos_lds + ((k) & 1) * 80, rowc, m_reg, qmin, negm, hi); SBAR(); } while (0)
#define VBLOCK(k) do { if (VAR != 1 && (k) >= kfirst) { SBAR(); \
        float pmax = fmaxf(fmaxf(p0[0], p0[1]), p1[0]); \
        _Pragma("unroll") for (int r = 2; r < 16; r += 2) pmax = fmaxf(fmaxf(pmax, p0[r]), p0[r + 1]); \
        _Pragma("unroll") for (int r = 1; r < 15; r += 2) pmax = fmaxf(fmaxf(pmax, p1[r]), p1[r + 1]); \
        pmax = fmaxf(pmax, p1[15]); \
        { auto rr = __builtin_amdgcn_permlane32_swap(__float_as_uint(pmax), __float_as_uint(pmax), false, false); pmax = fmaxf(__uint_as_float(rr[0]), __uint_as_float(rr[1])); } \
        const bool first = (k) == kfirst; \
        if (first || !__all(pmax <= THR)) { \
            const float delta = first ? pmax : fmaxf(pmax, 0.f); m_reg += delta; \
            _Pragma("unroll") for (int r = 0; r < 16; ++r) { p0[r] -= delta; p1[r] -= delta; } \
            if (!ALIBI) { _Pragma("unroll") for (int r = 0; r < 16; ++r) negm[r] = -m_reg; } \
            { const float alpha = first ? 1.0f : __builtin_amdgcn_exp2f(-delta); l_reg *= alpha; \
                if (hi == 0) al_l[r32] = alpha; asm volatile("s_waitcnt lgkmcnt(0)" ::: "memory"); \
                _Pragma("unroll") for (int d_ = 0; d_ < 4; ++d_) _Pragma("unroll") for (int r = 0; r < 16; ++r) o[d_][r] *= al_l[crow(r, hi)]; } } \
        _Pragma("unroll") for (int r = 0; r < 16; ++r) { p0[r] = __builtin_amdgcn_exp2f(p0[r]); p1[r] = __builtin_amdgcn_exp2f(p1[r]); } \
        float ps = 0.f; \
        _Pragma("unroll") for (int r = 0; r < 16; ++r) ps += p0[r]; \
        _Pragma("unroll") for (int r = 0; r < 16; ++r) ps += p1[r]; \
        l_reg += ps; \
        PK4(p0, 0, pa0); PK4(p0, 8, pa1); PK4(p1, 0, pa2); PK4(p1, 8, pa3); SBAR(); } } while (0)
#define PK4(P, B_, OUT) do { unsigned a0 = cvtpk(P[B_+0], P[B_+1]), a1 = cvtpk(P[B_+2], P[B_+3]);                          \
        unsigned b0 = cvtpk(P[B_+4], P[B_+5]), b1 = cvtpk(P[B_+6], P[B_+7]);                                             \
        auto r0 = __builtin_amdgcn_permlane32_swap(a0, b0, false, false); auto r1 = __builtin_amdgcn_permlane32_swap(a1, b1, false, false); \
        u32x4 w = {r0[0], r1[0], r0[1], r1[1]}; OUT = *reinterpret_cast<bf16x8*>(&w); } while (0)
    SLOAD_K(TI(0)); VMW(); SWRITE_K(0); LBAR();
#define STG_A(k) do { if (VAR == 3) break; if ((k) + 1 < NT) SLOAD_K(TI((k) + 1)); if ((k) < NT) SLOAD_V(TI(k)); } while (0)
#define STG_B(k, KB) do { if (VAR != 3 && (k) < NT) { VMW(); if ((k) + 1 < NT) SWRITE_K(1 - (KB)); SWRITE_V(KB); } } while (0)
    if (grp == 0) {
        for (int k = 0; k <= NT; k += 2) {
            STG_A(k); MBLOCK(k); LBAR();
            STG_B(k, 0); if (k < NT) VBLOCK(k); LBAR();
            if (k + 1 <= NT) {
            STG_A(k + 1); MBLOCK(k + 1); LBAR();
            STG_B(k + 1, 1); if (k + 1 < NT) VBLOCK(k + 1); LBAR(); }
        }
    } else {
        for (int k = 0; k <= NT; k += 2) {
            STG_A(k); if (k >= 1) VBLOCK(k - 1); LBAR();
            STG_B(k, 0); MBLOCK(k); LBAR();
            if (k + 1 <= NT) {
            STG_A(k + 1); VBLOCK(k); LBAR();
            STG_B(k + 1, 1); MBLOCK(k + 1); LBAR(); }
        }
    }
#undef STG_A
#undef STG_B
    { auto rr = __builtin_amdgcn_permlane32_swap(__float_as_uint(l_reg), __float_as_uint(l_reg), false, false); l_reg = __uint_as_float(rr[0]) + __uint_as_float(rr[1]); }
    if (hi == 0) li_l[r32] = l_reg; asm volatile("s_waitcnt lgkmcnt(0)" ::: "memory");
#pragma unroll
    for (int r = 0; r < 16; ++r) { const float rl = __builtin_amdgcn_rcpf(li_l[crow(r, hi)]);
#pragma unroll
        for (int d0 = 0; d0 < 4; ++d0) o[d0][r] *= rl; }
#undef PK4
#undef VBLOCK
#undef MBLOCK
#undef SWRITE_V
#undef SWRITE_K
#undef SLOAD_V
#undef SLOAD_K
#undef TI
#undef VMW
#undef LBAR
}
__device__ __forceinline__ void store_o_bf16(const f32x16 (&o)[4], bf16_t* Ow  , int ldo, int r32, int hi) {
#pragma unroll
    for (int r = 0; r < 16; ++r) { const int orow = crow(r, hi);
#pragma unroll
        for (int d0 = 0; d0 < 4; ++d0) { const float v = o[d0][r]; const float vn = __shfl_xor(v, 1);
            if ((r32 & 1) == 0) *(unsigned*)(Ow + (size_t)orow * ldo + d0 * 32 + r32) = cvtpk(v, vn); } }
}
#undef SBAR
}

#define LAS __attribute__((address_space(3)))
typedef unsigned short bf16;
typedef unsigned v4u __attribute__((ext_vector_type(4)));
typedef unsigned v2u __attribute__((ext_vector_type(2)));
typedef float f32x4 __attribute__((ext_vector_type(4)));
#ifndef ATT_NO_DIFF
#define ATT_NO_DIFF 0
#endif
#ifndef ATT_NO_MLA
#define ATT_NO_MLA 0
#endif
#ifndef ALIBI_ON
#define ALIBI_ON true
#endif
#ifndef PROBE_VAR
#define PROBE_VAR 0
#endif
#define ATT_CALL_D(...) do { if (PROBE_VAR == 0 || rep == 0) att::attn_pass<64, ALIBI_ON, 0>(__VA_ARGS__); else att::attn_pass<64, ALIBI_ON, PROBE_VAR>(__VA_ARGS__); } while (0)
#define ATT_CALL_M(...) do { if (PROBE_VAR == 0 || rep == 0) att::attn_pass<96, false, 0>(__VA_ARGS__); else att::attn_pass<96, false, PROBE_VAR>(__VA_ARGS__); } while (0)
#ifndef PHMASK
#define PHMASK 0x1ff
#endif
#define EN(k) (((PHMASK) >> (k)) & 1)
constexpr int NWAVES = 8;
constexpr int RING_BYTES = 131072, MISC_OFF = RING_BYTES, LDS_BYTES = 147456;
static_assert(att::L_END <= RING_BYTES, "attention LDS");
constexpr size_t MiB = 1u << 20;
constexpr size_t WS_CTL = 0, WS_WIN = 1 * MiB, WS_WUQ = 20 * MiB, WS_WUKV = 21 * MiB, WS_WO = 22 * MiB, WS_WGU = 30 * MiB, WS_WDN = 74 * MiB;
constexpr size_t WS_POSF = 96 * MiB, WS_COS = 97 * MiB, WS_SIN = 98 * MiB, WS_SSQ = 99 * MiB, WS_HB = 100 * MiB, WS_SCR = 164 * MiB;
constexpr size_t WS_AQ = WS_SCR, WS_AK = WS_SCR + 24 * MiB, WS_AV = WS_SCR + 48 * MiB, WS_BH = WS_SCR + 72 * MiB, WS_BB = WS_SCR + 88 * MiB, WS_BC = WS_SCR + 104 * MiB,
                 WS_CQ = WS_SCR + 120 * MiB, WS_CKV = WS_SCR + 136 * MiB, WS_CKR = WS_SCR + 144 * MiB, WS_QM = WS_SCR + 146 * MiB, WS_KM = WS_SCR + 164 * MiB, WS_VC = WS_SCR + 182 * MiB,
                 WS_STASH = WS_SCR + 206 * MiB;
constexpr size_t WS_A = WS_SCR, WS_GS = WS_SCR + 176 * MiB, WS_US = WS_SCR + 198 * MiB;
constexpr size_t WS_END = WS_SCR + 238 * MiB;
static_assert(WS_WIN + (size_t)PINP * DM * 2 <= WS_WUQ && WS_WGU + (size_t)2 * DFF * DM * 2 <= WS_WDN && WS_WDN + (size_t)DM * DFF * 2 <= WS_POSF, "weight map");
static_assert((size_t)S * DFF * 2 <= 176 * MiB && (size_t)(S / 64) * 4 * DFF * 4 <= 22 * MiB && (size_t)(S / 64) * 2 * DFF * 4 <= 11 * MiB, "ffn map");

__device__ __forceinline__ unsigned f2bf(float f) { unsigned u = __builtin_bit_cast(unsigned, f); return (u + 0x7fffu + ((u >> 16) & 1u)) >> 16; }
__device__ __forceinline__ unsigned pk2(float lo, float hi) { return f2bf(lo) | (f2bf(hi) << 16); }
__device__ __forceinline__ float bf2f(unsigned short b) { return __builtin_bit_cast(float, (unsigned)b << 16); }
__device__ __forceinline__ float bflo(unsigned w) { return __builtin_bit_cast(float, w << 16); }
__device__ __forceinline__ float bfhi(unsigned w) { return __builtin_bit_cast(float, w & 0xffff0000u); }
__device__ __forceinline__ float wave_sum(float v) {
#pragma unroll
    for (int o = 1; o < 64; o <<= 1) v += __shfl_xor(v, o);
    return v;
}
template <int MODE> __device__ __forceinline__ int dst_row(int n, int up) {
    if (MODE == 1) return ((n >> 7) << 8) + (n & 127) + up * 128;
    if (MODE == 2) { const int h = n / 192, w = n - h * 192; return w < 64 ? h * 64 + w : 384 + h * 128 + (w - 64); }
    return n;
}
template <int MODE> __device__ __forceinline__ void transpose_item(const float* __restrict__ W, int K, int N, bf16* __restrict__ WT, int up, const float* __restrict__ rs, LAS float* scr, int item, int lane) {
    const int nblk = N / 32, kb = item / nblk, nb = item - kb * nblk, k0 = 64 * kb, n0 = 32 * nb;
#pragma unroll 8
    for (int i = 0; i < 32; ++i) { const int kk = 2 * i + (lane >> 5); float v = W[(size_t)(k0 + kk) * N + n0 + (lane & 31)]; if (rs) v *= rs[k0 + kk]; scr[kk * 33 + (lane & 31)] = v; }
    asm volatile("s_waitcnt lgkmcnt(0)" ::: "memory");
    const int c = lane & 7;
#pragma unroll
    for (int j = 0; j < 4; ++j) { const int n = (lane >> 3) + 8 * j; const LAS float* s = scr + (8 * c) * 33 + n;
        v4u o; o.x = pk2(s[0 * 33], s[1 * 33]); o.y = pk2(s[2 * 33], s[3 * 33]); o.z = pk2(s[4 * 33], s[5 * 33]); o.w = pk2(s[6 * 33], s[7 * 33]);
        *(v4u*)(WT + (size_t)dst_row<MODE>(n0 + n, up) * K + k0 + 8 * c) = o; }
    asm volatile("s_waitcnt lgkmcnt(0)" ::: "memory");
}
struct Args {
    const float* x; const int* pos; const float *ln_in_g, *ln_in_b, *w_in, *diff_lambda, *diff_norm_g, *conv_w, *mla_q_norm_g, *mla_kv_norm_g, *w_uq, *w_ukv, *w_o, *ln1_g, *ln1_b,
        *ffn_w_gate, *ffn_w_up, *ffn_conv_w, *ffn_w_down, *ln2_g, *ln2_b;
    float* out; unsigned char* ws; int ph_lo, ph_hi;
};
typedef const __attribute__((address_space(4))) Args* ArgP;
__device__ __forceinline__ void convert_weights(ArgP a, int l, unsigned char* ws, LAS float* scr, int gw, int NGW, int lane) {
    constexpr int I_IN = (DM / 64) * (PIN / 32), I_UQ = (CQR / 64) * (NUQ / 32), I_UKV = (CKVR / 64) * (NUKV / 32), I_O = (DM / 64) * (DM / 32), I_G = (DM / 64) * (DFF / 32), I_D = (DFF / 64) * (DM / 32);
    constexpr int NITEMS = I_IN + I_UQ + I_UKV + I_O + 2 * I_G + I_D;
    for (int it = gw; it < NITEMS; it += NGW) {
        int r = it;
        if (r < I_IN) { transpose_item<0>(a->w_in + (size_t)l * DM * PIN, DM, PIN, (bf16*)(ws + WS_WIN), 0, nullptr, scr, r, lane); continue; } r -= I_IN;
        if (r < I_UQ) { transpose_item<0>(a->w_uq + (size_t)l * CQR * NUQ, CQR, NUQ, (bf16*)(ws + WS_WUQ), 0, a->mla_q_norm_g + l * CQR, scr, r, lane); continue; } r -= I_UQ;
        if (r < I_UKV) { transpose_item<2>(a->w_ukv + (size_t)l * CKVR * NUKV, CKVR, NUKV, (bf16*)(ws + WS_WUKV), 0, a->mla_kv_norm_g + l * CKVR, scr, r, lane); continue; } r -= I_UKV;
        if (r < I_O) { transpose_item<0>(a->w_o + (size_t)l * DM * DM, DM, DM, (bf16*)(ws + WS_WO), 0, nullptr, scr, r, lane); continue; } r -= I_O;
        if (r < I_G) { transpose_item<1>(a->ffn_w_gate + (size_t)l * DM * DFF, DM, DFF, (bf16*)(ws + WS_WGU), 0, nullptr, scr, r, lane); continue; } r -= I_G;
        if (r < I_G) { transpose_item<1>(a->ffn_w_up + (size_t)l * DM * DFF, DM, DFF, (bf16*)(ws + WS_WGU), 1, nullptr, scr, r, lane); continue; } r -= I_G;
        transpose_item<0>(a->ffn_w_down + (size_t)l * DFF * DM, DFF, DM, (bf16*)(ws + WS_WDN), 0, nullptr, scr, r, lane);
    }
}
__device__ __forceinline__ void ln_row(const float* xin, float* hout, bf16* hb, const float* __restrict__ g, const float* __restrict__ b, int lane) {
    const f32x4* xr = (const f32x4*)xin + lane;
    f32x4 v[8]; float s = 0.f;
#pragma unroll
    for (int j = 0; j < 8; ++j) { v[j] = xr[64 * j]; s += (v[j].x + v[j].y) + (v[j].z + v[j].w); }
    const float mean = wave_sum(s) * (1.f / DM); float s2 = 0.f;
#pragma unroll
    for (int j = 0; j < 8; ++j) { v[j] = v[j] - mean; s2 += (v[j].x * v[j].x + v[j].y * v[j].y) + (v[j].z * v[j].z + v[j].w * v[j].w); }
    const float rstd = 1.f / sqrtf(wave_sum(s2) * (1.f / DM) + LN_EPS);
    f32x4* ho = (f32x4*)hout + lane; v2u* o8 = (v2u*)hb + lane;
#pragma unroll
    for (int j = 0; j < 8; ++j) { const f32x4 gg = ((const f32x4*)g)[64 * j + lane], bb = ((const f32x4*)b)[64 * j + lane]; const f32x4 y = v[j] * rstd * gg + bb;
        ho[64 * j] = y; v2u w; w.x = pk2(y.x, y.y); w.y = pk2(y.z, y.w); o8[64 * j] = w; }
}
__device__ __forceinline__ void sincos_f32(float x, float& sn, float& cs) {
    const float k = __builtin_rintf(x * 0.636619772f);
    float y = __builtin_fmaf(-k, 1.570796371e+00f, x); y = __builtin_fmaf(-k, -4.371138829e-08f, y);
    const float y2 = y * y;
    float sp = 2.86567956e-6f; sp = sp * y2 - 1.98559923e-4f; sp = sp * y2 + 8.33338592e-3f; sp = sp * y2 - 1.66666672e-1f; const float sy = __builtin_fmaf(y * y2, sp, y);
    float cp = 2.44677067e-5f; cp = cp * y2 - 1.38877297e-3f; cp = cp * y2 + 4.16666567e-2f; cp = cp * y2 - 0.5f; const float cy = __builtin_fmaf(y2, cp, 1.0f);
    const int q = (int)k & 3;
    const float s_ = (q & 1) ? cy : sy, c_ = (q & 1) ? sy : cy;
    sn = (q & 2) ? -s_ : s_; cs = ((q + 1) & 2) ? -c_ : c_;
}
__device__ __forceinline__ float inv_freq16(int j) {
    float v = 1.000000000e+00f;
    v = j == 1 ? 5.623413324e-01f : v; v = j == 2 ? 3.162277639e-01f : v; v = j == 3 ? 1.778279394e-01f : v; v = j == 4 ? 1.000000015e-01f : v; v = j == 5 ? 5.623413250e-02f : v;
    v = j == 6 ? 3.162277490e-02f : v; v = j == 7 ? 1.778279431e-02f : v; v = j == 8 ? 9.999999776e-03f : v; v = j == 9 ? 5.623413250e-03f : v; v = j == 10 ? 3.162277630e-03f : v;
    v = j == 11 ? 1.778279431e-03f : v; v = j == 12 ? 1.000000047e-03f : v; v = j == 13 ? 5.623413017e-04f : v; v = j == 14 ? 3.162277571e-04f : v; v = j == 15 ? 1.778279402e-04f : v;
    return v;
}

#define XB_TMO      128
#define XB_XCNT(j)  (256  + 64 * (j))
#define XB_XSUB(j)  (1280 + 64 * (j))
#define XB_XGEN(j)  (2304 + 64 * (j))
#define XB_TOP      3328
#define XB_TOPGEN   3392
#define XCD_BAR_WORDS 3456
#define XB_SPIN_CAP (1u << 18)

__device__ __forceinline__ unsigned xb_ld(unsigned* p)              { return __hip_atomic_load(p, __ATOMIC_RELAXED, __HIP_MEMORY_SCOPE_AGENT); }
__device__ __forceinline__ unsigned xb_add(unsigned* p, unsigned v) { return __hip_atomic_fetch_add(p, v, __ATOMIC_RELAXED, __HIP_MEMORY_SCOPE_AGENT); }
__device__ __forceinline__ unsigned xb_xcc_id() { return (unsigned)__builtin_amdgcn_s_getreg((3 << 11) | 20) & 0xFu; }
#define XB_SPIN(cond, bar) do { unsigned _sp = 0; while (cond) { __builtin_amdgcn_s_sleep(1); \
    if ((++_sp & 255u) == 0u) { if (xb_ld(&(bar)[XB_TMO])) break; if (_sp > XB_SPIN_CAP) { atomicAdd(&(bar)[XB_TMO], 1u); break; } } } } while (0)

struct XcdBarrier {
    unsigned* bar; unsigned x;
    volatile LAS unsigned* st;
};

__device__ __forceinline__ XcdBarrier xcd_barrier_post(unsigned* bar, volatile LAS unsigned* st) {
    XcdBarrier b; b.bar = bar; b.x = xb_xcc_id(); b.st = st;
    if (threadIdx.x == 0) (void)xb_add(&bar[XB_XCNT(b.x)], 1u);
    return b;
}
__device__ __forceinline__ void xcd_barrier_complete(unsigned* bar, unsigned x, unsigned& nloc, unsigned& nx) {
    const unsigned G = gridDim.x * gridDim.y * gridDim.z;
    unsigned sum, cnt, mine, sp = 0u;
    for (;;) {
        sum = 0u; cnt = 0u; mine = 0u;
#pragma unroll
        for (unsigned j = 0; j < 16; ++j) { const unsigned c = xb_ld(&bar[XB_XCNT(j)]); sum += c; cnt += (c > 0u) ? 1u : 0u; mine = (j == x) ? c : mine; }
        if (sum == G) break;
        __builtin_amdgcn_s_sleep(1);
        if ((++sp & 255u) == 0u) { if (xb_ld(&bar[XB_TMO])) break; if (sp > XB_SPIN_CAP) { atomicAdd(&bar[XB_TMO], 1u); break; } }
    }
    nloc = mine > 0u ? mine : 1u; nx = cnt > 0u ? cnt : 1u;
}

__device__ __forceinline__ void xcd_barrier(const XcdBarrier& b) {
    asm volatile("s_waitcnt vmcnt(0)" ::: "memory");
    __syncthreads();
    if (threadIdx.x == 0) {
        unsigned* bar = b.bar;
        __builtin_amdgcn_s_waitcnt(0);
        unsigned nloc = b.st[0], nx = b.st[1];
        if (nloc == 0u) { xcd_barrier_complete(bar, b.x, nloc, nx); b.st[0] = nloc; b.st[1] = nx; }
        const unsigned old = xb_add(&bar[XB_XSUB(b.x)], 1u);
        const unsigned gen = old / nloc;
        if (old + 1u == (gen + 1u) * nloc) {
            __builtin_amdgcn_fence(__ATOMIC_RELEASE, "agent");
            asm volatile("s_waitcnt vmcnt(0)" ::: "memory");
            const unsigned og = xb_add(&bar[XB_TOP], 1u);
            const unsigned tg = og / nx;
            if (og + 1u == (tg + 1u) * nx) xb_add(&bar[XB_TOPGEN], 1u);
            else XB_SPIN(xb_ld(&bar[XB_TOPGEN]) == tg, bar);
            __builtin_amdgcn_fence(__ATOMIC_ACQUIRE, "agent");
            xb_add(&bar[XB_XGEN(b.x)], 1u);
            asm volatile("s_waitcnt vmcnt(0)" ::: "memory");
        } else {
            XB_SPIN(xb_ld(&bar[XB_XGEN(b.x)]) == gen, bar);
            __builtin_amdgcn_fence(__ATOMIC_ACQUIRE, "agent");
            asm volatile("s_waitcnt vmcnt(0)" ::: "memory");
        }
    }
    __syncthreads();
}

constexpr int CW_BAR = 4096;
__global__ void __launch_bounds__(NWAVES * 64, 2) mk_fwd(Args a) {
    extern __shared__ __attribute__((aligned(16))) unsigned char lds[];
    cg::grid_group grid = cg::this_grid();
    const int G = gridDim.x, NGW = G * NWAVES, NGT = G * NWAVES * 64;
    LAS unsigned char* ldsl = (LAS unsigned char*)lds;
    volatile LAS unsigned* MISC = (volatile LAS unsigned*)(ldsl + MISC_OFF);
    if (threadIdx.x < 32) MISC[threadIdx.x] = 0u;
    __syncthreads();

#ifndef PROBE_SUB
#define PROBE_SUB -1
#endif
    constexpr int NPROG = 1 + 9 * NLAYER + (PROBE_SUB >= 0 ? (PROBE_SUB >= 9 ? 1 : NLAYER) : 0);
    for (int pi = 0; pi < NPROG; ++pi) {
        int ph = pi, rep = 0;
        if (PROBE_SUB >= 9) { if (pi >= 1) { ph = pi - 1; rep = pi == 1; } }
        else if (PROBE_SUB >= 0) { constexpr int p0 = 1 + PROBE_SUB, p1 = 10 + PROBE_SUB;
            if (pi <= p0) ph = pi; else if (pi == p0 + 1) { ph = p0; rep = 1; } else if (pi <= p1 + 1) ph = pi - 1; else if (pi == p1 + 2) { ph = p1; rep = 1; } else ph = pi - 2; }
        ArgP ap = (ArgP)__builtin_amdgcn_kernarg_segment_ptr(); asm volatile("" : "+s"(ap));
        unsigned char* ws = ap->ws;
        float* hres = ap->out;
        bf16* hb = (bf16*)(ws + WS_HB);
        float* posf = (float*)(ws + WS_POSF); float* cost = (float*)(ws + WS_COS); float* sint = (float*)(ws + WS_SIN); float* ssq = (float*)(ws + WS_SSQ);
        unsigned* qctr = (unsigned*)(ws + WS_CTL);
        if (PROBE_SUB == 10 && pi == 1) { for (int e = 0; e < 10; ++e) { XcdBarrier xb_; xb_.bar = qctr + CW_BAR; xb_.x = xb_xcc_id(); xb_.st = MISC + 8; xcd_barrier(xb_); } continue; }
        if (ph == 0 && EN(0)) {
            int tid_ = threadIdx.x; asm volatile("" : "+v"(tid_)); const int tid = tid_, lane = tid & 63, wave = __builtin_amdgcn_readfirstlane(tid >> 6), gw = blockIdx.x * NWAVES + wave, gt = blockIdx.x * (NWAVES * 64) + tid; (void)gt; (void)gw; (void)lane;
            if (blockIdx.x == 0) { if (tid < 4 * NLAYER) __hip_atomic_store(qctr + 64 * tid, 0u, __ATOMIC_RELAXED, __HIP_MEMORY_SCOPE_AGENT);
                for (int i = tid; i < XCD_BAR_WORDS; i += NWAVES * 64) __hip_atomic_store(qctr + CW_BAR + i, 0u, __ATOMIC_RELAXED, __HIP_MEMORY_SCOPE_AGENT); }
            convert_weights(ap, 0, ws, (LAS float*)(ldsl + wave * 16384), gw, NGW, lane);
            for (int m = gw; m < S; m += NGW) ln_row(ap->x + (size_t)m * DM, hres + (size_t)m * DM, hb + (size_t)m * DM, ap->ln_in_g, ap->ln_in_b, lane);
            for (int i = gt; i < S * 16; i += NGT) { const int s = i >> 4, j = i & 15; const float p = (float)ap->pos[s];
                float sn, cs; sincos_f32(p * inv_freq16(j), sn, cs); cost[i] = cs; sint[i] = sn; if (j == 0) posf[s] = p; }
        } else {
            const int l = (ph - 1) / 9, sub = (ph - 1) % 9;
            const float lam_init = l == 0 ? 0.2f : 0.35550906759096927f;
            if (sub == 0 && EN(1)) {
                pg8::Gemm g{hb, (const bf16*)(ws + WS_WIN), S, PINP, DM}; pg8::StaticOrder so; so.init(S, PINP, G, (int)blockIdx.x);
                pg8::EpiProj E{(bf16*)(ws + WS_AQ), (bf16*)(ws + WS_AK), (bf16*)(ws + WS_AV), (bf16*)(ws + WS_BH), (bf16*)(ws + WS_BB), (bf16*)(ws + WS_BC), (bf16*)(ws + WS_CQ), (bf16*)(ws + WS_CKV), (bf16*)(ws + WS_CKR), ssq};
                pg8::gemm_phase<pg8::EpiProj, pg8::StaticOrder, true, true>(ldsl, g, so, E);
            } else if (sub == 1 && EN(2)) {
                int tid_ = threadIdx.x; asm volatile("" : "+v"(tid_)); const int tid = tid_, lane = tid & 63, wave = __builtin_amdgcn_readfirstlane(tid >> 6), gw = blockIdx.x * NWAVES + wave, gt = blockIdx.x * (NWAVES * 64) + tid; (void)gt; (void)gw; (void)lane;
                const bf16* ckr = (const bf16*)(ws + WS_CKR); bf16* km = (bf16*)(ws + WS_KM);
                for (int s0 = gw * 4; s0 < S; s0 += NGW * 4) { const int s = s0 + (lane >> 4), j = lane & 15;
                    const float x1 = bf2f(ckr[s * 32 + j]), x2 = bf2f(ckr[s * 32 + 16 + j]), c = cost[s * 16 + j], sn = sint[s * 16 + j];
                    const unsigned short o1 = (unsigned short)f2bf(x1 * c - x2 * sn), o2 = (unsigned short)f2bf(x2 * c + x1 * sn);
#pragma unroll
                    for (int h = 0; h < 6; ++h) { km[(size_t)s * NUQ + h * 96 + 64 + j] = o1; km[(size_t)s * NUQ + h * 96 + 80 + j] = o2; } }
                { const bf16* Bh = (const bf16*)(ws + WS_BH); const bf16* Bb = (const bf16*)(ws + WS_BB); const bf16* Bc = (const bf16*)(ws + WS_BC); const float* cw = ap->conv_w + (size_t)l * 3 * 512;
                  const int c = lane * 8; float w[3][8];
#pragma unroll
                  for (int i = 0; i < 3; ++i) { const f32x4 u0 = *(const f32x4*)(cw + i * 512 + c), u1 = *(const f32x4*)(cw + i * 512 + c + 4); w[i][0] = u0.x; w[i][1] = u0.y; w[i][2] = u0.z; w[i][3] = u0.w; w[i][4] = u1.x; w[i][5] = u1.y; w[i][6] = u1.z; w[i][7] = u1.w; }
                  for (int t = gw; t < S; t += NGW) {
                      float acc[8] = {0.f, 0.f, 0.f, 0.f, 0.f, 0.f, 0.f, 0.f};
#pragma unroll
                      for (int i = 0; i < 3; ++i) { const int tt = t - 2 + i; if (tt < 0) continue;
                          const v4u hv = *(const v4u*)(Bh + (size_t)tt * 512 + c), cv = *(const v4u*)(Bc + (size_t)tt * 512 + c);
                          acc[0] += w[i][0] * bflo(hv.x) * bflo(cv.x); acc[1] += w[i][1] * bfhi(hv.x) * bfhi(cv.x); acc[2] += w[i][2] * bflo(hv.y) * bflo(cv.y); acc[3] += w[i][3] * bfhi(hv.y) * bfhi(cv.y);
                          acc[4] += w[i][4] * bflo(hv.z) * bflo(cv.z); acc[5] += w[i][5] * bfhi(hv.z) * bfhi(cv.z); acc[6] += w[i][6] * bflo(hv.w) * bflo(cv.w); acc[7] += w[i][7] * bfhi(hv.w) * bfhi(cv.w); }
                      const v4u bv = *(const v4u*)(Bb + (size_t)t * 512 + c); v4u o;
                      o.x = pk2(acc[0] * bflo(bv.x), acc[1] * bfhi(bv.x)); o.y = pk2(acc[2] * bflo(bv.y), acc[3] * bfhi(bv.y)); o.z = pk2(acc[4] * bflo(bv.z), acc[5] * bfhi(bv.z)); o.w = pk2(acc[6] * bflo(bv.w), acc[7] * bfhi(bv.w));
                      *(v4u*)(hb + (size_t)t * DM + 768 + c) = o; } }
                { pg8::Gemm g{(const bf16*)(ws + WS_CQ), (const bf16*)(ws + WS_WUQ), S, NUQP, CQR}; pg8::StaticOrder so; so.init(S, NUQP, G, (int)blockIdx.x);
                  pg8::EpiQm E{(bf16*)(ws + WS_QM), ssq, cost, sint};
                  pg8::gemm_phase<pg8::EpiQm, pg8::StaticOrder, true, true>(ldsl, g, so, E); }
                { pg8::Gemm g{(const bf16*)(ws + WS_CKV), (const bf16*)(ws + WS_WUKV), S, NUKVP, CKVR}; pg8::StaticOrder so; so.init(S, NUKVP, G, (int)blockIdx.x);
                  pg8::EpiKv E{km, (bf16*)(ws + WS_VC), ssq};
                  pg8::gemm_phase<pg8::EpiKv, pg8::StaticOrder, true, true>(ldsl, g, so, E); }
            } else if (sub == 2 && EN(3)) {
                float lam; { const int lane = lane_id_v(); const float* dl = ap->diff_lambda + (size_t)l * 256;
                  lam = __expf(wave_sum(dl[lane] * dl[64 + lane])) - __expf(wave_sum(dl[128 + lane] * dl[192 + lane])) + lam_init; }
                if (!ATT_NO_DIFF) for (;;) {
                    if (threadIdx.x == 0) MISC[0] = __hip_atomic_fetch_add(qctr + 64 * (2 * l + 4 * rep), 1u, __ATOMIC_RELAXED, __HIP_MEMORY_SCOPE_AGENT);
                    __syncthreads(); const unsigned u = MISC[0]; __syncthreads();
                    if (u >= 384u) break;
                    const int qb = 63 - (int)(u / 6u), h = (int)(u % 6u), q0 = qb * 256;
                    att::f32x16 o[4];
                    const float nslope = -LOG2E * __builtin_amdgcn_exp2f(-8.0f * (float)(h + 1) / 6.0f);
                    for (int mp = 0; mp < 2; ++mp) {
                        ATT_CALL_D((LAS char*)ldsl, (const bf16*)(ws + WS_AQ) + h * 128 + mp * 64, 768, (const bf16*)(ws + WS_AK) + h * 128 + mp * 64, 768, (const bf16*)(ws + WS_AV) + h * 128, 768, posf, q0, nslope, o);
                        const int ln2 = lane_id_v(), wv2 = __builtin_amdgcn_readfirstlane(threadIdx.x >> 6);
                        float* st = (float*)(ws + WS_STASH) + (((size_t)blockIdx.x * NWAVES + wv2) * 64 + ln2) * 64;
                        if (mp == 0) {
#pragma unroll
                            for (int d0 = 0; d0 < 4; ++d0)
#pragma unroll
                                for (int r = 0; r < 16; r += 4) *(f32x4*)(st + d0 * 16 + r) = (f32x4){o[d0][r], o[d0][r + 1], o[d0][r + 2], o[d0][r + 3]};
                        } else {
                            asm volatile("s_waitcnt vmcnt(0)" ::: "memory");
#pragma unroll
                            for (int d0 = 0; d0 < 4; ++d0)
#pragma unroll
                                for (int r = 0; r < 16; r += 4) { const f32x4 sv = *(const f32x4*)(st + d0 * 16 + r);
#pragma unroll
                                    for (int i = 0; i < 4; ++i) o[d0][r + i] = sv[i] - lam * o[d0][r + i]; }
                        }
                    }
                    const int ln3 = lane_id_v(), r32 = ln3 & 31, hi = ln3 >> 5, wv3 = __builtin_amdgcn_readfirstlane(threadIdx.x >> 6);
                    const float* dng = ap->diff_norm_g + (size_t)l * 128; float gc[4];
#pragma unroll
                    for (int d0 = 0; d0 < 4; ++d0) gc[d0] = dng[d0 * 32 + r32] * (1.0f - lam_init);
#pragma unroll
                    for (int r = 0; r < 16; ++r) { float ss = (o[0][r] * o[0][r] + o[1][r] * o[1][r]) + (o[2][r] * o[2][r] + o[3][r] * o[3][r]);
                        ss += __shfl_xor(ss, 1); ss += __shfl_xor(ss, 2); ss += __shfl_xor(ss, 4); ss += __shfl_xor(ss, 8); ss += __shfl_xor(ss, 16);
                        const float rs = 1.0f / sqrtf(ss * (1.0f / 128.0f) + RMS_EPS);
#pragma unroll
                        for (int d0 = 0; d0 < 4; ++d0) o[d0][r] *= rs * gc[d0]; }
                    att::store_o_bf16(o, (rep ? (bf16*)(ws + WS_BH) : hb) + (size_t)(q0 + wv3 * 32) * DM + h * 128, DM, r32, hi);
                }
                if (!ATT_NO_MLA) for (;;) {
                    if (threadIdx.x == 0) MISC[0] = __hip_atomic_fetch_add(qctr + 64 * (2 * l + 1 + 4 * rep), 1u, __ATOMIC_RELAXED, __HIP_MEMORY_SCOPE_AGENT);
                    __syncthreads(); const unsigned u = MISC[0]; __syncthreads();
                    if (u >= 384u) break;
                    const int qb = 63 - (int)(u / 6u), h = (int)(u % 6u), q0 = qb * 256;
                    att::f32x16 o[4];
                    ATT_CALL_M((LAS char*)ldsl, (const bf16*)(ws + WS_QM) + h * 96, NUQ, (const bf16*)(ws + WS_KM) + h * 96, NUQ, (const bf16*)(ws + WS_VC) + h * 128, 768, posf, q0, 0.f, o);
                    const int ln3 = lane_id_v(), r32 = ln3 & 31, hi = ln3 >> 5, wv3 = __builtin_amdgcn_readfirstlane(threadIdx.x >> 6);
                    att::store_o_bf16(o, (rep ? (bf16*)(ws + WS_BH) : hb) + (size_t)(q0 + wv3 * 32) * DM + 1280 + h * 128, DM, r32, hi);
                }
            } else if (sub == 3 && EN(4)) {
                pg8::Gemm g{hb, (const bf16*)(ws + WS_WO), S, DM, DM}; pg8::StaticOrder so; so.init(S, DM, G, (int)blockIdx.x);
                pg8::EpiResid E{hres};
                pg8::gemm_phase<pg8::EpiResid, pg8::StaticOrder, true, true>(ldsl, g, so, E);
            } else if ((sub == 4 || sub == 8) && EN(5)) {
                int tid_ = threadIdx.x; asm volatile("" : "+v"(tid_)); const int tid = tid_, lane = tid & 63, wave = __builtin_amdgcn_readfirstlane(tid >> 6), gw = blockIdx.x * NWAVES + wave, gt = blockIdx.x * (NWAVES * 64) + tid; (void)gt; (void)gw; (void)lane;
                const float* g_ = (sub == 4 ? ap->ln1_g : ap->ln2_g) + (size_t)l * DM; const float* b_ = (sub == 4 ? ap->ln1_b : ap->ln2_b) + (size_t)l * DM;
                for (int m = gw; m < S; m += NGW) ln_row(hres + (size_t)m * DM, hres + (size_t)m * DM, hb + (size_t)m * DM, g_, b_, lane);
                if (sub == 8 && l + 1 < NLAYER) convert_weights(ap, l + 1, ws, (LAS float*)(ldsl + wave * 16384), gw, NGW, lane);
            } else if (sub == 5 && EN(6)) {
                pg8::Gemm g{hb, (const bf16*)(ws + WS_WGU), S, 2 * DFF, DM}; pg8::StaticOrder so; so.init(S, 2 * DFF, G, (int)blockIdx.x);
                pg8::EpiGateUp E{(bf16*)(ws + WS_A), ap->ffn_conv_w + (size_t)l * 3 * DFF, (float*)(ws + WS_GS), (float*)(ws + WS_US)};
                pg8::gemm_phase<pg8::EpiGateUp, pg8::StaticOrder, true, true>(ldsl, g, so, E);
            } else if (sub == 6 && EN(7)) {
                int tid_ = threadIdx.x; asm volatile("" : "+v"(tid_)); const int tid = tid_, lane = tid & 63, wave = __builtin_amdgcn_readfirstlane(tid >> 6), gw = blockIdx.x * NWAVES + wave, gt = blockIdx.x * (NWAVES * 64) + tid; (void)gt; (void)gw; (void)lane;
                const float* cw = ap->ffn_conv_w + (size_t)l * 3 * DFF; const float* GS = (const float*)(ws + WS_GS); const float* US = (const float*)(ws + WS_US); bf16* A = (bf16*)(ws + WS_A);
                for (int i = gt; i < (S / 64) * DFF; i += NGT) { const int span = i / DFF, ch = i - span * DFF;
                    const float gm2 = span ? GS[((size_t)(span - 1) * 4 + 2) * DFF + ch] : 0.f, gm1 = span ? GS[((size_t)(span - 1) * 4 + 3) * DFF + ch] : 0.f;
                    const float g0 = GS[((size_t)span * 4 + 0) * DFF + ch], g1 = GS[((size_t)span * 4 + 1) * DFF + ch], u0 = US[((size_t)span * 2 + 0) * DFF + ch], u1 = US[((size_t)span * 2 + 1) * DFF + ch];
                    const float w0 = cw[ch], w1 = cw[DFF + ch], w2 = cw[2 * DFF + ch];
                    const float c0 = w0 * gm2 + w1 * gm1 + w2 * g0, c1 = w0 * gm1 + w1 * g0 + w2 * g1;
                    A[(size_t)(span * 64) * DFF + ch] = (bf16)f2bf(c0 * u0 / (1.0f + __expf(-c0)));
                    A[(size_t)(span * 64 + 1) * DFF + ch] = (bf16)f2bf(c1 * u1 / (1.0f + __expf(-c1))); }
            } else if (sub == 7 && EN(8)) {
                pg8::Gemm g{(const bf16*)(ws + WS_A), (const bf16*)(ws + WS_WDN), S, DM, DFF}; pg8::StaticOrder so; so.init(S, DM, G, (int)blockIdx.x);
                pg8::EpiResid E{hres};
                pg8::gemm_phase<pg8::EpiResid, pg8::StaticOrder, true, true>(ldsl, g, so, E);
            }
        }
        if (pi + 1 < NPROG) {
            if (pi == 0) { grid.sync(); (void)xcd_barrier_post(qctr + CW_BAR, MISC + 8); }
            else { XcdBarrier xb_; xb_.bar = qctr + CW_BAR; xb_.x = xb_xcc_id(); xb_.st = MISC + 8; xcd_barrier(xb_); }
        }
    }
}

extern "C" void kernel_launch(void* const* d_in, const int* in_sizes, int n_in, void* d_out, int out_size, void* d_ws, size_t ws_size, hipStream_t stream) {
    static int grid = 0;
    if (grid == 0) {
        if (n_in != 21 || in_sizes[0] != S * DM || out_size != S * DM || ws_size < WS_END) { fprintf(stderr, "kernel_launch: unexpected shapes (n_in %d, in0 %d, out %d, ws %zu < %zu)\n", n_in, n_in > 0 ? in_sizes[0] : -1, out_size, ws_size, (size_t)WS_END); grid = -1; return; }
        int dev = 0, cus = 0, per_cu = 0;
        if (hipGetDevice(&dev) != hipSuccess || hipDeviceGetAttribute(&cus, hipDeviceAttributeMultiprocessorCount, dev) != hipSuccess) { grid = -1; return; }
        if (hipFuncSetAttribute((const void*)mk_fwd, hipFuncAttributeMaxDynamicSharedMemorySize, LDS_BYTES) != hipSuccess) { fprintf(stderr, "kernel_launch: hipFuncSetAttribute failed\n"); grid = -1; return; }
        if (hipOccupancyMaxActiveBlocksPerMultiprocessor(&per_cu, (const void*)mk_fwd, NWAVES * 64, LDS_BYTES) != hipSuccess || per_cu < 1) { fprintf(stderr, "kernel_launch: occupancy query says %d\n", per_cu); per_cu = 1; }
        (void)hipGetLastError();
        grid = cus * per_cu;
    }
    if (grid < 0) return;
    Args a{};
    a.x = (const float*)d_in[0]; a.pos = (const int*)d_in[1]; a.ln_in_g = (const float*)d_in[2]; a.ln_in_b = (const float*)d_in[3]; a.w_in = (const float*)d_in[4]; a.diff_lambda = (const float*)d_in[5];
    a.diff_norm_g = (const float*)d_in[6]; a.conv_w = (const float*)d_in[7]; a.mla_q_norm_g = (const float*)d_in[8]; a.mla_kv_norm_g = (const float*)d_in[9]; a.w_uq = (const float*)d_in[10]; a.w_ukv = (const float*)d_in[11];
    a.w_o = (const float*)d_in[12]; a.ln1_g = (const float*)d_in[13]; a.ln1_b = (const float*)d_in[14]; a.ffn_w_gate = (const float*)d_in[15]; a.ffn_w_up = (const float*)d_in[16]; a.ffn_conv_w = (const float*)d_in[17];
    a.ffn_w_down = (const float*)d_in[18]; a.ln2_g = (const float*)d_in[19]; a.ln2_b = (const float*)d_in[20];
    a.out = (float*)d_out; a.ws = (unsigned char*)d_ws; a.ph_lo = 0; a.ph_hi = 1 + 9 * NLAYER;
    void* args[] = {&a};
    const hipError_t e = hipLaunchCooperativeKernel((const void*)mk_fwd, dim3(grid), dim3(NWAVES * 64), args, LDS_BYTES, stream);
    if (e != hipSuccess) fprintf(stderr, "kernel_launch: cooperative launch failed: %s (grid %d)\n", hipGetErrorString(e), grid);
}
```

```cpp
#define PROBE_SUB -1
#define PROBE_VAR 0
#define PROBE_TSEC 0
#define PROBE_WAVE 0
#include <hip/hip_runtime.h>
#include <hip/hip_cooperative_groups.h>
#include <cstdio>
#include <cstdint>
namespace cg = cooperative_groups;

constexpr int S = 16384, DM = 2048, NLAYER = 2, PIN = 4640, PINP = 4864, DFF = 5632;
constexpr int CQR = 512, CKVR = 256, NUQ = 576, NUQP = 768, NUKV = 1152, NUKVP = 1280;
constexpr float LN_EPS = 1e-5f, RMS_EPS = 1e-6f;
constexpr float ALPHA_DN = 1.4142135623730951f;
constexpr float LOG2E = 1.4426950408889634f;
constexpr float QSCALE_A = 0.125f * LOG2E;
constexpr float QSCALE_C = 0.10206207261596577f * LOG2E;
__device__ __forceinline__ int lane_id_v() { int l; asm volatile("v_mbcnt_lo_u32_b32 %0, -1, 0\n\tv_mbcnt_hi_u32_b32 %0, -1, %0" : "=v"(l)); return l; }
__device__ __forceinline__ float bperm_f(int src_lane, float v) { return __builtin_bit_cast(float, __builtin_amdgcn_ds_bpermute(src_lane << 2, __builtin_bit_cast(int, v))); }
namespace pg8 {
#define PG8_LAS __attribute__((address_space(3)))
typedef unsigned short bf16_t;
typedef short bf16x8 __attribute__((ext_vector_type(8)));
typedef float f32x4 __attribute__((ext_vector_type(4)));
typedef unsigned u32x4 __attribute__((ext_vector_type(4)));
constexpr int BM = 256, BK = 64, HALF = 128, HTB = HALF * BK * 2  , STAGE_BYTES = 8 * HTB, NXCD = 8, WGM = 8;

__host__ __device__ __forceinline__ int lds_byte(int r, int c) { const int st = (r >> 4) * 2 + (c >> 5), rr = r & 15, cc = c & 31, ob = rr * 64 + cc * 2; return st * 1024 + (ob ^ (((ob >> 9) & 1) << 5)); }
__host__ __device__ __forceinline__ void stage_rc(int b, int& R, int& C) { const int st = b / 1024, sb = b % 1024, swz = sb ^ (((sb >> 9) & 1) << 5); R = (st >> 1) * 16 + swz / 64; C = (st & 1) * 32 + (swz % 64) / 2; }
__host__ __device__ __forceinline__ int perm32(int rho) { const int n = rho >> 4, i = rho & 15; return 8 * (i >> 2) + 4 * n + (i & 3); }

struct Unit { int pm, pn; };
struct Gemm { const bf16_t* A; const bf16_t* Bt; int M, N, K; };

struct StaticOrder {
    int nM, nN, nwg, G, c;
    __host__ __device__ void init(int M, int N, int G_, int c_) { nM = M / BM; nN = N / BM; nwg = nM * nN; G = G_; c = c_; }
    __host__ __device__ bool next(int i, Unit& u) const {
        const long L = (long)i * G + c; if (L >= nwg) return false;
        int wgid = (int)L; { const int q = nwg / NXCD, r = nwg % NXCD, xcd = wgid % NXCD, off = wgid / NXCD; wgid = (xcd < r ? xcd * (q + 1) : r * (q + 1) + (xcd - r) * q) + off; }
        const int nig = WGM * nN, gid = wgid / nig, fm = gid * WGM, gsz = (nM - fm) < WGM ? (nM - fm) : WGM;
        u.pm = fm + ((wgid % nig) % gsz); u.pn = (wgid % nig) / gsz; return true;
    }
    __device__ __forceinline__ void a_ready(const Unit&) const {}
    __device__ __forceinline__ void done(const Unit&) const {}
};

__device__ __forceinline__ unsigned cvt_pk_bf16(float lo, float hi) { unsigned r; asm volatile("v_cvt_pk_bf16_f32 %0, %1, %2" : "=v"(r) : "v"(lo), "v"(hi)); return r; }
typedef float f32x2 __attribute__((ext_vector_type(2)));
template <class Epi, class Sched, bool ALIGN_EPI = false, bool SP2 = false>
__device__ __forceinline__ void gemm_phase(PG8_LAS unsigned char* lds, const Gemm g, const Sched& S, const Epi& E) {
    int tid_ = threadIdx.x; asm volatile("" : "+v"(tid_));
    const int tid = tid_, wid = __builtin_amdgcn_readfirstlane(tid >> 6), lane = tid & 63, wr = wid >> 2, wc = wid & 3, fr = lane & 15, fq = lane >> 4;
    const int K = g.K, nt = K / BK;
    unsigned voffA[2], voffB[2];
#pragma unroll
    for (int i = 0; i < 2; ++i) { int R, C; stage_rc(tid * 16 + i * 8192, R, C); const int Rb = Epi::PERM ? ((R & ~31) + perm32(R & 31)) : R;
        voffA[i] = (unsigned)(R * K + C) * 2u; voffB[i] = (unsigned)(Rb * K + C) * 2u; }
    const size_t kstep = (size_t)(BK * 2);
    const size_t hstep = (size_t)HALF * K * 2;
    const size_t tstep = 2 * hstep;
    const unsigned ldsw = (unsigned)wid * 1024u;
    const int aoff = lds_byte(wr * 64 + fr, fq * 8), boff = lds_byte(wc * 32 + fr, fq * 8);
#define PG8_SA(b, h) (((b) * 2 + (h)) * HTB)
#define PG8_SB(b, h) ((4 + (b) * 2 + (h)) * HTB)
#define PG8_STAGE(bufoff, gbase, voff) do { _Pragma("unroll") for (int _i = 0; _i < 2; ++_i) \
        __builtin_amdgcn_global_load_lds((const unsigned*)((const char*)(gbase) + (voff)[_i]), (PG8_LAS unsigned*)(lds + (bufoff) + ldsw + _i * 8192), 16, 0, 0); } while (0)
#define PG8_LDA(dst, b, h) do { _Pragma("unroll") for (int m = 0; m < 4; ++m) _Pragma("unroll") for (int k = 0; k < 2; ++k) dst[m][k] = *(const PG8_LAS bf16x8*)(lds + PG8_SA(b, h) + aoff + m * 2048 + k * 1024); } while (0)
#define PG8_LDB(dst, b, h) do { _Pragma("unroll") for (int n = 0; n < 2; ++n) _Pragma("unroll") for (int k = 0; k < 2; ++k) dst[n][k] = *(const PG8_LAS bf16x8*)(lds + PG8_SB(b, h) + boff + n * 2048 + k * 1024); } while (0)
#define PG8_MMA(ai, bj, At, Bt) do { __builtin_amdgcn_s_setprio(1); _Pragma("unroll") for (int m = 0; m < 4; ++m) _Pragma("unroll") for (int n = 0; n < 2; ++n) _Pragma("unroll") for (int k = 0; k < 2; ++k) \
        acc[ai][bj][m][n] = __builtin_amdgcn_mfma_f32_16x16x32_bf16(Bt[n][k], At[m][k], acc[ai][bj][m][n], 0, 0, 0); __builtin_amdgcn_s_setprio(0); } while (0)
#define PG8_WAIT_V(n) asm volatile("s_waitcnt vmcnt(" #n ")" ::: "memory")
#define PG8_WAIT_L(n) asm volatile("s_waitcnt lgkmcnt(" #n ")" ::: "memory")
#define PG8_BAR __builtin_amdgcn_s_barrier()
#define PG8_SCHED __builtin_amdgcn_sched_barrier(0)
    Unit cur, nxt; int ui = 0;
    if (!S.next(0, cur)) return;
    f32x4 acc[2][2][4][2];
#pragma unroll
    for (int a = 0; a < 2; ++a)
#pragma unroll
        for (int b = 0; b < 2; ++b)
#pragma unroll
            for (int m = 0; m < 4; ++m)
#pragma unroll
                for (int n = 0; n < 2; ++n) acc[a][b][m][n] = (f32x4){0.f, 0.f, 0.f, 0.f};
    bf16x8 At[4][2], B0[2][2], B1[2][2];
    const char* cA = (const char*)g.A + (size_t)cur.pm * tstep; const char* cB = (const char*)g.Bt + (size_t)cur.pn * tstep;
    S.a_ready(cur);
    if constexpr (SP2) {
        PG8_STAGE(PG8_SB(0, 0), cB, voffB); PG8_STAGE(PG8_SB(0, 1), cB + hstep, voffB); PG8_STAGE(PG8_SA(0, 0), cA, voffA); PG8_STAGE(PG8_SA(0, 1), cA + hstep, voffA);
        if (wr == 1) PG8_BAR;
        PG8_WAIT_V(2); PG8_BAR;
        PG8_STAGE(PG8_SB(1, 0), cB + kstep, voffB); PG8_STAGE(PG8_SA(1, 0), cA + kstep, voffA); PG8_STAGE(PG8_SB(1, 1), cB + hstep + kstep, voffB);
        PG8_WAIT_V(6); PG8_BAR;
    } else {
        PG8_STAGE(PG8_SB(0, 0), cB, voffB); PG8_STAGE(PG8_SA(0, 0), cA, voffA); PG8_STAGE(PG8_SB(0, 1), cB + hstep, voffB); PG8_STAGE(PG8_SA(0, 1), cA + hstep, voffA);
        if (wr == 1) PG8_BAR;
        PG8_WAIT_V(4); PG8_BAR;
        PG8_STAGE(PG8_SB(1, 0), cB + kstep, voffB); PG8_STAGE(PG8_SA(1, 0), cA + kstep, voffA); PG8_STAGE(PG8_SB(1, 1), cB + hstep + kstep, voffB);
        PG8_WAIT_V(6); PG8_BAR;
    }
    for (;;) {
        const bool has_next = S.next(ui + 1, nxt);
        const char* nA = has_next ? (const char*)g.A + (size_t)nxt.pm * tstep : cA; const char* nB = has_next ? (const char*)g.Bt + (size_t)nxt.pn * tstep : cB;
        for (int t = 0; t < nt; t += 2) {
            const bool last = (t == nt - 2);
            const char* a1 = cA + (size_t)(t + 1) * kstep;
            const char* a2 = last ? nA : cA + (size_t)(t + 2) * kstep; const char* b2 = last ? nB : cB + (size_t)(t + 2) * kstep;
            const char* a3 = a2 + kstep; const char* b3 = b2 + kstep;
            if (last && has_next) S.a_ready(nxt);
            if constexpr (SP2) {
            PG8_LDB(B0, 0, 0); PG8_LDB(B1, 0, 1); PG8_SCHED; PG8_LDA(At, 0, 0); PG8_STAGE(PG8_SA(1, 1), a1 + hstep, voffA);
            PG8_WAIT_V(8); PG8_WAIT_L(0); PG8_BAR; PG8_MMA(0, 0, At, B0); PG8_MMA(0, 1, At, B1); PG8_BAR; PG8_SCHED;
            PG8_LDA(At, 0, 1); PG8_STAGE(PG8_SB(0, 0), b2, voffB); PG8_STAGE(PG8_SB(0, 1), b2 + hstep, voffB); PG8_STAGE(PG8_SA(0, 0), a2, voffA);
            PG8_WAIT_V(8); PG8_WAIT_L(0); PG8_BAR; PG8_MMA(1, 0, At, B0); PG8_MMA(1, 1, At, B1); PG8_BAR; PG8_SCHED;
            PG8_LDB(B0, 1, 0); PG8_LDB(B1, 1, 1); PG8_SCHED; PG8_LDA(At, 1, 0); PG8_STAGE(PG8_SA(0, 1), a2 + hstep, voffA);
            PG8_WAIT_V(8); PG8_WAIT_L(0); PG8_BAR; PG8_MMA(0, 0, At, B0); PG8_MMA(0, 1, At, B1); PG8_BAR; PG8_SCHED;
            PG8_LDA(At, 1, 1); PG8_STAGE(PG8_SB(1, 0), b3, voffB); PG8_STAGE(PG8_SB(1, 1), b3 + hstep, voffB); PG8_STAGE(PG8_SA(1, 0), a3, voffA);
            PG8_WAIT_V(8); PG8_WAIT_L(0); PG8_BAR; PG8_MMA(1, 0, At, B0); PG8_MMA(1, 1, At, B1); PG8_BAR; PG8_SCHED;
            } else {
            PG8_LDB(B0, 0, 0); PG8_SCHED; PG8_LDA(At, 0, 0); PG8_STAGE(PG8_SA(1, 1), a1 + hstep, voffA);
            PG8_WAIT_L(8); PG8_BAR; PG8_WAIT_L(0); PG8_MMA(0, 0, At, B0); PG8_BAR; PG8_SCHED;
            PG8_LDB(B1, 0, 1); PG8_STAGE(PG8_SB(0, 0), b2, voffB);
            PG8_BAR; PG8_WAIT_L(0); PG8_MMA(0, 1, At, B1); PG8_BAR;
            PG8_LDA(At, 0, 1); PG8_STAGE(PG8_SA(0, 0), a2, voffA);
            PG8_BAR; PG8_WAIT_L(0); PG8_MMA(1, 0, At, B0); PG8_BAR; PG8_SCHED;
            PG8_STAGE(PG8_SB(0, 1), b2 + hstep, voffB);
            PG8_WAIT_V(6); PG8_BAR; PG8_MMA(1, 1, At, B1); PG8_BAR;
            PG8_LDB(B0, 1, 0); PG8_SCHED; PG8_LDA(At, 1, 0); PG8_STAGE(PG8_SA(0, 1), a2 + hstep, voffA);
            PG8_WAIT_L(8); PG8_BAR; PG8_WAIT_L(0); PG8_MMA(0, 0, At, B0); PG8_BAR; PG8_SCHED;
            PG8_LDB(B1, 1, 1); PG8_STAGE(PG8_SB(1, 0), b3, voffB);
            PG8_BAR; PG8_WAIT_L(0); PG8_MMA(0, 1, At, B1); PG8_BAR;
            PG8_LDA(At, 1, 1); PG8_STAGE(PG8_SA(1, 0), a3, voffA);
            PG8_BAR; PG8_WAIT_L(0); PG8_MMA(1, 0, At, B0); PG8_BAR; PG8_SCHED;
            PG8_STAGE(PG8_SB(1, 1), b3 + hstep, voffB);
            PG8_WAIT_V(6); PG8_BAR; PG8_MMA(1, 1, At, B1); PG8_BAR;
            }
        }
        if constexpr (ALIGN_EPI) { if (wr == 0) PG8_BAR; }
        if constexpr (!Epi::AFTER_DRAIN) { E(acc, cur, wr, wc, fr, fq); S.done(cur); }
        if (!has_next) break;
#pragma unroll
        for (int a = 0; a < 2; ++a)
#pragma unroll
            for (int b = 0; b < 2; ++b)
#pragma unroll
                for (int m = 0; m < 4; ++m)
#pragma unroll
                    for (int n = 0; n < 2; ++n) acc[a][b][m][n] = (f32x4){0.f, 0.f, 0.f, 0.f};
        cur = nxt; cA = nA; cB = nB; ++ui;
        if constexpr (ALIGN_EPI) { if (wr == 1) PG8_BAR; }
    }
    PG8_WAIT_V(0);
    if constexpr (!ALIGN_EPI) { if (wr == 0) PG8_BAR; }
    PG8_BAR;
    if constexpr (Epi::AFTER_DRAIN) { E.fused(acc, cur, wr, wc, fr, fq, lds, wid, lane); S.done(cur); }
#undef PG8_SA
#undef PG8_SB
#undef PG8_STAGE
#undef PG8_LDA
#undef PG8_LDB
#undef PG8_MMA
#undef PG8_WAIT_V
#undef PG8_WAIT_L
#undef PG8_BAR
#undef PG8_SCHED
}
}

namespace pg8 {
__device__ __forceinline__ u32x4 pack8(const f32x4 a, const f32x4 b, float sc) {
    u32x4 w; w.x = cvt_pk_bf16(a[0] * sc, a[1] * sc); w.y = cvt_pk_bf16(a[2] * sc, a[3] * sc); w.z = cvt_pk_bf16(b[0] * sc, b[1] * sc); w.w = cvt_pk_bf16(b[2] * sc, b[3] * sc); return w;
}
struct EpiProj {
    static constexpr bool PERM = true, AFTER_DRAIN = false;
    bf16_t *Aq, *Ak, *Av, *Bh, *Bb, *Bc, *cq, *ckv, *ckr; float* ssq;
    __device__ __forceinline__ void operator()(const f32x4 (&acc)[2][2][4][2], const Unit& u, int wr, int wc, int fr_, int fq_) const {
        const int ln_ = lane_id_v(), fr = ln_ & 15, fq = ln_ >> 4; (void)fr_; (void)fq_;
        const int pn = u.pn; bf16_t* base; int ldc, colt, ssqi = -1, valid = 256; float sc = 1.f;
        if (pn < 3) { base = Aq; ldc = 768; colt = pn * 256; sc = QSCALE_A; }
        else if (pn < 6) { base = Ak; ldc = 768; colt = (pn - 3) * 256; }
        else if (pn < 9) { base = Av; ldc = 768; colt = (pn - 6) * 256; }
        else if (pn < 11) { base = Bh; ldc = 512; colt = (pn - 9) * 256; }
        else if (pn < 13) { base = Bb; ldc = 512; colt = (pn - 11) * 256; }
        else if (pn < 15) { base = Bc; ldc = 512; colt = (pn - 13) * 256; }
        else if (pn < 17) { base = cq; ldc = 512; colt = (pn - 15) * 256; ssqi = (pn - 15) * 4 + wc; }
        else if (pn < 18) { base = ckv; ldc = 256; colt = 0; ssqi = 8 + wc; }
        else { base = ckr; ldc = 32; colt = 0; valid = 32; }
        const int row0 = u.pm * BM + wr * 64 + fr, cl = wc * 32 + 8 * fq;
#pragma unroll
        for (int ai = 0; ai < 2; ++ai)
#pragma unroll
            for (int m = 0; m < 4; ++m) {
                const int row = row0 + ai * HALF + m * 16; bf16_t* rowp = base + (size_t)row * ldc + colt + cl;
                float q = 0.f;
#pragma unroll
                for (int bj = 0; bj < 2; ++bj) {
                    const f32x4 v0 = acc[ai][bj][m][0], v1 = acc[ai][bj][m][1];
                    q += (v0[0] * v0[0] + v0[1] * v0[1]) + (v0[2] * v0[2] + v0[3] * v0[3]) + (v1[0] * v1[0] + v1[1] * v1[1]) + (v1[2] * v1[2] + v1[3] * v1[3]);
                    if (cl + bj * HALF < valid) *(u32x4*)(rowp + bj * HALF) = pack8(v0, v1, sc);
                }
                if (ssqi >= 0) { q += bperm_f(ln_ ^ 16, q); q += bperm_f(ln_ ^ 32, q); if (fq == 0) ssq[(size_t)row * 12 + ssqi] = q; }
            }
    }
};
struct EpiQm {
    static constexpr bool PERM = true, AFTER_DRAIN = false;
    bf16_t* qm; const float* ssq; const float* cost; const float* sint;
    __device__ __forceinline__ void operator()(const f32x4 (&acc)[2][2][4][2], const Unit& u, int wr, int wc, int fr_, int fq_) const {
        const int ln_ = lane_id_v(), fr = ln_ & 15, fq = ln_ >> 4; (void)fr_; (void)fq_;
        const int row0 = u.pm * BM + wr * 64 + fr;
#pragma unroll
        for (int ai = 0; ai < 2; ++ai)
#pragma unroll
            for (int m = 0; m < 4; ++m) {
                const int row = row0 + ai * HALF + m * 16;
                const f32x4 s0 = *(const f32x4*)(ssq + (size_t)row * 12), s1 = *(const f32x4*)(ssq + (size_t)row * 12 + 4);
                const float rq = 1.0f / sqrtf((((s0[0] + s0[1]) + (s0[2] + s0[3])) + ((s1[0] + s1[1]) + (s1[2] + s1[3]))) * (1.0f / CQR) + RMS_EPS);
#pragma unroll
                for (int bj = 0; bj < 2; ++bj) {
                    const int g32 = u.pn * 8 + bj * 4 + wc;
                    if (g32 >= NUQ / 32) continue;
                    f32x4 v0 = acc[ai][bj][m][0] * rq, v1 = acc[ai][bj][m][1] * rq;
                    if (g32 % 3 == 2) {
                        f32x4 p0, p1;
#pragma unroll
                        for (int i = 0; i < 4; ++i) { p0[i] = bperm_f(ln_ ^ 32, v0[i]); p1[i] = bperm_f(ln_ ^ 32, v1[i]); }
                        const int j0 = (fq & 1) * 8;
                        const f32x4 c0 = *(const f32x4*)(cost + (size_t)row * 16 + j0), c1 = *(const f32x4*)(cost + (size_t)row * 16 + j0 + 4);
                        f32x4 n0 = *(const f32x4*)(sint + (size_t)row * 16 + j0), n1 = *(const f32x4*)(sint + (size_t)row * 16 + j0 + 4);
                        if (fq < 2) { n0 = -n0; n1 = -n1; }
                        v0 = v0 * c0 + p0 * n0; v1 = v1 * c1 + p1 * n1;
                    }
                    *(u32x4*)(qm + (size_t)row * NUQ + g32 * 32 + 8 * fq) = pack8(v0, v1, QSCALE_C);
                }
            }
    }
};
struct EpiKv {
    static constexpr bool PERM = true, AFTER_DRAIN = false;
    bf16_t* km; bf16_t* vc; const float* ssq;
    __device__ __forceinline__ void operator()(const f32x4 (&acc)[2][2][4][2], const Unit& u, int wr, int wc, int fr_, int fq_) const {
        const int ln_ = lane_id_v(), fr = ln_ & 15, fq = ln_ >> 4; (void)fr_; (void)fq_;
        const int row0 = u.pm * BM + wr * 64 + fr;
#pragma unroll
        for (int ai = 0; ai < 2; ++ai)
#pragma unroll
            for (int m = 0; m < 4; ++m) {
                const int row = row0 + ai * HALF + m * 16;
                const f32x4 s0 = *(const f32x4*)(ssq + (size_t)row * 12 + 8);
                const float rk = 1.0f / sqrtf(((s0[0] + s0[1]) + (s0[2] + s0[3])) * (1.0f / CKVR) + RMS_EPS);
#pragma unroll
                for (int bj = 0; bj < 2; ++bj) {
                    const int c8 = u.pn * 256 + bj * HALF + wc * 32 + 8 * fq;
                    if (c8 >= NUKV) continue;
                    bf16_t* dst = (c8 < 384) ? km + (size_t)row * NUQ + (c8 >> 6) * 96 + (c8 & 63) : vc + (size_t)row * 768 + (c8 - 384);
                    *(u32x4*)dst = pack8(acc[ai][bj][m][0], acc[ai][bj][m][1], rk);
                }
            }
    }
};
struct EpiResid {
    static constexpr bool PERM = false, AFTER_DRAIN = false;
    const float* src; float* out; const float* rs; const float* g; const float* b;
    __device__ __forceinline__ void operator()(const f32x4 (&acc)[2][2][4][2], const Unit& u, int wr, int wc, int fr_, int fq_) const {
        const int ln_ = lane_id_v(), fr = ln_ & 15, fq = ln_ >> 4; (void)fr_; (void)fq_;
        const int row0 = u.pm * BM + wr * 64 + fr, col0 = u.pn * BM + wc * 32 + 4 * fq;
#pragma unroll
        for (int bj = 0; bj < 2; ++bj)
#pragma unroll
            for (int n = 0; n < 2; ++n) {
                const int col = col0 + bj * HALF + n * 16;
                const f32x4 gv = *(const f32x4*)(g + col), bv = *(const f32x4*)(b + col);
#pragma unroll
                for (int ai = 0; ai < 2; ++ai)
#pragma unroll
                    for (int m = 0; m < 4; ++m) {
                        const size_t row = (size_t)(row0 + ai * HALF + m * 16);
                        const f32x4 t = *(const f32x4*)(src + row * DM + col); const f32x2 st = *(const f32x2*)(rs + row * 2);
                        const f32x4 h = (t - st.x) * st.y * gv + bv;
                        *(f32x4*)(out + row * DM + col) = h * ALPHA_DN + acc[ai][bj][m][n];
                    }
                asm volatile("" ::: "memory");
            }
    }
};
struct EpiGateUp {
    static constexpr bool PERM = true, AFTER_DRAIN = false;
    bf16_t* a; const float* cw; float* GS; float* US;
    __device__ __forceinline__ void operator()(const f32x4 (&acc)[2][2][4][2], const Unit& u, int wr, int wc, int fr_, int fq_) const {
        const int ln_ = lane_id_v(), fr = ln_ & 15, fq = ln_ >> 4; (void)fr_; (void)fq_;
        const int ch0 = u.pn * 128 + wc * 32 + 8 * fq, lane = fq * 16 + fr;
        const int src1 = (lane & 48) | ((fr - 1) & 15), src2 = (lane & 48) | ((fr - 2) & 15);
        f32x4 w0[2], w1[2], w2[2];
#pragma unroll
        for (int n = 0; n < 2; ++n) { w0[n] = *(const f32x4*)(cw + ch0 + 4 * n); w1[n] = *(const f32x4*)(cw + DFF + ch0 + 4 * n); w2[n] = *(const f32x4*)(cw + 2 * DFF + ch0 + 4 * n); }
#pragma unroll
        for (int ai = 0; ai < 2; ++ai) {
            const int span = u.pm * 4 + ai * 2 + wr;
            f32x4 q1[2] = {(f32x4){0.f, 0.f, 0.f, 0.f}, (f32x4){0.f, 0.f, 0.f, 0.f}}, q2[2] = {(f32x4){0.f, 0.f, 0.f, 0.f}, (f32x4){0.f, 0.f, 0.f, 0.f}};
#pragma unroll
            for (int m = 0; m < 4; ++m) {
                f32x4 o[2];
#pragma unroll
                for (int n = 0; n < 2; ++n) {
                    const f32x4 g = acc[ai][0][m][n], up = acc[ai][1][m][n]; f32x4 s1, s2;
#pragma unroll
                    for (int i = 0; i < 4; ++i) { s1[i] = bperm_f(src1, g[i]); s2[i] = bperm_f(src2, g[i]); }
                    f32x4 p1, p2;
#pragma unroll
                    for (int i = 0; i < 4; ++i) { p1[i] = fr >= 1 ? s1[i] : q1[n][i]; p2[i] = fr >= 2 ? s2[i] : q2[n][i]; }
                    q1[n] = s1; q2[n] = s2;
                    const f32x4 cv = w0[n] * p2 + w1[n] * p1 + w2[n] * g;
#pragma unroll
                    for (int i = 0; i < 4; ++i) o[n][i] = cv[i] * up[i] * __builtin_amdgcn_rcpf(1.0f + __builtin_amdgcn_exp2f(-LOG2E * cv[i]));
                    if (m == 0 && fr < 2) { *(f32x4*)(GS + ((size_t)span * 4 + fr) * DFF + ch0 + 4 * n) = g; *(f32x4*)(US + ((size_t)span * 2 + fr) * DFF + ch0 + 4 * n) = up; }
                    if (m == 3 && fr >= 14) *(f32x4*)(GS + ((size_t)span * 4 + fr - 12) * DFF + ch0 + 4 * n) = g;
                }
                const int row = u.pm * BM + ai * HALF + wr * 64 + m * 16 + fr;
                *(u32x4*)(a + (size_t)row * DFF + ch0) = pack8(o[0], o[1], 1.0f);
            }
        }
    }
};
}

namespace att {
typedef unsigned short bf16_t;
typedef short bf16x8 __attribute__((ext_vector_type(8)));
typedef short s16x4 __attribute__((ext_vector_type(4)));
typedef float f32x16 __attribute__((ext_vector_type(16)));
typedef float f32x4 __attribute__((ext_vector_type(4)));
typedef unsigned u32x4 __attribute__((ext_vector_type(4)));
#define SBAR() __builtin_amdgcn_sched_barrier(0)
#define ALAS __attribute__((address_space(3)))
constexpr int SHM_V = 64 * 128 * 2, SHM_KMAX = 64 * (96 * 2 + 16);
constexpr int L_V = 0, L_K = 2 * SHM_V, L_POS = L_K + 2 * SHM_KMAX, L_WS = L_POS + 2 * 80 * 4, L_XCH = L_WS + 8 * 64 * 4, L_END = L_XCH + 8 * 2 * 4;
#ifndef PROBE_TSEC
#define PROBE_TSEC 0
#endif
#ifndef PROBE_WAVE
#define PROBE_WAVE 0
#endif
constexpr float THR = 8.f;
constexpr int S_TMAX_OFF = 16384, S_PMAX_OFF = 16384 + 256;
constexpr float SKIP_T = 32.f;
__device__ __forceinline__ int v_st(int k, int c) { const int kk = (k & ~0xC) | ((k & 4) << 1) | ((k & 8) >> 1); return ((kk >> 3) * 4 + (c >> 5)) * 512 + ((kk & 7) * 32 + (c & 31)) * 2; }
__device__ __forceinline__ int v_rd_base(int lane) { return ((lane & 3) << 3) | (((lane >> 2) & 3) << 6) | (((lane >> 4) & 1) << 5) | (((lane >> 5) & 1) << 8); }
constexpr int v_rd_off(int d0, int ks, int half) { return d0 * 512 + ks * 4096 + half * 2048; }
__device__ __forceinline__ int crow(int r, int hi) { return (r & 3) + 8 * (r >> 2) + 4 * hi; }
__device__ __forceinline__ unsigned cvtpk(float lo, float hi) { unsigned r; asm volatile("v_cvt_pk_bf16_f32 %0, %1, %2" : "=v"(r) : "v"(lo), "v"(hi)); return r; }

template <int DQK, bool ALIBI>
__device__ __forceinline__ void qkt(f32x16& p0, f32x16& p1, const ALAS char* kb, const bf16x8* qr, const ALAS float* pk, float tmax, float rowc, float m_reg, float qmin, const f32x16& negm, int hi) {
    constexpr int KP = DQK * 2 + 16;
    if (ALIBI) {
        if (tmax <= qmin) {
            const float base = rowc - m_reg;
#pragma unroll
            for (int g = 0; g < 4; ++g) {
                const f32x4 k0 = *(const ALAS f32x4*)(pk + 8 * g + 4 * hi), k1 = *(const ALAS f32x4*)(pk + 32 + 8 * g + 4 * hi);
#pragma unroll
                for (int i = 0; i < 4; ++i) { p0[4 * g + i] = base + k0[i]; p1[4 * g + i] = base + k1[i]; }
            }
        } else {
#pragma unroll
            for (int g = 0; g < 4; ++g) {
                const f32x4 k0 = *(const ALAS f32x4*)(pk + 8 * g + 4 * hi), k1 = *(const ALAS f32x4*)(pk + 32 + 8 * g + 4 * hi);
#pragma unroll
                for (int i = 0; i < 4; ++i) { p0[4 * g + i] = -fabsf(rowc + k0[i]) - m_reg; p1[4 * g + i] = -fabsf(rowc + k1[i]) - m_reg; }
            }
        }
    }
#pragma unroll
    for (int d0 = 0; d0 < DQK / 16; ++d0) {
        const bf16x8 b0 = *(const ALAS bf16x8*)(kb + d0 * 32);
        const bf16x8 b1 = *(const ALAS bf16x8*)(kb + 32 * KP + d0 * 32);
        if (!ALIBI && d0 == 0) { p0 = __builtin_amdgcn_mfma_f32_32x32x16_bf16(b0, qr[0], negm, 0, 0, 0); p1 = __builtin_amdgcn_mfma_f32_32x32x16_bf16(b1, qr[0], negm, 0, 0, 0); }
        else { p0 = __builtin_amdgcn_mfma_f32_32x32x16_bf16(b0, qr[d0], p0, 0, 0, 0); p1 = __builtin_amdgcn_mfma_f32_32x32x16_bf16(b1, qr[d0], p1, 0, 0, 0); } }
}
__device__ __forceinline__ void pv_tile(f32x16* o, int vb, bf16x8 pa0, bf16x8 pa1, bf16x8 pa2, bf16x8 pa3) {
#define TRRD(dst, off) asm volatile("ds_read_b64_tr_b16 %0, %1 offset:%2" : "=&v"(dst) : "v"(vb), "i"(off) : "memory")
#define PV_D0(d0) do { s16x4 l0, l1, l2, l3, h0, h1, h2, h3; constexpr int b_ = v_rd_off(d0, 0, 0); \
        TRRD(l0, b_); TRRD(h0, b_ + 2048); TRRD(l1, b_ + 4096); TRRD(h1, b_ + 6144); TRRD(l2, b_ + 8192); TRRD(h2, b_ + 10240); TRRD(l3, b_ + 12288); TRRD(h3, b_ + 14336); \
        asm volatile("s_waitcnt lgkmcnt(0)" ::: "memory"); SBAR();   \
        o[d0] = __builtin_amdgcn_mfma_f32_32x32x16_bf16(pa0, (bf16x8){l0[0], l0[1], l0[2], l0[3], h0[0], h0[1], h0[2], h0[3]}, o[d0], 0, 0, 0);   \
        o[d0] = __builtin_amdgcn_mfma_f32_32x32x16_bf16(pa1, (bf16x8){l1[0], l1[1], l1[2], l1[3], h1[0], h1[1], h1[2], h1[3]}, o[d0], 0, 0, 0);   \
        o[d0] = __builtin_amdgcn_mfma_f32_32x32x16_bf16(pa2, (bf16x8){l2[0], l2[1], l2[2], l2[3], h2[0], h2[1], h2[2], h2[3]}, o[d0], 0, 0, 0);   \
        o[d0] = __builtin_amdgcn_mfma_f32_32x32x16_bf16(pa3, (bf16x8){l3[0], l3[1], l3[2], l3[3], h3[0], h3[1], h3[2], h3[3]}, o[d0], 0, 0, 0); } while (0)
    PV_D0(0); PV_D0(1); PV_D0(2); PV_D0(3);
#undef PV_D0
#undef TRRD
}
template <int DQK, bool ALIBI, int VAR = 0>
__device__ __forceinline__ void attn_pass(ALAS char* lds, const bf16_t* __restrict__ Qh, int ldq, const bf16_t* __restrict__ Kh, int ldk, const bf16_t* __restrict__ Vh, int ldv,
                                          const float* __restrict__ posf, int q0, float nslope, float kn, f32x16 (&o)[4], unsigned long long& tacc) {
    constexpr int ND = DQK / 16, CH = DQK / 8, KP = DQK * 2 + 16, SHM_K = 64 * KP;
    int tid_ = threadIdx.x; asm volatile("" : "+v"(tid_));
    const int tid = tid_, wid = __builtin_amdgcn_readfirstlane(tid >> 6), lane = tid & 63, r32 = lane & 31, hi = lane >> 5, grp = wid >> 2;
    int NTE = (q0 + 256) / 64;
    const int NT = (q0 + 256) / 64, nact = q0 / 64 + (wid >> 1) + 1, kfirst = NT - nact;
    ALAS char* V_lds = lds + L_V; ALAS char* K_lds = lds + L_K; ALAS float* pos_lds = (ALAS float*)(lds + L_POS); ALAS float* ws = (ALAS float*)(lds + L_WS) + wid * 64; ALAS float* li_l = ws; ALAS float* al_l = ws + 32; ALAS float* xch = (ALAS float*)(lds + L_XCH);
    bf16x8 qr[ND];
#pragma unroll
    for (int d0 = 0; d0 < ND; ++d0) qr[d0] = *(const bf16x8*)(Qh + (size_t)(q0 + wid * 32 + r32) * ldq + d0 * 16 + hi * 8);
    float rowc = 0.f, qmin = 0.f;
    if (ALIBI) { const float pq = posf[q0 + wid * 32 + r32]; rowc = nslope * pq; qmin = pq;
#pragma unroll
        for (int off = 1; off < 32; off <<= 1) qmin = fminf(qmin, bperm_f(lane ^ off, qmin)); }
    const int k0key = tid / CH, k0ch = tid - k0key * CH; const int i1 = tid + 512; const bool has1 = (CH == 12) && (tid < 256); const int k1key = i1 / CH, k1ch = i1 - k1key * CH;
    const int sr = tid >> 4, sc = (tid & 15) * 8, vst0 = v_st(sr, sc), vst1 = v_st(32 + sr, sc);
    const int vb0 = (int)(unsigned)(uintptr_t)V_lds + v_rd_base(lane);
    const ALAS char* kfr = K_lds + r32 * KP + hi * 16;
    bf16x8 st_k0, st_k1 = {}, st_v0, st_v1; float st_p = 0.f;
#define VMW() asm volatile("s_waitcnt vmcnt(0)" ::: "memory")
#define LBAR() do { TS_BEG(4); asm volatile("s_waitcnt lgkmcnt(0)\n\ts_barrier" ::: "memory"); TS_END(4); } while (0)
#define TI(k) (NT - 1 - (k))
#define SLOAD_K(t) do { const int kb_ = (t) * 64; st_k0 = *(const bf16x8*)(Kh + (size_t)(kb_ + k0key) * ldk + k0ch * 8); if (CH == 12) { if (has1) st_k1 = *(const bf16x8*)(Kh + (size_t)(kb_ + k1key) * ldk + k1ch * 8); } \
        if (ALIBI) { if (tid < 64) st_p = posf[kb_ + tid]; } } while (0)
#define SLOAD_V(t) do { const int kb_ = (t) * 64; st_v0 = *(const bf16x8*)(Vh + (size_t)(kb_ + sr) * ldv + sc); st_v1 = *(const bf16x8*)(Vh + (size_t)(kb_ + 32 + sr) * ldv + sc); } while (0)
#define SWRITE_K(bf) do { *(ALAS bf16x8*)(K_lds + (bf) * SHM_K + k0key * KP + k0ch * 16) = st_k0; if (CH == 12) { if (has1) *(ALAS bf16x8*)(K_lds + (bf) * SHM_K + k1key * KP + k1ch * 16) = st_k1; } \
        if (ALIBI) { if (tid < 64) pos_lds[(bf) * 80 + tid] = -nslope * st_p; } } while (0)
#define SWRITE_V(bf) do { *(ALAS bf16x8*)(V_lds + (bf) * SHM_V + vst0) = st_v0; *(ALAS bf16x8*)(V_lds + (bf) * SHM_V + vst1) = st_v1; } while (0)
    unsigned long long ts0_ = 0ull; (void)ts0_;
#define TS_BEG(id) do { if (PROBE_TSEC == (id) && wid == PROBE_WAVE) { ts0_ = __builtin_readcyclecounter(); } } while (0)
#define TS_END(id) do { if (PROBE_TSEC == (id) && wid == PROBE_WAVE) { tacc += __builtin_readcyclecounter() - ts0_; } } while (0)
    float m_reg = 0.f, l_reg = 0.f;
#pragma unroll
    for (int d0 = 0; d0 < 4; ++d0) o[d0] = f32x16{};
    f32x16 p0 = f32x16{}, p1 = f32x16{}, negm = f32x16{}; bf16x8 pa0 = {}, pa1 = {}, pa2 = {}, pa3 = {};
#define MBLOCK(k) do { if (VAR == 2) break; TS_BEG(2); SBAR(); \
        float tmx_ = 0.f; if (ALIBI) { const int kq_ = (k) < NT ? (k) : NT - 1; tmx_ = posf[S_TMAX_OFF + TI(kq_)]; } \
        if ((k) >= 1 && (k) - 1 >= kfirst) pv_tile(o, vb0 + (((k) - 1) & 1) * SHM_V, pa0, pa1, pa2, pa3); SBAR(); \
        if ((k) < NTE && (k) >= kfirst) qkt<DQK, ALIBI>(p0, p1, kfr + ((k) & 1) * SHM_K, qr, pos_lds + ((k) & 1) * 80, tmx_, rowc, m_reg, qmin, negm, hi); SBAR(); TS_END(2); } while (0)
#define VBLOCK(k) do { if (VAR != 1 && (k) >= kfirst) { TS_BEG(3); SBAR(); \
        float pmax = fmaxf(fmaxf(p0[0], p0[1]), p1[0]); \
        _Pragma("unroll") for (int r = 2; r < 16; r += 2) pmax = fmaxf(fmaxf(pmax, p0[r]), p0[r + 1]); \
        _Pragma("unroll") for (int r = 1; r < 15; r += 2) pmax = fmaxf(fmaxf(pmax, p1[r]), p1[r + 1]); \
        pmax = fmaxf(pmax, p1[15]); \
        { auto rr = __builtin_amdgcn_permlane32_swap(__float_as_uint(pmax), __float_as_uint(pmax), false, false); pmax = fmaxf(__uint_as_float(rr[0]), __uint_as_float(rr[1])); } \
        const bool first = (k) == kfirst; \
        if (first || !__all(pmax <= THR)) { \
            const float delta = first ? pmax : fmaxf(pmax, 0.f); m_reg += delta; \
            _Pragma("unroll") for (int r = 0; r < 16; ++r) { p0[r] -= delta; p1[r] -= delta; } \
            if (!ALIBI) { _Pragma("unroll") for (int r = 0; r < 16; ++r) negm[r] = -m_reg; } \
            { const float alpha = first ? 1.0f : __builtin_amdgcn_exp2f(-delta); l_reg *= alpha; \
                if (hi == 0) al_l[r32] = alpha; asm volatile("s_waitcnt lgkmcnt(0)" ::: "memory"); \
                _Pragma("unroll") for (int d_ = 0; d_ < 4; ++d_) _Pragma("unroll") for (int r = 0; r < 16; ++r) o[d_][r] *= al_l[crow(r, hi)]; } } \
        _Pragma("unroll") for (int r = 0; r < 16; ++r) { p0[r] = __builtin_amdgcn_exp2f(p0[r]); p1[r] = __builtin_amdgcn_exp2f(p1[r]); } \
        float ps = 0.f; \
        _Pragma("unroll") for (int r = 0; r < 16; ++r) ps += p0[r]; \
        _Pragma("unroll") for (int r = 0; r < 16; ++r) ps += p1[r]; \
        l_reg += ps; \
        PK4(p0, 0, pa0); PK4(p0, 8, pa1); PK4(p1, 0, pa2); PK4(p1, 8, pa3); SBAR(); TS_END(3); } } while (0)
#define PK4(P, B_, OUT) do { unsigned a0 = cvtpk(P[B_+0], P[B_+1]), a1 = cvtpk(P[B_+2], P[B_+3]);                          \
        unsigned b0 = cvtpk(P[B_+4], P[B_+5]), b1 = cvtpk(P[B_+6], P[B_+7]);                                             \
        auto r0 = __builtin_amdgcn_permlane32_swap(a0, b0, false, false); auto r1 = __builtin_amdgcn_permlane32_swap(a1, b1, false, false); \
        u32x4 w = {r0[0], r1[0], r0[1], r1[1]}; OUT = *reinterpret_cast<bf16x8*>(&w); } while (0)
#define SKIP_DECIDE() do { float B_ = xch[0], Q_ = xch[1]; _Pragma("unroll") for (int w = 1; w < 8; ++w) { B_ = fmaxf(B_, xch[2 * w]); Q_ = fminf(Q_, xch[2 * w + 1]); } \
        int kst_ = NT; _Pragma("unroll") for (int j_ = 0; j_ < 4; ++j_) { const int kc_ = 4 + lane + 64 * j_; \
            if (kc_ < NT) { const float pm_ = posf[S_PMAX_OFF + TI(kc_)]; if (B_ + nslope * fmaxf(Q_ - pm_, 0.f) <= -SKIP_T) kst_ = kc_ < kst_ ? kc_ : kst_; } } \
        _Pragma("unroll") for (int off = 1; off < 64; off <<= 1) { const int o_ = __builtin_amdgcn_ds_bpermute((lane ^ off) << 2, kst_); kst_ = o_ < kst_ ? o_ : kst_; } \
        kst_ = __builtin_amdgcn_readfirstlane(kst_); NTE = (kst_ + 1) & ~1; if (NTE > NT) NTE = NT; } while (0)
    if (ALIBI) { float ss_ = 0.f, sd_ = 0.f; const bf16_t* krow_ = Kh + (size_t)(q0 + wid * 32 + r32) * ldk + hi * 8;
#pragma unroll
        for (int d0 = 0; d0 < ND; ++d0) { const bf16x8 kv_ = *(const bf16x8*)(krow_ + d0 * 16);
#pragma unroll
            for (int e = 0; e < 8; ++e) { const float x_ = __uint_as_float((unsigned)(unsigned short)qr[d0][e] << 16), y_ = __uint_as_float((unsigned)(unsigned short)kv_[e] << 16); ss_ = fmaf(x_, x_, ss_); sd_ = fmaf(x_, y_, sd_); } }
        { auto rr = __builtin_amdgcn_permlane32_swap(__float_as_uint(ss_), __float_as_uint(ss_), false, false); ss_ = __uint_as_float(rr[0]) + __uint_as_float(rr[1]); }
        { auto rr = __builtin_amdgcn_permlane32_swap(__float_as_uint(sd_), __float_as_uint(sd_), false, false); sd_ = __uint_as_float(rr[0]) + __uint_as_float(rr[1]); }
        float b_ = sqrtf(ss_) * 1.0001f * kn - sd_;
#pragma unroll
        for (int off = 1; off < 32; off <<= 1) b_ = fmaxf(b_, bperm_f(lane ^ off, b_));
        if (lane == 0) { xch[2 * wid] = b_; xch[2 * wid + 1] = qmin; } }
    SLOAD_K(TI(0)); VMW(); SWRITE_K(0); LBAR();
    if (ALIBI) SKIP_DECIDE();
#define STG_W(k, KB) do { if (VAR != 3 && (k) < NTE) { TS_BEG(6); VMW(); if ((k) + 1 < NTE) SWRITE_K(1 - (KB)); SWRITE_V(KB); TS_END(6); } } while (0)
#define STG_L(k) do { if (VAR != 3) { TS_BEG(5); if ((k) + 2 < NTE) SLOAD_K(TI((k) + 2)); if ((k) + 1 < NTE) SLOAD_V(TI((k) + 1)); TS_END(5); } } while (0)
    if (1 < NT) SLOAD_K(TI(1));
    SLOAD_V(TI(0));
    if (grp == 0) {
#define BODY_A(k) do { \
            MBLOCK(k); LBAR(); \
            STG_W(k, 0); STG_L(k); if ((k) < NTE) VBLOCK(k); LBAR(); \
            if ((k) + 1 <= NTE) { \
            MBLOCK((k) + 1); LBAR(); \
            STG_W((k) + 1, 1); STG_L((k) + 1); if ((k) + 1 < NTE) VBLOCK((k) + 1); LBAR(); } } while (0)
        for (int k = 0; k <= NTE; k += 2) BODY_A(k);
#undef BODY_A
    } else {
#define BODY_B(k) do { \
            STG_W(k, 0); STG_L(k); if ((k) >= 1) VBLOCK((k) - 1); LBAR(); \
            MBLOCK(k); LBAR(); \
            if ((k) + 1 <= NTE) { \
            STG_W((k) + 1, 1); STG_L((k) + 1); VBLOCK(k); LBAR(); \
            MBLOCK((k) + 1); LBAR(); } } while (0)
        for (int k = 0; k <= NTE; k += 2) BODY_B(k);
#undef BODY_B
    }
#undef STG_W
#undef SKIP_DECIDE
#undef STG_L
    { auto rr = __builtin_amdgcn_permlane32_swap(__float_as_uint(l_reg), __float_as_uint(l_reg), false, false); l_reg = __uint_as_float(rr[0]) + __uint_as_float(rr[1]); }
    if (hi == 0) li_l[r32] = l_reg; asm volatile("s_waitcnt lgkmcnt(0)" ::: "memory");
#pragma unroll
    for (int r = 0; r < 16; ++r) { const float rl = __builtin_amdgcn_rcpf(li_l[crow(r, hi)]);
#pragma unroll
        for (int d0 = 0; d0 < 4; ++d0) o[d0][r] *= rl; }
#undef PK4
#undef VBLOCK
#undef MBLOCK
#undef SWRITE_V
#undef SWRITE_K
#undef SLOAD_V
#undef SLOAD_K
#undef TI
#undef VMW
#undef LBAR
#undef TS_BEG
#undef TS_END
}
__device__ __forceinline__ void store_o_bf16(const f32x16 (&o)[4], bf16_t* Ow  , int ldo, int r32, int hi) {
#pragma unroll
    for (int r = 0; r < 16; ++r) { const int orow = crow(r, hi);
#pragma unroll
        for (int d0 = 0; d0 < 4; ++d0) { const float v = o[d0][r]; const float vn = bperm_f((hi * 32 + r32) ^ 1, v);
            if ((r32 & 1) == 0) *(unsigned*)(Ow + (size_t)orow * ldo + d0 * 32 + r32) = cvtpk(v, vn); } }
}
#undef SBAR
}

#define LAS __attribute__((address_space(3)))
typedef unsigned short bf16;
typedef unsigned v4u __attribute__((ext_vector_type(4)));
typedef unsigned v2u __attribute__((ext_vector_type(2)));
typedef float f32x4 __attribute__((ext_vector_type(4)));
#ifndef ATT_NO_DIFF
#define ATT_NO_DIFF 0
#endif
#ifndef ATT_NO_MLA
#define ATT_NO_MLA 0
#endif
#ifndef ALIBI_ON
#define ALIBI_ON true
#endif
#ifndef PROBE_VAR
#define PROBE_VAR 0
#endif
#define PTS_BEG(id) do { if (PROBE_TSEC == (id) && __builtin_amdgcn_readfirstlane(threadIdx.x >> 6) == PROBE_WAVE) pts0 = __builtin_readcyclecounter(); } while (0)
#define PTS_END(id) do { if (PROBE_TSEC == (id) && __builtin_amdgcn_readfirstlane(threadIdx.x >> 6) == PROBE_WAVE) tacc += __builtin_readcyclecounter() - pts0; } while (0)
#define ATT_CALL_D(...) do { PTS_BEG(7); if (PROBE_VAR == 0 || rep == 0) att::attn_pass<64, ALIBI_ON, 0>(__VA_ARGS__); else att::attn_pass<64, ALIBI_ON, PROBE_VAR>(__VA_ARGS__); PTS_END(7); } while (0)
#define ATT_CALL_M(...) do { PTS_BEG(7); if (PROBE_VAR == 0 || rep == 0) att::attn_pass<96, false, 0>(__VA_ARGS__); else att::attn_pass<96, false, PROBE_VAR>(__VA_ARGS__); PTS_END(7); } while (0)
#ifndef PHMASK
#define PHMASK 0x1ff
#endif
#define EN(k) (((PHMASK) >> (k)) & 1)
constexpr int NWAVES = 8;
constexpr int RING_BYTES = 131072, MISC_OFF = RING_BYTES, LDS_BYTES = 147456;
static_assert(att::L_END <= RING_BYTES, "attention LDS");
constexpr size_t MiB = 1u << 20;
constexpr size_t WS_CTL = 0, WS_WIN = 1 * MiB, WS_WUQ = 20 * MiB, WS_WUKV = 21 * MiB, WS_WO = 22 * MiB, WS_WGU = 30 * MiB, WS_WDN = 74 * MiB;
constexpr size_t WS_POSF = 96 * MiB, WS_COS = 97 * MiB, WS_SIN = 98 * MiB, WS_SSQ = 99 * MiB, WS_HB = 100 * MiB, WS_SCR = 164 * MiB;
constexpr size_t WS_AQ = WS_SCR, WS_AK = WS_SCR + 24 * MiB, WS_AV = WS_SCR + 48 * MiB, WS_BH = WS_SCR + 72 * MiB, WS_BB = WS_SCR + 88 * MiB, WS_BC = WS_SCR + 104 * MiB,
                 WS_CQ = WS_SCR + 120 * MiB, WS_CKV = WS_SCR + 136 * MiB, WS_CKR = WS_SCR + 144 * MiB, WS_QM = WS_SCR + 146 * MiB, WS_KM = WS_SCR + 164 * MiB, WS_VC = WS_SCR + 182 * MiB,
                 WS_STASH = WS_SCR + 206 * MiB;
constexpr size_t WS_RS = WS_SSQ + 800 * 1024;
constexpr size_t WS_A = WS_SCR, WS_GS = WS_SCR + 176 * MiB, WS_US = WS_SCR + 198 * MiB;
constexpr size_t WS_END = WS_SCR + 238 * MiB;
static_assert(WS_WIN + (size_t)PINP * DM * 2 <= WS_WUQ && WS_WGU + (size_t)2 * DFF * DM * 2 <= WS_WDN && WS_WDN + (size_t)DM * DFF * 2 <= WS_POSF, "weight map");
static_assert((size_t)S * DFF * 2 <= 176 * MiB && (size_t)(S / 64) * 4 * DFF * 4 <= 22 * MiB && (size_t)(S / 64) * 2 * DFF * 4 <= 11 * MiB, "ffn map");

__device__ __forceinline__ unsigned f2bf(float f) { unsigned u = __builtin_bit_cast(unsigned, f); return (u + 0x7fffu + ((u >> 16) & 1u)) >> 16; }
__device__ __forceinline__ unsigned pk2(float lo, float hi) { return f2bf(lo) | (f2bf(hi) << 16); }
__device__ __forceinline__ float bf2f(unsigned short b) { return __builtin_bit_cast(float, (unsigned)b << 16); }
__device__ __forceinline__ float bflo(unsigned w) { return __builtin_bit_cast(float, w << 16); }
__device__ __forceinline__ float bfhi(unsigned w) { return __builtin_bit_cast(float, w & 0xffff0000u); }
__device__ __forceinline__ float wave_sum(float v) {
    const int ln = lane_id_v();
#pragma unroll
    for (int o = 1; o < 64; o <<= 1) v += bperm_f(ln ^ o, v);
    return v;
}
template <int MODE> __device__ __forceinline__ int dst_row(int n, int up) {
    if (MODE == 1) return ((n >> 7) << 8) + (n & 127) + up * 128;
    if (MODE == 2) { const int h = n / 192, w = n - h * 192; return w < 64 ? h * 64 + w : 384 + h * 128 + (w - 64); }
    return n;
}
template <int MODE> __device__ __forceinline__ void transpose_item(const float* __restrict__ W, int K, int N, bf16* __restrict__ WT, int up, const float* __restrict__ rs, LAS float* scr, int item, int lane) {
    const int nblk = N / 32, kb = item / nblk, nb = item - kb * nblk, k0 = 64 * kb, n0 = 32 * nb;
#pragma unroll 8
    for (int i = 0; i < 32; ++i) { const int kk = 2 * i + (lane >> 5); float v = W[(size_t)(k0 + kk) * N + n0 + (lane & 31)]; if (rs) v *= rs[k0 + kk]; scr[kk * 33 + (lane & 31)] = v; }
    asm volatile("s_waitcnt lgkmcnt(0)" ::: "memory");
    const int c = lane & 7;
#pragma unroll
    for (int j = 0; j < 4; ++j) { const int n = (lane >> 3) + 8 * j; const LAS float* s = scr + (8 * c) * 33 + n;
        v4u o; o.x = pk2(s[0 * 33], s[1 * 33]); o.y = pk2(s[2 * 33], s[3 * 33]); o.z = pk2(s[4 * 33], s[5 * 33]); o.w = pk2(s[6 * 33], s[7 * 33]);
        *(v4u*)(WT + (size_t)dst_row<MODE>(n0 + n, up) * K + k0 + 8 * c) = o; }
    asm volatile("s_waitcnt lgkmcnt(0)" ::: "memory");
}
struct Args {
    const float* x; const int* pos; const float *ln_in_g, *ln_in_b, *w_in, *diff_lambda, *diff_norm_g, *conv_w, *mla_q_norm_g, *mla_kv_norm_g, *w_uq, *w_ukv, *w_o, *ln1_g, *ln1_b,
        *ffn_w_gate, *ffn_w_up, *ffn_conv_w, *ffn_w_down, *ln2_g, *ln2_b;
    float* out; unsigned char* ws; int ph_lo, ph_hi;
};
typedef const __attribute__((address_space(4))) Args* ArgP;
__device__ __forceinline__ void convert_weights(ArgP a, int l, unsigned char* ws, LAS float* scr, int gw, int NGW, int lane) {
    constexpr int I_IN = (DM / 64) * (PIN / 32), I_UQ = (CQR / 64) * (NUQ / 32), I_UKV = (CKVR / 64) * (NUKV / 32), I_O = (DM / 64) * (DM / 32), I_G = (DM / 64) * (DFF / 32), I_D = (DFF / 64) * (DM / 32);
    constexpr int NITEMS = I_IN + I_UQ + I_UKV + I_O + 2 * I_G + I_D;
    for (int it = gw; it < NITEMS; it += NGW) {
        int r = it;
        if (r < I_IN) { transpose_item<0>(a->w_in + (size_t)l * DM * PIN, DM, PIN, (bf16*)(ws + WS_WIN), 0, nullptr, scr, r, lane); continue; } r -= I_IN;
        if (r < I_UQ) { transpose_item<0>(a->w_uq + (size_t)l * CQR * NUQ, CQR, NUQ, (bf16*)(ws + WS_WUQ), 0, a->mla_q_norm_g + l * CQR, scr, r, lane); continue; } r -= I_UQ;
        if (r < I_UKV) { transpose_item<2>(a->w_ukv + (size_t)l * CKVR * NUKV, CKVR, NUKV, (bf16*)(ws + WS_WUKV), 0, a->mla_kv_norm_g + l * CKVR, scr, r, lane); continue; } r -= I_UKV;
        if (r < I_O) { transpose_item<0>(a->w_o + (size_t)l * DM * DM, DM, DM, (bf16*)(ws + WS_WO), 0, nullptr, scr, r, lane); continue; } r -= I_O;
        if (r < I_G) { transpose_item<1>(a->ffn_w_gate + (size_t)l * DM * DFF, DM, DFF, (bf16*)(ws + WS_WGU), 0, nullptr, scr, r, lane); continue; } r -= I_G;
        if (r < I_G) { transpose_item<1>(a->ffn_w_up + (size_t)l * DM * DFF, DM, DFF, (bf16*)(ws + WS_WGU), 1, nullptr, scr, r, lane); continue; } r -= I_G;
        transpose_item<0>(a->ffn_w_down + (size_t)l * DFF * DM, DFF, DM, (bf16*)(ws + WS_WDN), 0, nullptr, scr, r, lane);
    }
}
template <bool FINAL> __device__ __forceinline__ void ln_row(const float* xin, float* hout, bf16* hb, float* rs2, const float* __restrict__ g, const float* __restrict__ b, int lane) {
    const f32x4* xr = (const f32x4*)xin + lane;
    f32x4 v[8]; float s = 0.f;
#pragma unroll
    for (int j = 0; j < 8; ++j) { v[j] = xr[64 * j]; s += (v[j].x + v[j].y) + (v[j].z + v[j].w); }
    const float mean = wave_sum(s) * (1.f / DM); float s2 = 0.f;
#pragma unroll
    for (int j = 0; j < 8; ++j) { v[j] = v[j] - mean; s2 += (v[j].x * v[j].x + v[j].y * v[j].y) + (v[j].z * v[j].z + v[j].w * v[j].w); }
    const float rstd = 1.f / sqrtf(wave_sum(s2) * (1.f / DM) + LN_EPS);
    if (!FINAL && lane == 0) { rs2[0] = mean; rs2[1] = rstd; }
    f32x4* ho = (f32x4*)hout + lane; v2u* o8 = (v2u*)hb + lane;
#pragma unroll
    for (int j = 0; j < 8; ++j) { const f32x4 gg = ((const f32x4*)g)[64 * j + lane], bb = ((const f32x4*)b)[64 * j + lane]; const f32x4 y = v[j] * rstd * gg + bb;
        if (FINAL) ho[64 * j] = y; else { v2u w; w.x = pk2(y.x, y.y); w.y = pk2(y.z, y.w); o8[64 * j] = w; } }
}
__device__ __forceinline__ void sincos_f32(float x, float& sn, float& cs) {
    const float k = __builtin_rintf(x * 0.636619772f);
    float y = __builtin_fmaf(-k, 1.570796371e+00f, x); y = __builtin_fmaf(-k, -4.371138829e-08f, y);
    const float y2 = y * y;
    float sp = 2.86567956e-6f; sp = sp * y2 - 1.98559923e-4f; sp = sp * y2 + 8.33338592e-3f; sp = sp * y2 - 1.66666672e-1f; const float sy = __builtin_fmaf(y * y2, sp, y);
    float cp = 2.44677067e-5f; cp = cp * y2 - 1.38877297e-3f; cp = cp * y2 + 4.16666567e-2f; cp = cp * y2 - 0.5f; const float cy = __builtin_fmaf(y2, cp, 1.0f);
    const int q = (int)k & 3;
    const float s_ = (q & 1) ? cy : sy, c_ = (q & 1) ? sy : cy;
    sn = (q & 2) ? -s_ : s_; cs = ((q + 1) & 2) ? -c_ : c_;
}
__device__ __forceinline__ float inv_freq16(int j) {
    float v = 1.000000000e+00f;
    v = j == 1 ? 5.623413324e-01f : v; v = j == 2 ? 3.162277639e-01f : v; v = j == 3 ? 1.778279394e-01f : v; v = j == 4 ? 1.000000015e-01f : v; v = j == 5 ? 5.623413250e-02f : v;
    v = j == 6 ? 3.162277490e-02f : v; v = j == 7 ? 1.778279431e-02f : v; v = j == 8 ? 9.999999776e-03f : v; v = j == 9 ? 5.623413250e-03f : v; v = j == 10 ? 3.162277630e-03f : v;
    v = j == 11 ? 1.778279431e-03f : v; v = j == 12 ? 1.000000047e-03f : v; v = j == 13 ? 5.623413017e-04f : v; v = j == 14 ? 3.162277571e-04f : v; v = j == 15 ? 1.778279402e-04f : v;
    return v;
}

#define XB_TMO      128
#define XB_XCNT(j)  (256  + 64 * (j))
#define XB_XSUB(j)  (1280 + 64 * (j))
#define XB_XGEN(j)  (2304 + 64 * (j))
#define XB_TOP      3328
#define XB_TOPGEN   3392
#define XCD_BAR_WORDS 3456
#define XB_SPIN_CAP (1u << 18)

__device__ __forceinline__ unsigned xb_ld(unsigned* p)              { return __hip_atomic_load(p, __ATOMIC_RELAXED, __HIP_MEMORY_SCOPE_AGENT); }
__device__ __forceinline__ unsigned xb_add(unsigned* p, unsigned v) { return __hip_atomic_fetch_add(p, v, __ATOMIC_RELAXED, __HIP_MEMORY_SCOPE_AGENT); }
__device__ __forceinline__ unsigned xb_xcc_id() { return (unsigned)__builtin_amdgcn_s_getreg((3 << 11) | 20) & 0xFu; }
#define XB_SPIN(cond, bar) do { unsigned _sp = 0; while (cond) { __builtin_amdgcn_s_sleep(1); \
    if ((++_sp & 255u) == 0u) { if (xb_ld(&(bar)[XB_TMO])) break; if (_sp > XB_SPIN_CAP) { atomicAdd(&(bar)[XB_TMO], 1u); break; } } } } while (0)

struct XcdBarrier {
    unsigned* bar; unsigned x;
    volatile LAS unsigned* st;
};

__device__ __forceinline__ XcdBarrier xcd_barrier_post(unsigned* bar, volatile LAS unsigned* st) {
    XcdBarrier b; b.bar = bar; b.x = xb_xcc_id(); b.st = st;
    if (threadIdx.x == 0) (void)xb_add(&bar[XB_XCNT(b.x)], 1u);
    return b;
}
__device__ __forceinline__ void xcd_barrier_complete(unsigned* bar, unsigned x, unsigned& nloc, unsigned& nx) {
    const unsigned G = gridDim.x * gridDim.y * gridDim.z;
    unsigned sum, cnt, mine, sp = 0u;
    for (;;) {
        sum = 0u; cnt = 0u; mine = 0u;
#pragma unroll
        for (unsigned j = 0; j < 16; ++j) { const unsigned c = xb_ld(&bar[XB_XCNT(j)]); sum += c; cnt += (c > 0u) ? 1u : 0u; mine = (j == x) ? c : mine; }
        if (sum == G) break;
        __builtin_amdgcn_s_sleep(1);
        if ((++sp & 255u) == 0u) { if (xb_ld(&bar[XB_TMO])) break; if (sp > XB_SPIN_CAP) { atomicAdd(&bar[XB_TMO], 1u); break; } }
    }
    nloc = mine > 0u ? mine : 1u; nx = cnt > 0u ? cnt : 1u;
}

__device__ __forceinline__ void xcd_barrier(const XcdBarrier& b) {
    asm volatile("s_waitcnt vmcnt(0)" ::: "memory");
    __syncthreads();
    if (threadIdx.x == 0) {
        unsigned* bar = b.bar;
        __builtin_amdgcn_s_waitcnt(0);
        unsigned nloc = b.st[0], nx = b.st[1];
        if (nloc == 0u) { xcd_barrier_complete(bar, b.x, nloc, nx); b.st[0] = nloc; b.st[1] = nx; }
        const unsigned old = xb_add(&bar[XB_XSUB(b.x)], 1u);
        const unsigned gen = old / nloc;
        if (old + 1u == (gen + 1u) * nloc) {
            __builtin_amdgcn_fence(__ATOMIC_RELEASE, "agent");
            asm volatile("s_waitcnt vmcnt(0)" ::: "memory");
            const unsigned og = xb_add(&bar[XB_TOP], 1u);
            const unsigned tg = og / nx;
            if (og + 1u == (tg + 1u) * nx) xb_add(&bar[XB_TOPGEN], 1u);
            else XB_SPIN(xb_ld(&bar[XB_TOPGEN]) == tg, bar);
            __builtin_amdgcn_fence(__ATOMIC_ACQUIRE, "agent");
            xb_add(&bar[XB_XGEN(b.x)], 1u);
            asm volatile("s_waitcnt vmcnt(0)" ::: "memory");
        } else {
            XB_SPIN(xb_ld(&bar[XB_XGEN(b.x)]) == gen, bar);
            __builtin_amdgcn_fence(__ATOMIC_ACQUIRE, "agent");
            asm volatile("s_waitcnt vmcnt(0)" ::: "memory");
        }
    }
    __syncthreads();
}

constexpr int CW_BAR = 4096, CW_KN = 1024, CW_GRP = 2048;
__device__ const unsigned short DIFF_ORDER[384] = {381,389,397,405,413,421,429,437,445,453,461,469,477,485,493,501,509,373,365,357,349,341,333,325,317,309,301,293,285,277,269,261,253,245,237,229,221,213,205,197,189,181,173,165,157,156,164,172,180,188,196,204,212,220,228,236,244,252,260,268,276,284,292,300,308,316,324,332,340,348,356,364,372,380,388,396,404,412,420,428,436,444,452,460,468,476,484,492,500,508,148,149,140,141,132,133,124,125,116,117,108,109,100,101,92,93,84,85,76,77,68,69,67,75,83,91,99,107,115,123,131,139,147,155,163,171,179,187,195,203,211,219,227,235,243,251,259,267,275,283,291,299,307,315,323,331,339,347,355,363,371,379,387,395,403,411,419,427,435,443,451,459,467,475,483,491,499,507,59,60,61,51,52,53,43,44,45,35,36,37,34,42,50,58,66,74,82,90,98,106,114,122,130,138,146,154,162,170,178,186,194,202,210,218,226,234,242,250,258,266,274,282,290,298,306,314,322,330,338,346,354,362,370,378,386,394,402,410,418,426,434,442,450,458,466,474,482,490,498,506,26,27,28,29,18,19,20,21,17,25,33,41,49,57,65,73,81,89,97,105,113,121,129,137,145,153,161,169,177,185,193,201,209,217,225,233,241,249,257,265,273,281,289,297,305,313,321,329,337,345,353,361,369,377,385,393,401,409,417,425,433,441,449,457,465,473,481,489,497,505,9,10,11,12,13,8,16,24,32,40,48,56,64,72,80,88,96,104,112,120,128,136,144,152,160,168,176,184,192,200,208,216,224,232,240,248,256,264,272,280,288,296,304,312,320,328,336,344,352,360,368,376,384,392,400,408,416,424,432,440,448,456,464,472,480,488,496,504,0,1,2,3,4,5};
__device__ __forceinline__ void grp_barrier(unsigned* ctr, unsigned target) {
    asm volatile("s_waitcnt vmcnt(0)" ::: "memory");
    __syncthreads();
    if (threadIdx.x == 0) {
        __builtin_amdgcn_fence(__ATOMIC_RELEASE, "agent"); asm volatile("s_waitcnt vmcnt(0)" ::: "memory");
        (void)__hip_atomic_fetch_add(ctr, 1u, __ATOMIC_RELAXED, __HIP_MEMORY_SCOPE_AGENT);
        unsigned sp = 0u; while (__hip_atomic_load(ctr, __ATOMIC_RELAXED, __HIP_MEMORY_SCOPE_AGENT) < target) { __builtin_amdgcn_s_sleep(1); if (++sp > (1u << 24)) break; }
        __builtin_amdgcn_fence(__ATOMIC_ACQUIRE, "agent"); asm volatile("s_waitcnt vmcnt(0)" ::: "memory");
    }
    __syncthreads();
}
__global__ void __launch_bounds__(NWAVES * 64, 2) mk_fwd(Args a) {
    extern __shared__ __attribute__((aligned(16))) unsigned char lds[];
    cg::grid_group grid = cg::this_grid();
    const int G = gridDim.x, NGW = G * NWAVES, NGT = G * NWAVES * 64;
    LAS unsigned char* ldsl = (LAS unsigned char*)lds;
    volatile LAS unsigned* MISC = (volatile LAS unsigned*)(ldsl + MISC_OFF);
    if (threadIdx.x < 32) MISC[threadIdx.x] = 0u;
    __syncthreads();

#ifndef PROBE_SUB
#define PROBE_SUB -1
#endif
    unsigned long long tacc = 0ull, pts0 = 0ull; (void)pts0;
    constexpr int NPROG = 1 + 9 * NLAYER + (PROBE_SUB >= 0 ? (PROBE_SUB >= 9 ? 1 : NLAYER) : 0);
    for (int pi = 0; pi < NPROG; ++pi) {
        int ph = pi, rep = 0;
        if (PROBE_SUB >= 9) { if (pi >= 1) { ph = pi - 1; rep = pi == 1; } }
        else if (PROBE_SUB >= 0) { constexpr int p0 = 1 + PROBE_SUB, p1 = 10 + PROBE_SUB;
            if (pi <= p0) ph = pi; else if (pi == p0 + 1) { ph = p0; rep = 1; } else if (pi <= p1 + 1) ph = pi - 1; else if (pi == p1 + 2) { ph = p1; rep = 1; } else ph = pi - 2; }
        ArgP ap = (ArgP)__builtin_amdgcn_kernarg_segment_ptr(); asm volatile("" : "+s"(ap));
        unsigned char* ws = ap->ws;
        float* hres = ap->out;
        bf16* hb = (bf16*)(ws + WS_HB);
        float* posf = (float*)(ws + WS_POSF); float* cost = (float*)(ws + WS_COS); float* sint = (float*)(ws + WS_SIN); float* ssq = (float*)(ws + WS_SSQ);
        unsigned* qctr = (unsigned*)(ws + WS_CTL);
        if (PROBE_SUB == 10 && pi == 1) { for (int e = 0; e < 10; ++e) { XcdBarrier xb_; xb_.bar = qctr + CW_BAR; xb_.x = xb_xcc_id(); xb_.st = MISC + 8; xcd_barrier(xb_); } continue; }
        if (ph == 0 && EN(0)) {
            int tid_ = threadIdx.x; asm volatile("" : "+v"(tid_)); const int tid = tid_, lane = tid & 63, wave = __builtin_amdgcn_readfirstlane(tid >> 6), gw = blockIdx.x * NWAVES + wave, gt = blockIdx.x * (NWAVES * 64) + tid; (void)gt; (void)gw; (void)lane;
            if (blockIdx.x == 0 && rep == 0) { if (tid < 4 * NLAYER) __hip_atomic_store(qctr + 64 * tid, 0u, __ATOMIC_RELAXED, __HIP_MEMORY_SCOPE_AGENT); if (tid < 8) __hip_atomic_store(qctr + CW_GRP + 64 * tid, 0u, __ATOMIC_RELAXED, __HIP_MEMORY_SCOPE_AGENT);
                for (int i = tid; i < XCD_BAR_WORDS; i += NWAVES * 64) __hip_atomic_store(qctr + CW_BAR + i, 0u, __ATOMIC_RELAXED, __HIP_MEMORY_SCOPE_AGENT); }
            convert_weights(ap, 0, ws, (LAS float*)(ldsl + wave * 16384), gw, NGW, lane);
            for (int m = gw; m < S; m += NGW) ln_row<false>(ap->x + (size_t)m * DM, nullptr, hb + (size_t)m * DM, (float*)(ws + WS_RS) + 2 * m, ap->ln_in_g, ap->ln_in_b, lane);
            if (gw < S / 64) { float mx = (float)ap->pos[gw * 64 + lane];
#pragma unroll
                for (int off = 1; off < 64; off <<= 1) mx = fmaxf(mx, bperm_f(lane ^ off, mx));
                if (lane == 0) posf[att::S_TMAX_OFF + gw] = mx; }
            for (int i = gt; i < S * 16; i += NGT) { const int s = i >> 4, j = i & 15; const float p = (float)ap->pos[s];
                float sn, cs; sincos_f32(p * inv_freq16(j), sn, cs); cost[i] = cs; sint[i] = sn; if (j == 0) posf[s] = p; }
        } else {
            const int l = (ph - 1) / 9, sub = (ph - 1) % 9;
            const float lam_init = l == 0 ? 0.2f : 0.35550906759096927f;
            if (sub == 0 && EN(1)) {
                if (blockIdx.x == 0) {
                    const int lane = lane_id_v(); const bool w0 = __builtin_amdgcn_readfirstlane(threadIdx.x >> 6) == 0;
                    if (w0 && lane < 12) __hip_atomic_store(qctr + CW_KN + lane, 0u, __ATOMIC_RELAXED, __HIP_MEMORY_SCOPE_AGENT);
                    if (w0) { float carry = -3.0e38f;
                        for (int j = 0; j < 4; ++j) { float v = posf[att::S_TMAX_OFF + 64 * j + lane];
#pragma unroll
                            for (int off = 1; off < 64; off <<= 1) { const float t = bperm_f(lane >= off ? lane - off : lane, v); v = lane >= off ? fmaxf(v, t) : v; }
                            v = fmaxf(v, carry); posf[att::S_PMAX_OFF + 64 * j + lane] = v; carry = bperm_f(63, v); } }
                }
                pg8::Gemm g{hb, (const bf16*)(ws + WS_WIN), S, PINP, DM}; pg8::StaticOrder so; so.init(S, PINP, G, (int)blockIdx.x);
                pg8::EpiProj E{(bf16*)(ws + WS_AQ), (bf16*)(ws + WS_AK), (bf16*)(ws + WS_AV), (bf16*)(ws + WS_BH), (bf16*)(ws + WS_BB), (bf16*)(ws + WS_BC), (bf16*)(ws + WS_CQ), (bf16*)(ws + WS_CKV), (bf16*)(ws + WS_CKR), ssq};
                pg8::gemm_phase<pg8::EpiProj, pg8::StaticOrder, true, true>(ldsl, g, so, E);
            } else if (sub == 1 && EN(2)) {
                int tid_ = threadIdx.x; asm volatile("" : "+v"(tid_)); const int tid = tid_, lane = tid & 63, wave = __builtin_amdgcn_readfirstlane(tid >> 6), gw = blockIdx.x * NWAVES + wave, gt = blockIdx.x * (NWAVES * 64) + tid; (void)gt; (void)gw; (void)lane;
                const bf16* ckr = (const bf16*)(ws + WS_CKR); bf16* km = (bf16*)(ws + WS_KM);
                for (int s0 = gw * 4; s0 < S; s0 += NGW * 4) { const int s = s0 + (lane >> 4), j = lane & 15;
                    const float x1 = bf2f(ckr[s * 32 + j]), x2 = bf2f(ckr[s * 32 + 16 + j]), c = cost[s * 16 + j], sn = sint[s * 16 + j];
                    const unsigned short o1 = (unsigned short)f2bf(x1 * c - x2 * sn), o2 = (unsigned short)f2bf(x2 * c + x1 * sn);
#pragma unroll
                    for (int h = 0; h < 6; ++h) { km[(size_t)s * NUQ + h * 96 + 64 + j] = o1; km[(size_t)s * NUQ + h * 96 + 80 + j] = o2; } }
                { const bf16* Bh = (const bf16*)(ws + WS_BH); const bf16* Bb = (const bf16*)(ws + WS_BB); const bf16* Bc = (const bf16*)(ws + WS_BC); const float* cw = ap->conv_w + (size_t)l * 3 * 512;
                  const int c = lane * 8; float w[3][8];
#pragma unroll
                  for (int i = 0; i < 3; ++i) { const f32x4 u0 = *(const f32x4*)(cw + i * 512 + c), u1 = *(const f32x4*)(cw + i * 512 + c + 4); w[i][0] = u0.x; w[i][1] = u0.y; w[i][2] = u0.z; w[i][3] = u0.w; w[i][4] = u1.x; w[i][5] = u1.y; w[i][6] = u1.z; w[i][7] = u1.w; }
                  for (int t = gw; t < S; t += NGW) {
                      float acc[8] = {0.f, 0.f, 0.f, 0.f, 0.f, 0.f, 0.f, 0.f};
#pragma unroll
                      for (int i = 0; i < 3; ++i) { const int tt = t - 2 + i; if (tt < 0) continue;
                          const v4u hv = *(const v4u*)(Bh + (size_t)tt * 512 + c), cv = *(const v4u*)(Bc + (size_t)tt * 512 + c);
                          acc[0] += w[i][0] * bflo(hv.x) * bflo(cv.x); acc[1] += w[i][1] * bfhi(hv.x) * bfhi(cv.x); acc[2] += w[i][2] * bflo(hv.y) * bflo(cv.y); acc[3] += w[i][3] * bfhi(hv.y) * bfhi(cv.y);
                          acc[4] += w[i][4] * bflo(hv.z) * bflo(cv.z); acc[5] += w[i][5] * bfhi(hv.z) * bfhi(cv.z); acc[6] += w[i][6] * bflo(hv.w) * bflo(cv.w); acc[7] += w[i][7] * bfhi(hv.w) * bfhi(cv.w); }
                      const v4u bv = *(const v4u*)(Bb + (size_t)t * 512 + c); v4u o;
                      o.x = pk2(acc[0] * bflo(bv.x), acc[1] * bfhi(bv.x)); o.y = pk2(acc[2] * bflo(bv.y), acc[3] * bfhi(bv.y)); o.z = pk2(acc[4] * bflo(bv.z), acc[5] * bfhi(bv.z)); o.w = pk2(acc[6] * bflo(bv.w), acc[7] * bfhi(bv.w));
                      *(v4u*)(hb + (size_t)t * DM + 768 + c) = o; } }
                { const bf16* Ak = (const bf16*)(ws + WS_AK); float m0 = 0.f, m1 = 0.f;
                  for (int t = gw; t < S; t += NGW) {
                      const v4u a0 = *(const v4u*)(Ak + (size_t)t * 768 + lane * 8); v4u a1 = {0u, 0u, 0u, 0u}; if (lane < 32) a1 = *(const v4u*)(Ak + (size_t)t * 768 + 512 + lane * 8);
                      float s0 = bflo(a0.x) * bflo(a0.x) + bfhi(a0.x) * bfhi(a0.x) + bflo(a0.y) * bflo(a0.y) + bfhi(a0.y) * bfhi(a0.y) + bflo(a0.z) * bflo(a0.z) + bfhi(a0.z) * bfhi(a0.z) + bflo(a0.w) * bflo(a0.w) + bfhi(a0.w) * bfhi(a0.w);
                      float s1 = bflo(a1.x) * bflo(a1.x) + bfhi(a1.x) * bfhi(a1.x) + bflo(a1.y) * bflo(a1.y) + bfhi(a1.y) * bfhi(a1.y) + bflo(a1.z) * bflo(a1.z) + bfhi(a1.z) * bfhi(a1.z) + bflo(a1.w) * bflo(a1.w) + bfhi(a1.w) * bfhi(a1.w);
#pragma unroll
                      for (int off = 1; off < 8; off <<= 1) { s0 += bperm_f(lane ^ off, s0); s1 += bperm_f(lane ^ off, s1); }
                      m0 = fmaxf(m0, s0); m1 = fmaxf(m1, s1); }
                  if ((lane & 7) == 0) { __hip_atomic_fetch_max(qctr + CW_KN + (lane >> 3), __float_as_uint(m0), __ATOMIC_RELAXED, __HIP_MEMORY_SCOPE_AGENT);
                      if (lane < 32) __hip_atomic_fetch_max(qctr + CW_KN + 8 + (lane >> 3), __float_as_uint(m1), __ATOMIC_RELAXED, __HIP_MEMORY_SCOPE_AGENT); } }
                { pg8::Gemm g{(const bf16*)(ws + WS_CQ), (const bf16*)(ws + WS_WUQ), S, NUQP, CQR}; pg8::StaticOrder so; so.init(S, NUQP, G, (int)blockIdx.x);
                  pg8::EpiQm E{(bf16*)(ws + WS_QM), ssq, cost, sint};
                  pg8::gemm_phase<pg8::EpiQm, pg8::StaticOrder, true, true>(ldsl, g, so, E); }
                { pg8::Gemm g{(const bf16*)(ws + WS_CKV), (const bf16*)(ws + WS_WUKV), S, NUKVP, CKVR}; pg8::StaticOrder so; so.init(S, NUKVP, G, (int)blockIdx.x);
                  pg8::EpiKv E{km, (bf16*)(ws + WS_VC), ssq};
                  pg8::gemm_phase<pg8::EpiKv, pg8::StaticOrder, true, true>(ldsl, g, so, E); }
            } else if (sub == 2 && EN(3)) {
                float lam; { const int lane = lane_id_v(); const float* dl = ap->diff_lambda + (size_t)l * 256;
                  lam = __expf(wave_sum(dl[lane] * dl[64 + lane])) - __expf(wave_sum(dl[128 + lane] * dl[192 + lane])) + lam_init; }
                if (!ATT_NO_DIFF) for (;;) {
                    PTS_BEG(9); if (threadIdx.x == 0) MISC[0] = __hip_atomic_fetch_add(qctr + 64 * (2 * l + 4 * rep), 1u, __ATOMIC_RELAXED, __HIP_MEMORY_SCOPE_AGENT);
                    __syncthreads(); const unsigned u = MISC[0]; __syncthreads(); PTS_END(9);
                    if (u >= 384u) break;
                    const unsigned id = DIFF_ORDER[u]; const int qb = (int)(id >> 3), h = (int)(id & 7u), q0 = qb * 256;
                    att::f32x16 o[4];
                    const float nslope = -LOG2E * __builtin_amdgcn_exp2f(-8.0f * (float)(h + 1) / 6.0f);
                    for (int mp = 0; mp < 2; ++mp) {
                        ATT_CALL_D((LAS char*)ldsl, (const bf16*)(ws + WS_AQ) + h * 128 + mp * 64, 768, (const bf16*)(ws + WS_AK) + h * 128 + mp * 64, 768, (const bf16*)(ws + WS_AV) + h * 128, 768, posf, q0, nslope, sqrtf(__uint_as_float(__hip_atomic_load(qctr + CW_KN + 2 * h + mp, __ATOMIC_RELAXED, __HIP_MEMORY_SCOPE_AGENT))) * 1.0001f, o, tacc);
                        const int ln2 = lane_id_v(), wv2 = __builtin_amdgcn_readfirstlane(threadIdx.x >> 6);
                        float* st = (float*)(ws + WS_STASH) + (((size_t)blockIdx.x * NWAVES + wv2) * 64 + ln2) * 64;
                        if (mp == 0) {
#pragma unroll
                            for (int d0 = 0; d0 < 4; ++d0)
#pragma unroll
                                for (int r = 0; r < 16; r += 4) *(f32x4*)(st + d0 * 16 + r) = (f32x4){o[d0][r], o[d0][r + 1], o[d0][r + 2], o[d0][r + 3]};
                        } else {
                            asm volatile("s_waitcnt vmcnt(0)" ::: "memory");
#pragma unroll
                            for (int d0 = 0; d0 < 4; ++d0)
#pragma unroll
                                for (int r = 0; r < 16; r += 4) { const f32x4 sv = *(const f32x4*)(st + d0 * 16 + r);
#pragma unroll
                                    for (int i = 0; i < 4; ++i) o[d0][r + i] = sv[i] - lam * o[d0][r + i]; }
                        }
                    }
                    const int ln3 = lane_id_v(), r32 = ln3 & 31, hi = ln3 >> 5, wv3 = __builtin_amdgcn_readfirstlane(threadIdx.x >> 6);
                    const float* dng = ap->diff_norm_g + (size_t)l * 128; float gc[4];
#pragma unroll
                    for (int d0 = 0; d0 < 4; ++d0) gc[d0] = dng[d0 * 32 + r32] * (1.0f - lam_init);
#pragma unroll
                    for (int r = 0; r < 16; ++r) { float ss = (o[0][r] * o[0][r] + o[1][r] * o[1][r]) + (o[2][r] * o[2][r] + o[3][r] * o[3][r]);
                        ss += bperm_f(ln3 ^ 1, ss); ss += bperm_f(ln3 ^ 2, ss); ss += bperm_f(ln3 ^ 4, ss); ss += bperm_f(ln3 ^ 8, ss); ss += bperm_f(ln3 ^ 16, ss);
                        const float rs = 1.0f / sqrtf(ss * (1.0f / 128.0f) + RMS_EPS);
#pragma unroll
                        for (int d0 = 0; d0 < 4; ++d0) o[d0][r] *= rs * gc[d0]; }
                    att::store_o_bf16(o, (rep ? (bf16*)(ws + WS_BH) : hb) + (size_t)(q0 + wv3 * 32) * DM + h * 128, DM, r32, hi);
                }
                if (!ATT_NO_MLA) for (;;) {
                    PTS_BEG(9); if (threadIdx.x == 0) MISC[0] = __hip_atomic_fetch_add(qctr + 64 * (2 * l + 1 + 4 * rep), 1u, __ATOMIC_RELAXED, __HIP_MEMORY_SCOPE_AGENT);
                    __syncthreads(); const unsigned u = MISC[0]; __syncthreads(); PTS_END(9);
                    if (u >= 384u) break;
                    const int qb = 63 - (int)(u / 6u), h = (int)(u % 6u), q0 = qb * 256;
                    att::f32x16 o[4];
                    ATT_CALL_M((LAS char*)ldsl, (const bf16*)(ws + WS_QM) + h * 96, NUQ, (const bf16*)(ws + WS_KM) + h * 96, NUQ, (const bf16*)(ws + WS_VC) + h * 128, 768, posf, q0, 0.f, 0.f, o, tacc);
                    const int ln3 = lane_id_v(), r32 = ln3 & 31, hi = ln3 >> 5, wv3 = __builtin_amdgcn_readfirstlane(threadIdx.x >> 6);
                    att::store_o_bf16(o, (rep ? (bf16*)(ws + WS_BH) : hb) + (size_t)(q0 + wv3 * 32) * DM + 1280 + h * 128, DM, r32, hi);
                }
            } else if (sub == 3 && EN(4)) {
                pg8::Gemm g{hb, (const bf16*)(ws + WS_WO), S, DM, DM}; pg8::StaticOrder so; so.init(S, DM, G, (int)blockIdx.x);
                pg8::EpiResid E{l == 0 ? ap->x : (const float*)hres, hres, (const float*)(ws + WS_RS), l == 0 ? ap->ln_in_g : ap->ln2_g + (size_t)(l - 1) * DM, l == 0 ? ap->ln_in_b : ap->ln2_b + (size_t)(l - 1) * DM};
                pg8::gemm_phase<pg8::EpiResid, pg8::StaticOrder, true, true>(ldsl, g, so, E);
            } else if ((sub == 4 || sub == 8) && EN(5)) {
                int tid_ = threadIdx.x; asm volatile("" : "+v"(tid_)); const int tid = tid_, lane = tid & 63, wave = __builtin_amdgcn_readfirstlane(tid >> 6), gw = blockIdx.x * NWAVES + wave, gt = blockIdx.x * (NWAVES * 64) + tid; (void)gt; (void)gw; (void)lane;
                int phl_ = ph; asm volatile("" : "+s"(phl_));
                const int l2 = (phl_ - 1) / 9, sub2 = (phl_ - 1) - 9 * l2;
                const float* g_ = (sub2 == 4 ? ap->ln1_g : ap->ln2_g) + (size_t)l2 * DM; const float* b_ = (sub2 == 4 ? ap->ln1_b : ap->ln2_b) + (size_t)l2 * DM;
                const bool grp_ = G == 256; const int m0_ = grp_ ? 2048 * (int)(blockIdx.x & 7) + (int)(blockIdx.x >> 3) * NWAVES + wave : gw, m1_ = grp_ ? 2048 * (int)(blockIdx.x & 7) + 2048 : S, ms_ = grp_ ? 256 : NGW;
                if (phl_ == 9 * NLAYER) { for (int m = m0_; m < m1_; m += ms_) ln_row<true>(hres + (size_t)m * DM, hres + (size_t)m * DM, nullptr, nullptr, g_, b_, lane); }
                else { for (int m = m0_; m < m1_; m += ms_) ln_row<false>(hres + (size_t)m * DM, nullptr, hb + (size_t)m * DM, (float*)(ws + WS_RS) + 2 * m, g_, b_, lane); }
                if (sub2 == 8 && l2 + 1 < NLAYER) convert_weights(ap, l2 + 1, ws, (LAS float*)(ldsl + wave * 16384), gw, NGW, lane);
            } else if (sub == 5 && EN(6)) {
                pg8::Gemm g{hb, (const bf16*)(ws + WS_WGU), S, 2 * DFF, DM}; pg8::StaticOrder so; so.init(S, 2 * DFF, G, (int)blockIdx.x);
                pg8::EpiGateUp E{(bf16*)(ws + WS_A), ap->ffn_conv_w + (size_t)l * 3 * DFF, (float*)(ws + WS_GS), (float*)(ws + WS_US)};
                pg8::gemm_phase<pg8::EpiGateUp, pg8::StaticOrder, true, true>(ldsl, g, so, E);
            } else if (sub == 6 && EN(7)) {
                int tid_ = threadIdx.x; asm volatile("" : "+v"(tid_)); const int tid = tid_, lane = tid & 63, wave = __builtin_amdgcn_readfirstlane(tid >> 6), gw = blockIdx.x * NWAVES + wave, gt = blockIdx.x * (NWAVES * 64) + tid; (void)gt; (void)gw; (void)lane;
                const float* cw = ap->ffn_conv_w + (size_t)l * 3 * DFF; const float* GS = (const float*)(ws + WS_GS); const float* US = (const float*)(ws + WS_US); bf16* A = (bf16*)(ws + WS_A);
                const bool grp_ = G == 256; const int i0_ = grp_ ? 32 * DFF * (int)(blockIdx.x & 7) + (int)(blockIdx.x >> 3) * (NWAVES * 64) + tid : gt, i1_ = grp_ ? 32 * DFF * ((int)(blockIdx.x & 7) + 1) : (S / 64) * DFF, is_ = grp_ ? 32 * NWAVES * 64 : NGT;
                for (int i = i0_; i < i1_; i += is_) { const int span = i / DFF, ch = i - span * DFF;
                    const float gm2 = span ? GS[((size_t)(span - 1) * 4 + 2) * DFF + ch] : 0.f, gm1 = span ? GS[((size_t)(span - 1) * 4 + 3) * DFF + ch] : 0.f;
                    const float g0 = GS[((size_t)span * 4 + 0) * DFF + ch], g1 = GS[((size_t)span * 4 + 1) * DFF + ch], u0 = US[((size_t)span * 2 + 0) * DFF + ch], u1 = US[((size_t)span * 2 + 1) * DFF + ch];
                    const float w0 = cw[ch], w1 = cw[DFF + ch], w2 = cw[2 * DFF + ch];
                    const float c0 = w0 * gm2 + w1 * gm1 + w2 * g0, c1 = w0 * gm1 + w1 * g0 + w2 * g1;
                    A[(size_t)(span * 64) * DFF + ch] = (bf16)f2bf(c0 * u0 / (1.0f + __expf(-c0)));
                    A[(size_t)(span * 64 + 1) * DFF + ch] = (bf16)f2bf(c1 * u1 / (1.0f + __expf(-c1))); }
            } else if (sub == 7 && EN(8)) {
                pg8::Gemm g{(const bf16*)(ws + WS_A), (const bf16*)(ws + WS_WDN), S, DM, DFF}; pg8::StaticOrder so; so.init(S, DM, G, (int)blockIdx.x);
                pg8::EpiResid E{hres, hres, (const float*)(ws + WS_RS), ap->ln1_g + (size_t)l * DM, ap->ln1_b + (size_t)l * DM};
                pg8::gemm_phase<pg8::EpiResid, pg8::StaticOrder, true, true>(ldsl, g, so, E);
            }
        }
        if (pi + 1 < NPROG) {
            if (pi == 0) { grid.sync(); (void)xcd_barrier_post(qctr + CW_BAR, MISC + 8); }
            else { const int sb_ = ph > 0 ? (ph - 1) % 9 : -1, ll_ = ph > 0 ? (ph - 1) / 9 : 0;
                const int li_ = sb_ == 3 ? 1 : sb_ == 4 ? 2 : sb_ == 6 ? 3 : (sb_ == 7 && ll_ + 1 == NLAYER) ? 4 : 0;
                if (PROBE_SUB < 0 && G == 256 && li_ != 0) grp_barrier(qctr + CW_GRP + 64 * (blockIdx.x & 7), 32u * (unsigned)(3 * ll_ + li_));
                else { XcdBarrier xb_; xb_.bar = qctr + CW_BAR; xb_.x = xb_xcc_id(); xb_.st = MISC + 8; xcd_barrier(xb_); } }
        }
    }
    if (PROBE_TSEC != 0 && blockIdx.x == 0 && __builtin_amdgcn_readfirstlane(threadIdx.x >> 6) == PROBE_WAVE) {
        const unsigned long long t0 = __builtin_readcyclecounter(); while (__builtin_readcyclecounter() - t0 < tacc) __builtin_amdgcn_s_sleep(1); }
}

extern "C" void kernel_launch(void* const* d_in, const int* in_sizes, int n_in, void* d_out, int out_size, void* d_ws, size_t ws_size, hipStream_t stream) {
    static int grid = 0;
    if (grid == 0) {
        if (n_in != 21 || in_sizes[0] != S * DM || out_size != S * DM || ws_size < WS_END) { fprintf(stderr, "kernel_launch: unexpected shapes (n_in %d, in0 %d, out %d, ws %zu < %zu)\n", n_in, n_in > 0 ? in_sizes[0] : -1, out_size, ws_size, (size_t)WS_END); grid = -1; return; }
        int dev = 0, cus = 0, per_cu = 0;
        if (hipGetDevice(&dev) != hipSuccess || hipDeviceGetAttribute(&cus, hipDeviceAttributeMultiprocessorCount, dev) != hipSuccess) { grid = -1; return; }
        if (hipFuncSetAttribute((const void*)mk_fwd, hipFuncAttributeMaxDynamicSharedMemorySize, LDS_BYTES) != hipSuccess) { fprintf(stderr, "kernel_launch: hipFuncSetAttribute failed\n"); grid = -1; return; }
        if (hipOccupancyMaxActiveBlocksPerMultiprocessor(&per_cu, (const void*)mk_fwd, NWAVES * 64, LDS_BYTES) != hipSuccess || per_cu < 1) { fprintf(stderr, "kernel_launch: occupancy query says %d\n", per_cu); per_cu = 1; }
        (void)hipGetLastError();
        grid = cus * per_cu;
    }
    if (grid < 0) return;
    Args a{};
    a.x = (const float*)d_in[0]; a.pos = (const int*)d_in[1]; a.ln_in_g = (const float*)d_in[2]; a.ln_in_b = (const float*)d_in[3]; a.w_in = (const float*)d_in[4]; a.diff_lambda = (const float*)d_in[5];
    a.diff_norm_g = (const float*)d_in[6]; a.conv_w = (const float*)d_in[7]; a.mla_q_norm_g = (const float*)d_in[8]; a.mla_kv_norm_g = (const float*)d_in[9]; a.w_uq = (const float*)d_in[10]; a.w_ukv = (const float*)d_in[11];
    a.w_o = (const float*)d_in[12]; a.ln1_g = (const float*)d_in[13]; a.ln1_b = (const float*)d_in[14]; a.ffn_w_gate = (const float*)d_in[15]; a.ffn_w_up = (const float*)d_in[16]; a.ffn_conv_w = (const float*)d_in[17];
    a.ffn_w_down = (const float*)d_in[18]; a.ln2_g = (const float*)d_in[19]; a.ln2_b = (const float*)d_in[20];
    a.out = (float*)d_out; a.ws = (unsigned char*)d_ws; a.ph_lo = 0; a.ph_hi = 1 + 9 * NLAYER;
    void* args[] = {&a};
    const hipError_t e = hipLaunchCooperativeKernel((const void*)mk_fwd, dim3(grid), dim3(NWAVES * 64), args, LDS_BYTES, stream);
    if (e != hipSuccess) fprintf(stderr, "kernel_launch: cooperative launch failed: %s (grid %d)\n", hipGetErrorString(e), grid);
}
```

```cpp
#define PROBE_SUB -1
#define PROBE_VAR 0
#define PROBE_TSEC 0
#define PROBE_WAVE 0
#include <hip/hip_runtime.h>
#include <hip/hip_cooperative_groups.h>
#include <cstdio>
#include <cstdint>
namespace cg = cooperative_groups;

constexpr int S = 16384, DM = 2048, NLAYER = 2, PIN = 4640, PINP = 4864, DFF = 5632;
constexpr int CQR = 512, CKVR = 256, NUQ = 576, NUQP = 768, NUKV = 1152, NUKVP = 1280;
constexpr float LN_EPS = 1e-5f, RMS_EPS = 1e-6f;
constexpr float ALPHA_DN = 1.4142135623730951f;
constexpr float LOG2E = 1.4426950408889634f;
constexpr float QSCALE_A = 0.125f * LOG2E;
constexpr float QSCALE_C = 0.10206207261596577f * LOG2E;
__device__ __forceinline__ int lane_id_v() { int l; asm volatile("v_mbcnt_lo_u32_b32 %0, -1, 0\n\tv_mbcnt_hi_u32_b32 %0, -1, %0" : "=v"(l)); return l; }
__device__ __forceinline__ float bperm_f(int src_lane, float v) { return __builtin_bit_cast(float, __builtin_amdgcn_ds_bpermute(src_lane << 2, __builtin_bit_cast(int, v))); }
namespace pg8 {
#define PG8_LAS __attribute__((address_space(3)))
typedef unsigned short bf16_t;
typedef short bf16x8 __attribute__((ext_vector_type(8)));
typedef float f32x4 __attribute__((ext_vector_type(4)));
typedef unsigned u32x4 __attribute__((ext_vector_type(4)));
constexpr int BM = 256, BK = 64, HALF = 128, HTB = HALF * BK * 2  , STAGE_BYTES = 8 * HTB, NXCD = 8, WGM = 8;

__host__ __device__ __forceinline__ int lds_byte(int r, int c) { const int st = (r >> 4) * 2 + (c >> 5), rr = r & 15, cc = c & 31, ob = rr * 64 + cc * 2; return st * 1024 + (ob ^ (((ob >> 9) & 1) << 5)); }
__host__ __device__ __forceinline__ void stage_rc(int b, int& R, int& C) { const int st = b / 1024, sb = b % 1024, swz = sb ^ (((sb >> 9) & 1) << 5); R = (st >> 1) * 16 + swz / 64; C = (st & 1) * 32 + (swz % 64) / 2; }
__host__ __device__ __forceinline__ int perm32(int rho) { const int n = rho >> 4, i = rho & 15; return 8 * (i >> 2) + 4 * n + (i & 3); }

struct Unit { int pm, pn; };
struct Gemm { const bf16_t* A; const bf16_t* Bt; int M, N, K; };

struct StaticOrder {
    int nM, nN, nwg, G, c;
    __host__ __device__ void init(int M, int N, int G_, int c_) { nM = M / BM; nN = N / BM; nwg = nM * nN; G = G_; c = c_; }
    __host__ __device__ bool next(int i, Unit& u) const {
        const long L = (long)i * G + c; if (L >= nwg) return false;
        int wgid = (int)L; { const int q = nwg / NXCD, r = nwg % NXCD, xcd = wgid % NXCD, off = wgid / NXCD; wgid = (xcd < r ? xcd * (q + 1) : r * (q + 1) + (xcd - r) * q) + off; }
        const int nig = WGM * nN, gid = wgid / nig, fm = gid * WGM, gsz = (nM - fm) < WGM ? (nM - fm) : WGM;
        u.pm = fm + ((wgid % nig) % gsz); u.pn = (wgid % nig) / gsz; return true;
    }
    __device__ __forceinline__ void a_ready(const Unit&) const {}
    __device__ __forceinline__ void done(const Unit&) const {}
};

__device__ __forceinline__ unsigned cvt_pk_bf16(float lo, float hi) { unsigned r; asm volatile("v_cvt_pk_bf16_f32 %0, %1, %2" : "=v"(r) : "v"(lo), "v"(hi)); return r; }
typedef float f32x2 __attribute__((ext_vector_type(2)));
template <class Epi, class Sched, bool ALIGN_EPI = false, bool SP2 = false>
__device__ __forceinline__ void gemm_phase(PG8_LAS unsigned char* lds, const Gemm g, const Sched& S, const Epi& E) {
    int tid_ = threadIdx.x; asm volatile("" : "+v"(tid_));
    const int tid = tid_, wid = __builtin_amdgcn_readfirstlane(tid >> 6), lane = tid & 63, wr = wid >> 2, wc = wid & 3, fr = lane & 15, fq = lane >> 4;
    const int K = g.K, nt = K / BK;
    unsigned voffA[2], voffB[2];
#pragma unroll
    for (int i = 0; i < 2; ++i) { int R, C; stage_rc(tid * 16 + i * 8192, R, C); const int Rb = Epi::PERM ? ((R & ~31) + perm32(R & 31)) : R;
        voffA[i] = (unsigned)(R * K + C) * 2u; voffB[i] = (unsigned)(Rb * K + C) * 2u; }
    const size_t kstep = (size_t)(BK * 2);
    const size_t hstep = (size_t)HALF * K * 2;
    const size_t tstep = 2 * hstep;
    const unsigned ldsw = (unsigned)wid * 1024u;
    const int aoff = lds_byte(wr * 64 + fr, fq * 8), boff = lds_byte(wc * 32 + fr, fq * 8);
#define PG8_SA(b, h) (((b) * 2 + (h)) * HTB)
#define PG8_SB(b, h) ((4 + (b) * 2 + (h)) * HTB)
#define PG8_STAGE(bufoff, gbase, voff) do { _Pragma("unroll") for (int _i = 0; _i < 2; ++_i) \
        __builtin_amdgcn_global_load_lds((const unsigned*)((const char*)(gbase) + (voff)[_i]), (PG8_LAS unsigned*)(lds + (bufoff) + ldsw + _i * 8192), 16, 0, 0); } while (0)
#define PG8_LDA(dst, b, h) do { _Pragma("unroll") for (int m = 0; m < 4; ++m) _Pragma("unroll") for (int k = 0; k < 2; ++k) dst[m][k] = *(const PG8_LAS bf16x8*)(lds + PG8_SA(b, h) + aoff + m * 2048 + k * 1024); } while (0)
#define PG8_LDB(dst, b, h) do { _Pragma("unroll") for (int n = 0; n < 2; ++n) _Pragma("unroll") for (int k = 0; k < 2; ++k) dst[n][k] = *(const PG8_LAS bf16x8*)(lds + PG8_SB(b, h) + boff + n * 2048 + k * 1024); } while (0)
#define PG8_MMA(ai, bj, At, Bt) do { __builtin_amdgcn_s_setprio(1); _Pragma("unroll") for (int m = 0; m < 4; ++m) _Pragma("unroll") for (int n = 0; n < 2; ++n) _Pragma("unroll") for (int k = 0; k < 2; ++k) \
        acc[ai][bj][m][n] = __builtin_amdgcn_mfma_f32_16x16x32_bf16(Bt[n][k], At[m][k], acc[ai][bj][m][n], 0, 0, 0); __builtin_amdgcn_s_setprio(0); } while (0)
#define PG8_WAIT_V(n) asm volatile("s_waitcnt vmcnt(" #n ")" ::: "memory")
#define PG8_WAIT_L(n) asm volatile("s_waitcnt lgkmcnt(" #n ")" ::: "memory")
#define PG8_BAR __builtin_amdgcn_s_barrier()
#define PG8_SCHED __builtin_amdgcn_sched_barrier(0)
    Unit cur, nxt; int ui = 0;
    if (!S.next(0, cur)) return;
    f32x4 acc[2][2][4][2];
#pragma unroll
    for (int a = 0; a < 2; ++a)
#pragma unroll
        for (int b = 0; b < 2; ++b)
#pragma unroll
            for (int m = 0; m < 4; ++m)
#pragma unroll
                for (int n = 0; n < 2; ++n) acc[a][b][m][n] = (f32x4){0.f, 0.f, 0.f, 0.f};
    bf16x8 At[4][2], B0[2][2], B1[2][2];
    const char* cA = (const char*)g.A + (size_t)cur.pm * tstep; const char* cB = (const char*)g.Bt + (size_t)cur.pn * tstep;
    S.a_ready(cur);
    if constexpr (SP2) {
        PG8_STAGE(PG8_SB(0, 0), cB, voffB); PG8_STAGE(PG8_SB(0, 1), cB + hstep, voffB); PG8_STAGE(PG8_SA(0, 0), cA, voffA); PG8_STAGE(PG8_SA(0, 1), cA + hstep, voffA);
        if (wr == 1) PG8_BAR;
        PG8_WAIT_V(2); PG8_BAR;
        PG8_STAGE(PG8_SB(1, 0), cB + kstep, voffB); PG8_STAGE(PG8_SA(1, 0), cA + kstep, voffA); PG8_STAGE(PG8_SB(1, 1), cB + hstep + kstep, voffB);
        PG8_WAIT_V(6); PG8_BAR;
    } else {
        PG8_STAGE(PG8_SB(0, 0), cB, voffB); PG8_STAGE(PG8_SA(0, 0), cA, voffA); PG8_STAGE(PG8_SB(0, 1), cB + hstep, voffB); PG8_STAGE(PG8_SA(0, 1), cA + hstep, voffA);
        if (wr == 1) PG8_BAR;
        PG8_WAIT_V(4); PG8_BAR;
        PG8_STAGE(PG8_SB(1, 0), cB + kstep, voffB); PG8_STAGE(PG8_SA(1, 0), cA + kstep, voffA); PG8_STAGE(PG8_SB(1, 1), cB + hstep + kstep, voffB);
        PG8_WAIT_V(6); PG8_BAR;
    }
    for (;;) {
        const bool has_next = S.next(ui + 1, nxt);
        const char* nA = has_next ? (const char*)g.A + (size_t)nxt.pm * tstep : cA; const char* nB = has_next ? (const char*)g.Bt + (size_t)nxt.pn * tstep : cB;
        for (int t = 0; t < nt; t += 2) {
            const bool last = (t == nt - 2);
            const char* a1 = cA + (size_t)(t + 1) * kstep;
            const char* a2 = last ? nA : cA + (size_t)(t + 2) * kstep; const char* b2 = last ? nB : cB + (size_t)(t + 2) * kstep;
            const char* a3 = a2 + kstep; const char* b3 = b2 + kstep;
            if (last && has_next) S.a_ready(nxt);
            if constexpr (SP2) {
            PG8_LDB(B0, 0, 0); PG8_LDB(B1, 0, 1); PG8_SCHED; PG8_LDA(At, 0, 0); PG8_STAGE(PG8_SA(1, 1), a1 + hstep, voffA);
            PG8_WAIT_V(8); PG8_WAIT_L(0); PG8_BAR; PG8_MMA(0, 0, At, B0); PG8_MMA(0, 1, At, B1); PG8_BAR; PG8_SCHED;
            PG8_LDA(At, 0, 1); PG8_STAGE(PG8_SB(0, 0), b2, voffB); PG8_STAGE(PG8_SB(0, 1), b2 + hstep, voffB); PG8_STAGE(PG8_SA(0, 0), a2, voffA);
            PG8_WAIT_V(8); PG8_WAIT_L(0); PG8_BAR; PG8_MMA(1, 0, At, B0); PG8_MMA(1, 1, At, B1); PG8_BAR; PG8_SCHED;
            PG8_LDB(B0, 1, 0); PG8_LDB(B1, 1, 1); PG8_SCHED; PG8_LDA(At, 1, 0); PG8_STAGE(PG8_SA(0, 1), a2 + hstep, voffA);
            PG8_WAIT_V(8); PG8_WAIT_L(0); PG8_BAR; PG8_MMA(0, 0, At, B0); PG8_MMA(0, 1, At, B1); PG8_BAR; PG8_SCHED;
            PG8_LDA(At, 1, 1); PG8_STAGE(PG8_SB(1, 0), b3, voffB); PG8_STAGE(PG8_SB(1, 1), b3 + hstep, voffB); PG8_STAGE(PG8_SA(1, 0), a3, voffA);
            PG8_WAIT_V(8); PG8_WAIT_L(0); PG8_BAR; PG8_MMA(1, 0, At, B0); PG8_MMA(1, 1, At, B1); PG8_BAR; PG8_SCHED;
            } else {
            PG8_LDB(B0, 0, 0); PG8_SCHED; PG8_LDA(At, 0, 0); PG8_STAGE(PG8_SA(1, 1), a1 + hstep, voffA);
            PG8_WAIT_L(8); PG8_BAR; PG8_WAIT_L(0); PG8_MMA(0, 0, At, B0); PG8_BAR; PG8_SCHED;
            PG8_LDB(B1, 0, 1); PG8_STAGE(PG8_SB(0, 0), b2, voffB);
            PG8_BAR; PG8_WAIT_L(0); PG8_MMA(0, 1, At, B1); PG8_BAR;
            PG8_LDA(At, 0, 1); PG8_STAGE(PG8_SA(0, 0), a2, voffA);
            PG8_BAR; PG8_WAIT_L(0); PG8_MMA(1, 0, At, B0); PG8_BAR; PG8_SCHED;
            PG8_STAGE(PG8_SB(0, 1), b2 + hstep, voffB);
            PG8_WAIT_V(6); PG8_BAR; PG8_MMA(1, 1, At, B1); PG8_BAR;
            PG8_LDB(B0, 1, 0); PG8_SCHED; PG8_LDA(At, 1, 0); PG8_STAGE(PG8_SA(0, 1), a2 + hstep, voffA);
            PG8_WAIT_L(8); PG8_BAR; PG8_WAIT_L(0); PG8_MMA(0, 0, At, B0); PG8_BAR; PG8_SCHED;
            PG8_LDB(B1, 1, 1); PG8_STAGE(PG8_SB(1, 0), b3, voffB);
            PG8_BAR; PG8_WAIT_L(0); PG8_MMA(0, 1, At, B1); PG8_BAR;
            PG8_LDA(At, 1, 1); PG8_STAGE(PG8_SA(1, 0), a3, voffA);
            PG8_BAR; PG8_WAIT_L(0); PG8_MMA(1, 0, At, B0); PG8_BAR; PG8_SCHED;
            PG8_STAGE(PG8_SB(1, 1), b3 + hstep, voffB);
            PG8_WAIT_V(6); PG8_BAR; PG8_MMA(1, 1, At, B1); PG8_BAR;
            }
        }
        if constexpr (ALIGN_EPI) { if (wr == 0) PG8_BAR; }
        if constexpr (!Epi::AFTER_DRAIN) { E(acc, cur, wr, wc, fr, fq); S.done(cur); }
        if (!has_next) break;
#pragma unroll
        for (int a = 0; a < 2; ++a)
#pragma unroll
            for (int b = 0; b < 2; ++b)
#pragma unroll
                for (int m = 0; m < 4; ++m)
#pragma unroll
                    for (int n = 0; n < 2; ++n) acc[a][b][m][n] = (f32x4){0.f, 0.f, 0.f, 0.f};
        cur = nxt; cA = nA; cB = nB; ++ui;
        if constexpr (ALIGN_EPI) { if (wr == 1) PG8_BAR; }
    }
    PG8_WAIT_V(0);
    if constexpr (!ALIGN_EPI) { if (wr == 0) PG8_BAR; }
    PG8_BAR;
    if constexpr (Epi::AFTER_DRAIN) { E.fused(acc, cur, wr, wc, fr, fq, lds, wid, lane); S.done(cur); }
#undef PG8_SA
#undef PG8_SB
#undef PG8_STAGE
#undef PG8_LDA
#undef PG8_LDB
#undef PG8_MMA
#undef PG8_WAIT_V
#undef PG8_WAIT_L
#undef PG8_BAR
#undef PG8_SCHED
}
}

namespace pg8 {
__device__ __forceinline__ u32x4 pack8(const f32x4 a, const f32x4 b, float sc) {
    u32x4 w; w.x = cvt_pk_bf16(a[0] * sc, a[1] * sc); w.y = cvt_pk_bf16(a[2] * sc, a[3] * sc); w.z = cvt_pk_bf16(b[0] * sc, b[1] * sc); w.w = cvt_pk_bf16(b[2] * sc, b[3] * sc); return w;
}
struct EpiProj {
    static constexpr bool PERM = true, AFTER_DRAIN = false;
    bf16_t *Aq, *Ak, *Av, *Bh, *Bb, *Bc, *cq, *ckv, *ckr; float* ssq;
    __device__ __forceinline__ void operator()(const f32x4 (&acc)[2][2][4][2], const Unit& u, int wr, int wc, int fr_, int fq_) const {
        const int ln_ = lane_id_v(), fr = ln_ & 15, fq = ln_ >> 4; (void)fr_; (void)fq_;
        const int pn = u.pn; bf16_t* base; int ldc, colt, ssqi = -1, valid = 256; float sc = 1.f;
        if (pn < 3) { base = Aq; ldc = 768; colt = pn * 256; sc = QSCALE_A; }
        else if (pn < 6) { base = Ak; ldc = 768; colt = (pn - 3) * 256; }
        else if (pn < 9) { base = Av; ldc = 768; colt = (pn - 6) * 256; }
        else if (pn < 11) { base = Bh; ldc = 512; colt = (pn - 9) * 256; }
        else if (pn < 13) { base = Bb; ldc = 512; colt = (pn - 11) * 256; }
        else if (pn < 15) { base = Bc; ldc = 512; colt = (pn - 13) * 256; }
        else if (pn < 17) { base = cq; ldc = 512; colt = (pn - 15) * 256; ssqi = (pn - 15) * 4 + wc; }
        else if (pn < 18) { base = ckv; ldc = 256; colt = 0; ssqi = 8 + wc; }
        else { base = ckr; ldc = 32; colt = 0; valid = 32; }
        const int row0 = u.pm * BM + wr * 64 + fr, cl = wc * 32 + 8 * fq;
#pragma unroll
        for (int ai = 0; ai < 2; ++ai)
#pragma unroll
            for (int m = 0; m < 4; ++m) {
                const int row = row0 + ai * HALF + m * 16; bf16_t* rowp = base + (size_t)row * ldc + colt + cl;
                float q = 0.f;
#pragma unroll
                for (int bj = 0; bj < 2; ++bj) {
                    const f32x4 v0 = acc[ai][bj][m][0], v1 = acc[ai][bj][m][1];
                    q += (v0[0] * v0[0] + v0[1] * v0[1]) + (v0[2] * v0[2] + v0[3] * v0[3]) + (v1[0] * v1[0] + v1[1] * v1[1]) + (v1[2] * v1[2] + v1[3] * v1[3]);
                    if (cl + bj * HALF < valid) *(u32x4*)(rowp + bj * HALF) = pack8(v0, v1, sc);
                }
                if (ssqi >= 0) { q += bperm_f(ln_ ^ 16, q); q += bperm_f(ln_ ^ 32, q); if (fq == 0) ssq[(size_t)row * 12 + ssqi] = q; }
            }
    }
};
struct EpiQm {
    static constexpr bool PERM = true, AFTER_DRAIN = false;
    bf16_t* qm; const float* ssq; const float* cost; const float* sint;
    __device__ __forceinline__ void operator()(const f32x4 (&acc)[2][2][4][2], const Unit& u, int wr, int wc, int fr_, int fq_) const {
        const int ln_ = lane_id_v(), fr = ln_ & 15, fq = ln_ >> 4; (void)fr_; (void)fq_;
        const int row0 = u.pm * BM + wr * 64 + fr;
#pragma unroll
        for (int ai = 0; ai < 2; ++ai)
#pragma unroll
            for (int m = 0; m < 4; ++m) {
                const int row = row0 + ai * HALF + m * 16;
                const f32x4 s0 = *(const f32x4*)(ssq + (size_t)row * 12), s1 = *(const f32x4*)(ssq + (size_t)row * 12 + 4);
                const float rq = 1.0f / sqrtf((((s0[0] + s0[1]) + (s0[2] + s0[3])) + ((s1[0] + s1[1]) + (s1[2] + s1[3]))) * (1.0f / CQR) + RMS_EPS);
#pragma unroll
                for (int bj = 0; bj < 2; ++bj) {
                    const int g32 = u.pn * 8 + bj * 4 + wc;
                    if (g32 >= NUQ / 32) continue;
                    f32x4 v0 = acc[ai][bj][m][0] * rq, v1 = acc[ai][bj][m][1] * rq;
                    if (g32 % 3 == 2) {
                        f32x4 p0, p1;
#pragma unroll
                        for (int i = 0; i < 4; ++i) { p0[i] = bperm_f(ln_ ^ 32, v0[i]); p1[i] = bperm_f(ln_ ^ 32, v1[i]); }
                        const int j0 = (fq & 1) * 8;
                        const f32x4 c0 = *(const f32x4*)(cost + (size_t)row * 16 + j0), c1 = *(const f32x4*)(cost + (size_t)row * 16 + j0 + 4);
                        f32x4 n0 = *(const f32x4*)(sint + (size_t)row * 16 + j0), n1 = *(const f32x4*)(sint + (size_t)row * 16 + j0 + 4);
                        if (fq < 2) { n0 = -n0; n1 = -n1; }
                        v0 = v0 * c0 + p0 * n0; v1 = v1 * c1 + p1 * n1;
                    }
                    *(u32x4*)(qm + (size_t)row * NUQ + g32 * 32 + 8 * fq) = pack8(v0, v1, QSCALE_C);
                }
            }
    }
};
struct EpiKv {
    static constexpr bool PERM = true, AFTER_DRAIN = false;
    bf16_t* km; bf16_t* vc; const float* ssq;
    __device__ __forceinline__ void operator()(const f32x4 (&acc)[2][2][4][2], const Unit& u, int wr, int wc, int fr_, int fq_) const {
        const int ln_ = lane_id_v(), fr = ln_ & 15, fq = ln_ >> 4; (void)fr_; (void)fq_;
        const int row0 = u.pm * BM + wr * 64 + fr;
#pragma unroll
        for (int ai = 0; ai < 2; ++ai)
#pragma unroll
            for (int m = 0; m < 4; ++m) {
                const int row = row0 + ai * HALF + m * 16;
                const f32x4 s0 = *(const f32x4*)(ssq + (size_t)row * 12 + 8);
                const float rk = 1.0f / sqrtf(((s0[0] + s0[1]) + (s0[2] + s0[3])) * (1.0f / CKVR) + RMS_EPS);
#pragma unroll
                for (int bj = 0; bj < 2; ++bj) {
                    const int c8 = u.pn * 256 + bj * HALF + wc * 32 + 8 * fq;
                    if (c8 >= NUKV) continue;
                    bf16_t* dst = (c8 < 384) ? km + (size_t)row * NUQ + (c8 >> 6) * 96 + (c8 & 63) : vc + (size_t)row * 768 + (c8 - 384);
                    *(u32x4*)dst = pack8(acc[ai][bj][m][0], acc[ai][bj][m][1], rk);
                }
            }
    }
};
struct EpiResid {
    static constexpr bool PERM = false, AFTER_DRAIN = false;
    const float* src; float* out; const float* rs; const float* g; const float* b;
    __device__ __forceinline__ void operator()(const f32x4 (&acc)[2][2][4][2], const Unit& u, int wr, int wc, int fr_, int fq_) const {
        const int ln_ = lane_id_v(), fr = ln_ & 15, fq = ln_ >> 4; (void)fr_; (void)fq_;
        const int row0 = u.pm * BM + wr * 64 + fr, col0 = u.pn * BM + wc * 32 + 4 * fq;
#pragma unroll
        for (int bj = 0; bj < 2; ++bj)
#pragma unroll
            for (int n = 0; n < 2; ++n) {
                const int col = col0 + bj * HALF + n * 16;
                const f32x4 gv = *(const f32x4*)(g + col), bv = *(const f32x4*)(b + col);
#pragma unroll
                for (int ai = 0; ai < 2; ++ai)
#pragma unroll
                    for (int m = 0; m < 4; ++m) {
                        const size_t row = (size_t)(row0 + ai * HALF + m * 16);
                        const f32x4 t = *(const f32x4*)(src + row * DM + col); const f32x2 st = *(const f32x2*)(rs + row * 2);
                        const f32x4 h = (t - st.x) * st.y * gv + bv;
                        *(f32x4*)(out + row * DM + col) = h * ALPHA_DN + acc[ai][bj][m][n];
                    }
                asm volatile("" ::: "memory");
            }
    }
};
struct EpiGateUp {
    static constexpr bool PERM = true, AFTER_DRAIN = false;
    bf16_t* a; const float* cw; float* GS; float* US;
    __device__ __forceinline__ void operator()(const f32x4 (&acc)[2][2][4][2], const Unit& u, int wr, int wc, int fr_, int fq_) const {
        const int ln_ = lane_id_v(), fr = ln_ & 15, fq = ln_ >> 4; (void)fr_; (void)fq_;
        const int ch0 = u.pn * 128 + wc * 32 + 8 * fq, lane = fq * 16 + fr;
        const int src1 = (lane & 48) | ((fr - 1) & 15), src2 = (lane & 48) | ((fr - 2) & 15);
        f32x4 w0[2], w1[2], w2[2];
#pragma unroll
        for (int n = 0; n < 2; ++n) { w0[n] = *(const f32x4*)(cw + ch0 + 4 * n); w1[n] = *(const f32x4*)(cw + DFF + ch0 + 4 * n); w2[n] = *(const f32x4*)(cw + 2 * DFF + ch0 + 4 * n); }
#pragma unroll
        for (int ai = 0; ai < 2; ++ai) {
            const int span = u.pm * 4 + ai * 2 + wr;
            f32x4 q1[2] = {(f32x4){0.f, 0.f, 0.f, 0.f}, (f32x4){0.f, 0.f, 0.f, 0.f}}, q2[2] = {(f32x4){0.f, 0.f, 0.f, 0.f}, (f32x4){0.f, 0.f, 0.f, 0.f}};
#pragma unroll
            for (int m = 0; m < 4; ++m) {
                f32x4 o[2];
#pragma unroll
                for (int n = 0; n < 2; ++n) {
                    const f32x4 g = acc[ai][0][m][n], up = acc[ai][1][m][n]; f32x4 s1, s2;
#pragma unroll
                    for (int i = 0; i < 4; ++i) { s1[i] = bperm_f(src1, g[i]); s2[i] = bperm_f(src2, g[i]); }
                    f32x4 p1, p2;
#pragma unroll
                    for (int i = 0; i < 4; ++i) { p1[i] = fr >= 1 ? s1[i] : q1[n][i]; p2[i] = fr >= 2 ? s2[i] : q2[n][i]; }
                    q1[n] = s1; q2[n] = s2;
                    const f32x4 cv = w0[n] * p2 + w1[n] * p1 + w2[n] * g;
#pragma unroll
                    for (int i = 0; i < 4; ++i) o[n][i] = cv[i] * up[i] * __builtin_amdgcn_rcpf(1.0f + __builtin_amdgcn_exp2f(-LOG2E * cv[i]));
                    if (m == 0 && fr < 2) { *(f32x4*)(GS + ((size_t)span * 4 + fr) * DFF + ch0 + 4 * n) = g; *(f32x4*)(US + ((size_t)span * 2 + fr) * DFF + ch0 + 4 * n) = up; }
                    if (m == 3 && fr >= 14) *(f32x4*)(GS + ((size_t)span * 4 + fr - 12) * DFF + ch0 + 4 * n) = g;
                }
                const int row = u.pm * BM + ai * HALF + wr * 64 + m * 16 + fr;
                *(u32x4*)(a + (size_t)row * DFF + ch0) = pack8(o[0], o[1], 1.0f);
            }
        }
    }
};
}

namespace att {
typedef unsigned short bf16_t;
typedef short bf16x8 __attribute__((ext_vector_type(8)));
typedef short s16x4 __attribute__((ext_vector_type(4)));
typedef float f32x16 __attribute__((ext_vector_type(16)));
typedef float f32x4 __attribute__((ext_vector_type(4)));
typedef unsigned u32x4 __attribute__((ext_vector_type(4)));
#define SBAR() __builtin_amdgcn_sched_barrier(0)
#define ALAS __attribute__((address_space(3)))
constexpr int SHM_V = 64 * 128 * 2, SHM_KMAX = 64 * (96 * 2 + 16);
constexpr int L_V = 0, L_K = 2 * SHM_V, L_POS = L_K + 2 * SHM_KMAX, L_WS = L_POS + 2 * 80 * 4, L_XCH = L_WS + 8 * 64 * 4, L_END = L_XCH + 8 * 2 * 4;
#ifndef PROBE_TSEC
#define PROBE_TSEC 0
#endif
#ifndef PROBE_WAVE
#define PROBE_WAVE 0
#endif
constexpr float THR = 8.f;
constexpr int S_TMAX_OFF = 16384, S_PMAX_OFF = 16384 + 256;
constexpr float SKIP_T = 32.f;
__device__ __forceinline__ int v_st(int k, int c) { const int kk = (k & ~0xC) | ((k & 4) << 1) | ((k & 8) >> 1); return ((kk >> 3) * 4 + (c >> 5)) * 512 + ((kk & 7) * 32 + (c & 31)) * 2; }
__device__ __forceinline__ int v_rd_base(int lane) { return ((lane & 3) << 3) | (((lane >> 2) & 3) << 6) | (((lane >> 4) & 1) << 5) | (((lane >> 5) & 1) << 8); }
constexpr int v_rd_off(int d0, int ks, int half) { return d0 * 512 + ks * 4096 + half * 2048; }
__device__ __forceinline__ int crow(int r, int hi) { return (r & 3) + 8 * (r >> 2) + 4 * hi; }
__device__ __forceinline__ unsigned cvtpk(float lo, float hi) { unsigned r; asm volatile("v_cvt_pk_bf16_f32 %0, %1, %2" : "=v"(r) : "v"(lo), "v"(hi)); return r; }

template <int DQK, bool ALIBI>
__device__ __forceinline__ void qkt(f32x16& p0, f32x16& p1, const ALAS char* kb, const bf16x8* qr, const ALAS float* pk, float tmax, float rowc, float m_reg, float qmin, const f32x16& negm, int hi) {
    constexpr int KP = DQK * 2 + 16;
    if (ALIBI) {
        if (tmax <= qmin) {
            const float base = rowc - m_reg;
#pragma unroll
            for (int g = 0; g < 4; ++g) {
                const f32x4 k0 = *(const ALAS f32x4*)(pk + 8 * g + 4 * hi), k1 = *(const ALAS f32x4*)(pk + 32 + 8 * g + 4 * hi);
#pragma unroll
                for (int i = 0; i < 4; ++i) { p0[4 * g + i] = base + k0[i]; p1[4 * g + i] = base + k1[i]; }
            }
        } else {
#pragma unroll
            for (int g = 0; g < 4; ++g) {
                const f32x4 k0 = *(const ALAS f32x4*)(pk + 8 * g + 4 * hi), k1 = *(const ALAS f32x4*)(pk + 32 + 8 * g + 4 * hi);
#pragma unroll
                for (int i = 0; i < 4; ++i) { p0[4 * g + i] = -fabsf(rowc + k0[i]) - m_reg; p1[4 * g + i] = -fabsf(rowc + k1[i]) - m_reg; }
            }
        }
    }
#pragma unroll
    for (int d0 = 0; d0 < DQK / 16; ++d0) {
        const bf16x8 b0 = *(const ALAS bf16x8*)(kb + d0 * 32);
        const bf16x8 b1 = *(const ALAS bf16x8*)(kb + 32 * KP + d0 * 32);
        if (!ALIBI && d0 == 0) { p0 = __builtin_amdgcn_mfma_f32_32x32x16_bf16(b0, qr[0], negm, 0, 0, 0); p1 = __builtin_amdgcn_mfma_f32_32x32x16_bf16(b1, qr[0], negm, 0, 0, 0); }
        else { p0 = __builtin_amdgcn_mfma_f32_32x32x16_bf16(b0, qr[d0], p0, 0, 0, 0); p1 = __builtin_amdgcn_mfma_f32_32x32x16_bf16(b1, qr[d0], p1, 0, 0, 0); } }
}
__device__ __forceinline__ void pv_tile(f32x16* o, int vb, bf16x8 pa0, bf16x8 pa1, bf16x8 pa2, bf16x8 pa3) {
#define TRRD(dst, off) asm volatile("ds_read_b64_tr_b16 %0, %1 offset:%2" : "=&v"(dst) : "v"(vb), "i"(off) : "memory")
#define PV_D0(d0) do { s16x4 l0, l1, l2, l3, h0, h1, h2, h3; constexpr int b_ = v_rd_off(d0, 0, 0); \
        TRRD(l0, b_); TRRD(h0, b_ + 2048); TRRD(l1, b_ + 4096); TRRD(h1, b_ + 6144); TRRD(l2, b_ + 8192); TRRD(h2, b_ + 10240); TRRD(l3, b_ + 12288); TRRD(h3, b_ + 14336); \
        asm volatile("s_waitcnt lgkmcnt(0)" ::: "memory"); SBAR();   \
        o[d0] = __builtin_amdgcn_mfma_f32_32x32x16_bf16(pa0, (bf16x8){l0[0], l0[1], l0[2], l0[3], h0[0], h0[1], h0[2], h0[3]}, o[d0], 0, 0, 0);   \
        o[d0] = __builtin_amdgcn_mfma_f32_32x32x16_bf16(pa1, (bf16x8){l1[0], l1[1], l1[2], l1[3], h1[0], h1[1], h1[2], h1[3]}, o[d0], 0, 0, 0);   \
        o[d0] = __builtin_amdgcn_mfma_f32_32x32x16_bf16(pa2, (bf16x8){l2[0], l2[1], l2[2], l2[3], h2[0], h2[1], h2[2], h2[3]}, o[d0], 0, 0, 0);   \
        o[d0] = __builtin_amdgcn_mfma_f32_32x32x16_bf16(pa3, (bf16x8){l3[0], l3[1], l3[2], l3[3], h3[0], h3[1], h3[2], h3[3]}, o[d0], 0, 0, 0); } while (0)
    PV_D0(0); PV_D0(1); PV_D0(2); PV_D0(3);
#undef PV_D0
#undef TRRD
}
template <int DQK, bool ALIBI, int VAR = 0>
__device__ __forceinline__ void attn_pass(ALAS char* lds, const bf16_t* __restrict__ Qh, int ldq, const bf16_t* __restrict__ Kh, int ldk, const bf16_t* __restrict__ Vh, int ldv,
                                          const float* __restrict__ posf, int q0, float nslope, float kn, f32x16 (&o)[4], unsigned long long& tacc) {
    constexpr int ND = DQK / 16, CH = DQK / 8, KP = DQK * 2 + 16, SHM_K = 64 * KP;
    int tid_ = threadIdx.x; asm volatile("" : "+v"(tid_));
    const int tid = tid_, wid = __builtin_amdgcn_readfirstlane(tid >> 6), lane = tid & 63, r32 = lane & 31, hi = lane >> 5, grp = wid >> 2;
    int NTE = (q0 + 256) / 64;
    const int NT = (q0 + 256) / 64, nact = q0 / 64 + (wid >> 1) + 1, kfirst = NT - nact;
    ALAS char* V_lds = lds + L_V; ALAS char* K_lds = lds + L_K; ALAS float* pos_lds = (ALAS float*)(lds + L_POS); ALAS float* ws = (ALAS float*)(lds + L_WS) + wid * 64; ALAS float* li_l = ws; ALAS float* al_l = ws + 32; ALAS float* xch = (ALAS float*)(lds + L_XCH);
    bf16x8 qr[ND];
#pragma unroll
    for (int d0 = 0; d0 < ND; ++d0) qr[d0] = *(const bf16x8*)(Qh + (size_t)(q0 + wid * 32 + r32) * ldq + d0 * 16 + hi * 8);
    float rowc = 0.f, qmin = 0.f;
    if (ALIBI) { const float pq = posf[q0 + wid * 32 + r32]; rowc = nslope * pq; qmin = pq;
#pragma unroll
        for (int off = 1; off < 32; off <<= 1) qmin = fminf(qmin, bperm_f(lane ^ off, qmin)); }
    const int k0key = tid / CH, k0ch = tid - k0key * CH; const int i1 = tid + 512; const bool has1 = (CH == 12) && (tid < 256); const int k1key = i1 / CH, k1ch = i1 - k1key * CH;
    const int sr = tid >> 4, sc = (tid & 15) * 8, vst0 = v_st(sr, sc), vst1 = v_st(32 + sr, sc);
    const int vb0 = (int)(unsigned)(uintptr_t)V_lds + v_rd_base(lane);
    const ALAS char* kfr = K_lds + r32 * KP + hi * 16;
    bf16x8 st_k0, st_k1 = {}, st_v0, st_v1; float st_p = 0.f;
#define VMW() asm volatile("s_waitcnt vmcnt(0)" ::: "memory")
#define LBAR() do { TS_BEG(4); asm volatile("s_waitcnt lgkmcnt(0)\n\ts_barrier" ::: "memory"); TS_END(4); } while (0)
#define TI(k) (NT - 1 - (k))
#define SLOAD_K(t) do { const int kb_ = (t) * 64; st_k0 = *(const bf16x8*)(Kh + (size_t)(kb_ + k0key) * ldk + k0ch * 8); if (CH == 12) { if (has1) st_k1 = *(const bf16x8*)(Kh + (size_t)(kb_ + k1key) * ldk + k1ch * 8); } \
        if (ALIBI) { if (tid < 64) st_p = posf[kb_ + tid]; } } while (0)
#define SLOAD_V(t) do { const int kb_ = (t) * 64; st_v0 = *(const bf16x8*)(Vh + (size_t)(kb_ + sr) * ldv + sc); st_v1 = *(const bf16x8*)(Vh + (size_t)(kb_ + 32 + sr) * ldv + sc); } while (0)
#define SWRITE_K(bf) do { *(ALAS bf16x8*)(K_lds + (bf) * SHM_K + k0key * KP + k0ch * 16) = st_k0; if (CH == 12) { if (has1) *(ALAS bf16x8*)(K_lds + (bf) * SHM_K + k1key * KP + k1ch * 16) = st_k1; } \
        if (ALIBI) { if (tid < 64) pos_lds[(bf) * 80 + tid] = -nslope * st_p; } } while (0)
#define SWRITE_V(bf) do { *(ALAS bf16x8*)(V_lds + (bf) * SHM_V + vst0) = st_v0; *(ALAS bf16x8*)(V_lds + (bf) * SHM_V + vst1) = st_v1; } while (0)
    unsigned long long ts0_ = 0ull; (void)ts0_;
#define TS_BEG(id) do { if (PROBE_TSEC == (id) && wid == PROBE_WAVE) { ts0_ = __builtin_readcyclecounter(); } } while (0)
#define TS_END(id) do { if (PROBE_TSEC == (id) && wid == PROBE_WAVE) { tacc += __builtin_readcyclecounter() - ts0_; } } while (0)
    float m_reg = 0.f, l_reg = 0.f;
#pragma unroll
    for (int d0 = 0; d0 < 4; ++d0) o[d0] = f32x16{};
    f32x16 p0 = f32x16{}, p1 = f32x16{}, negm = f32x16{}; bf16x8 pa0 = {}, pa1 = {}, pa2 = {}, pa3 = {};
#define MBLOCK(k) do { if (VAR == 2) break; TS_BEG(2); SBAR(); \
        float tmx_ = 0.f; if (ALIBI) { const int kq_ = (k) < NT ? (k) : NT - 1; tmx_ = posf[S_TMAX_OFF + TI(kq_)]; } \
        if ((k) >= 1 && (k) - 1 >= kfirst) pv_tile(o, vb0 + (((k) - 1) & 1) * SHM_V, pa0, pa1, pa2, pa3); SBAR(); \
        if ((k) < NTE && (k) >= kfirst) qkt<DQK, ALIBI>(p0, p1, kfr + ((k) & 1) * SHM_K, qr, pos_lds + ((k) & 1) * 80, tmx_, rowc, m_reg, qmin, negm, hi); SBAR(); TS_END(2); } while (0)
#define VBLOCK(k) do { if (VAR != 1 && (k) >= kfirst) { TS_BEG(3); SBAR(); \
        float pmax = fmaxf(fmaxf(p0[0], p0[1]), p1[0]); \
        _Pragma("unroll") for (int r = 2; r < 16; r += 2) pmax = fmaxf(fmaxf(pmax, p0[r]), p0[r + 1]); \
        _Pragma("unroll") for (int r = 1; r < 15; r += 2) pmax = fmaxf(fmaxf(pmax, p1[r]), p1[r + 1]); \
        pmax = fmaxf(pmax, p1[15]); \
        { auto rr = __builtin_amdgcn_permlane32_swap(__float_as_uint(pmax), __float_as_uint(pmax), false, false); pmax = fmaxf(__uint_as_float(rr[0]), __uint_as_float(rr[1])); } \
        const bool first = (k) == kfirst; \
        if (first || !__all(pmax <= THR)) { \
            const float delta = first ? pmax : fmaxf(pmax, 0.f); m_reg += delta; \
            _Pragma("unroll") for (int r = 0; r < 16; ++r) { p0[r] -= delta; p1[r] -= delta; } \
            if (!ALIBI) { _Pragma("unroll") for (int r = 0; r < 16; ++r) negm[r] = -m_reg; } \
            { const float alpha = first ? 1.0f : __builtin_amdgcn_exp2f(-delta); l_reg *= alpha; \
                if (hi == 0) al_l[r32] = alpha; asm volatile("s_waitcnt lgkmcnt(0)" ::: "memory"); \
                _Pragma("unroll") for (int d_ = 0; d_ < 4; ++d_) _Pragma("unroll") for (int r = 0; r < 16; ++r) o[d_][r] *= al_l[crow(r, hi)]; } } \
        _Pragma("unroll") for (int r = 0; r < 16; ++r) { p0[r] = __builtin_amdgcn_exp2f(p0[r]); p1[r] = __builtin_amdgcn_exp2f(p1[r]); } \
        float ps = 0.f; \
        _Pragma("unroll") for (int r = 0; r < 16; ++r) ps += p0[r]; \
        _Pragma("unroll") for (int r = 0; r < 16; ++r) ps += p1[r]; \
        l_reg += ps; \
        PK4(p0, 0, pa0); PK4(p0, 8, pa1); PK4(p1, 0, pa2); PK4(p1, 8, pa3); SBAR(); TS_END(3); } } while (0)
#define PK4(P, B_, OUT) do { unsigned a0 = cvtpk(P[B_+0], P[B_+1]), a1 = cvtpk(P[B_+2], P[B_+3]);                          \
        unsigned b0 = cvtpk(P[B_+4], P[B_+5]), b1 = cvtpk(P[B_+6], P[B_+7]);                                             \
        auto r0 = __builtin_amdgcn_permlane32_swap(a0, b0, false, false); auto r1 = __builtin_amdgcn_permlane32_swap(a1, b1, false, false); \
        u32x4 w = {r0[0], r1[0], r0[1], r1[1]}; OUT = *reinterpret_cast<bf16x8*>(&w); } while (0)
#define SKIP_DECIDE() do { float B_ = xch[0], Q_ = xch[1]; _Pragma("unroll") for (int w = 1; w < 8; ++w) { B_ = fmaxf(B_, xch[2 * w]); Q_ = fminf(Q_, xch[2 * w + 1]); } \
        int kst_ = NT; _Pragma("unroll") for (int j_ = 0; j_ < 4; ++j_) { const int kc_ = 4 + lane + 64 * j_; \
            if (kc_ < NT) { const float pm_ = posf[S_PMAX_OFF + TI(kc_)]; if (B_ + nslope * fmaxf(Q_ - pm_, 0.f) <= -SKIP_T) kst_ = kc_ < kst_ ? kc_ : kst_; } } \
        _Pragma("unroll") for (int off = 1; off < 64; off <<= 1) { const int o_ = __builtin_amdgcn_ds_bpermute((lane ^ off) << 2, kst_); kst_ = o_ < kst_ ? o_ : kst_; } \
        kst_ = __builtin_amdgcn_readfirstlane(kst_); NTE = (kst_ + 1) & ~1; if (NTE > NT) NTE = NT; } while (0)
    if (ALIBI) { float ss_ = 0.f, sd_ = 0.f; const bf16_t* krow_ = Kh + (size_t)(q0 + wid * 32 + r32) * ldk + hi * 8;
#pragma unroll
        for (int d0 = 0; d0 < ND; ++d0) { const bf16x8 kv_ = *(const bf16x8*)(krow_ + d0 * 16);
#pragma unroll
            for (int e = 0; e < 8; ++e) { const float x_ = __uint_as_float((unsigned)(unsigned short)qr[d0][e] << 16), y_ = __uint_as_float((unsigned)(unsigned short)kv_[e] << 16); ss_ = fmaf(x_, x_, ss_); sd_ = fmaf(x_, y_, sd_); } }
        { auto rr = __builtin_amdgcn_permlane32_swap(__float_as_uint(ss_), __float_as_uint(ss_), false, false); ss_ = __uint_as_float(rr[0]) + __uint_as_float(rr[1]); }
        { auto rr = __builtin_amdgcn_permlane32_swap(__float_as_uint(sd_), __float_as_uint(sd_), false, false); sd_ = __uint_as_float(rr[0]) + __uint_as_float(rr[1]); }
        float b_ = sqrtf(ss_) * 1.0001f * kn - sd_;
#pragma unroll
        for (int off = 1; off < 32; off <<= 1) b_ = fmaxf(b_, bperm_f(lane ^ off, b_));
        if (lane == 0) { xch[2 * wid] = b_; xch[2 * wid + 1] = qmin; } }
    SLOAD_K(TI(0)); VMW(); SWRITE_K(0); LBAR();
    if (ALIBI) SKIP_DECIDE();
#define STG_W(k, KB) do { if (VAR != 3 && (k) < NTE) { TS_BEG(6); VMW(); if ((k) + 1 < NTE) SWRITE_K(1 - (KB)); SWRITE_V(KB); TS_END(6); } } while (0)
#define STG_L(k) do { if (VAR != 3) { TS_BEG(5); if ((k) + 2 < NTE) SLOAD_K(TI((k) + 2)); if ((k) + 1 < NTE) SLOAD_V(TI((k) + 1)); TS_END(5); } } while (0)
    if (1 < NT) SLOAD_K(TI(1));
    SLOAD_V(TI(0));
    if (grp == 0) {
#define BODY_A(k) do { \
            MBLOCK(k); LBAR(); \
            STG_W(k, 0); STG_L(k); if ((k) < NTE) VBLOCK(k); LBAR(); \
            if ((k) + 1 <= NTE) { \
            MBLOCK((k) + 1); LBAR(); \
            STG_W((k) + 1, 1); STG_L((k) + 1); if ((k) + 1 < NTE) VBLOCK((k) + 1); LBAR(); } } while (0)
        for (int k = 0; k <= NTE; k += 2) BODY_A(k);
#undef BODY_A
    } else {
#define BODY_B(k) do { \
            STG_W(k, 0); STG_L(k); if ((k) >= 1) VBLOCK((k) - 1); LBAR(); \
            MBLOCK(k); LBAR(); \
            if ((k) + 1 <= NTE) { \
            STG_W((k) + 1, 1); STG_L((k) + 1); VBLOCK(k); LBAR(); \
            MBLOCK((k) + 1); LBAR(); } } while (0)
        for (int k = 0; k <= NTE; k += 2) BODY_B(k);
#undef BODY_B
    }
#undef STG_W
#undef SKIP_DECIDE
#undef STG_L
    { auto rr = __builtin_amdgcn_permlane32_swap(__float_as_uint(l_reg), __float_as_uint(l_reg), false, false); l_reg = __uint_as_float(rr[0]) + __uint_as_float(rr[1]); }
    if (hi == 0) li_l[r32] = l_reg; asm volatile("s_waitcnt lgkmcnt(0)" ::: "memory");
#pragma unroll
    for (int r = 0; r < 16; ++r) { const float rl = __builtin_amdgcn_rcpf(li_l[crow(r, hi)]);
#pragma unroll
        for (int d0 = 0; d0 < 4; ++d0) o[d0][r] *= rl; }
#undef PK4
#undef VBLOCK
#undef MBLOCK
#undef SWRITE_V
#undef SWRITE_K
#undef SLOAD_V
#undef SLOAD_K
#undef TI
#undef VMW
#undef LBAR
#undef TS_BEG
#undef TS_END
}
__device__ __forceinline__ void store_o_bf16(const f32x16 (&o)[4], bf16_t* Ow  , int ldo, int r32, int hi) {
#pragma unroll
    for (int r = 0; r < 16; ++r) { const int orow = crow(r, hi);
#pragma unroll
        for (int d0 = 0; d0 < 4; ++d0) { const float v = o[d0][r]; const float vn = bperm_f((hi * 32 + r32) ^ 1, v);
            if ((r32 & 1) == 0) *(unsigned*)(Ow + (size_t)orow * ldo + d0 * 32 + r32) = cvtpk(v, vn); } }
}
#undef SBAR
}

#define LAS __attribute__((address_space(3)))
typedef unsigned short bf16;
typedef unsigned v4u __attribute__((ext_vector_type(4)));
typedef unsigned v2u __attribute__((ext_vector_type(2)));
typedef float f32x4 __attribute__((ext_vector_type(4)));
#ifndef ATT_NO_DIFF
#define ATT_NO_DIFF 0
#endif
#ifndef ATT_NO_MLA
#define ATT_NO_MLA 0
#endif
#ifndef ALIBI_ON
#define ALIBI_ON true
#endif
#ifndef PROBE_VAR
#define PROBE_VAR 0
#endif
#define PTS_BEG(id) do { if (PROBE_TSEC == (id) && __builtin_amdgcn_readfirstlane(threadIdx.x >> 6) == PROBE_WAVE) pts0 = __builtin_readcyclecounter(); } while (0)
#define PTS_END(id) do { if (PROBE_TSEC == (id) && __builtin_amdgcn_readfirstlane(threadIdx.x >> 6) == PROBE_WAVE) tacc += __builtin_readcyclecounter() - pts0; } while (0)
#define ATT_CALL_D(...) do { PTS_BEG(7); if (PROBE_VAR == 0 || rep == 0) att::attn_pass<64, ALIBI_ON, 0>(__VA_ARGS__); else att::attn_pass<64, ALIBI_ON, PROBE_VAR>(__VA_ARGS__); PTS_END(7); } while (0)
#define ATT_CALL_M(...) do { PTS_BEG(7); if (PROBE_VAR == 0 || rep == 0) att::attn_pass<96, false, 0>(__VA_ARGS__); else att::attn_pass<96, false, PROBE_VAR>(__VA_ARGS__); PTS_END(7); } while (0)
#ifndef PHMASK
#define PHMASK 0x1ff
#endif
#define EN(k) (((PHMASK) >> (k)) & 1)
constexpr int NWAVES = 8;
constexpr int RING_BYTES = 131072, MISC_OFF = RING_BYTES, LDS_BYTES = 147456;
static_assert(att::L_END <= RING_BYTES, "attention LDS");
constexpr size_t MiB = 1u << 20;
constexpr size_t WS_CTL = 0, WS_WIN = 1 * MiB, WS_WUQ = 20 * MiB, WS_WUKV = 21 * MiB, WS_WO = 22 * MiB, WS_WGU = 30 * MiB, WS_WDN = 74 * MiB;
constexpr size_t WS_POSF = 96 * MiB, WS_COS = 97 * MiB, WS_SIN = 98 * MiB, WS_SSQ = 99 * MiB, WS_HB = 100 * MiB, WS_SCR = 164 * MiB;
constexpr size_t WS_AQ = WS_SCR, WS_AK = WS_SCR + 24 * MiB, WS_AV = WS_SCR + 48 * MiB, WS_BH = WS_SCR + 72 * MiB, WS_BB = WS_SCR + 88 * MiB, WS_BC = WS_SCR + 104 * MiB,
                 WS_CQ = WS_SCR + 120 * MiB, WS_CKV = WS_SCR + 136 * MiB, WS_CKR = WS_SCR + 144 * MiB, WS_QM = WS_SCR + 146 * MiB, WS_KM = WS_SCR + 164 * MiB, WS_VC = WS_SCR + 182 * MiB,
                 WS_STASH = WS_SCR + 206 * MiB;
constexpr size_t WS_RS = WS_SSQ + 800 * 1024;
constexpr size_t WS_A = WS_SCR, WS_GS = WS_SCR + 176 * MiB, WS_US = WS_SCR + 198 * MiB;
constexpr size_t WS_END = WS_SCR + 238 * MiB;
static_assert(WS_WIN + (size_t)PINP * DM * 2 <= WS_WUQ && WS_WGU + (size_t)2 * DFF * DM * 2 <= WS_WDN && WS_WDN + (size_t)DM * DFF * 2 <= WS_POSF, "weight map");
static_assert((size_t)S * DFF * 2 <= 176 * MiB && (size_t)(S / 64) * 4 * DFF * 4 <= 22 * MiB && (size_t)(S / 64) * 2 * DFF * 4 <= 11 * MiB, "ffn map");

__device__ __forceinline__ unsigned f2bf(float f) { unsigned u = __builtin_bit_cast(unsigned, f); return (u + 0x7fffu + ((u >> 16) & 1u)) >> 16; }
__device__ __forceinline__ unsigned pk2(float lo, float hi) { return f2bf(lo) | (f2bf(hi) << 16); }
__device__ __forceinline__ float bf2f(unsigned short b) { return __builtin_bit_cast(float, (unsigned)b << 16); }
__device__ __forceinline__ float bflo(unsigned w) { return __builtin_bit_cast(float, w << 16); }
__device__ __forceinline__ float bfhi(unsigned w) { return __builtin_bit_cast(float, w & 0xffff0000u); }
__device__ __forceinline__ float wave_sum(float v) {
    const int ln = lane_id_v();
#pragma unroll
    for (int o = 1; o < 64; o <<= 1) v += bperm_f(ln ^ o, v);
    return v;
}
template <int MODE> __device__ __forceinline__ int dst_row(int n, int up) {
    if (MODE == 1) return ((n >> 7) << 8) + (n & 127) + up * 128;
    if (MODE == 2) { const int h = n / 192, w = n - h * 192; return w < 64 ? h * 64 + w : 384 + h * 128 + (w - 64); }
    return n;
}
template <int MODE> __device__ __forceinline__ void transpose_item(const float* __restrict__ W, int K, int N, bf16* __restrict__ WT, int up, const float* __restrict__ rs, LAS float* scr, int item, int lane) {
    const int nblk = N / 32, kb = item / nblk, nb = item - kb * nblk, k0 = 64 * kb, n0 = 32 * nb;
#pragma unroll 8
    for (int i = 0; i < 32; ++i) { const int kk = 2 * i + (lane >> 5); float v = W[(size_t)(k0 + kk) * N + n0 + (lane & 31)]; if (rs) v *= rs[k0 + kk]; scr[kk * 33 + (lane & 31)] = v; }
    asm volatile("s_waitcnt lgkmcnt(0)" ::: "memory");
    const int c = lane & 7;
#pragma unroll
    for (int j = 0; j < 4; ++j) { const int n = (lane >> 3) + 8 * j; const LAS float* s = scr + (8 * c) * 33 + n;
        v4u o; o.x = pk2(s[0 * 33], s[1 * 33]); o.y = pk2(s[2 * 33], s[3 * 33]); o.z = pk2(s[4 * 33], s[5 * 33]); o.w = pk2(s[6 * 33], s[7 * 33]);
        *(v4u*)(WT + (size_t)dst_row<MODE>(n0 + n, up) * K + k0 + 8 * c) = o; }
    asm volatile("s_waitcnt lgkmcnt(0)" ::: "memory");
}
struct Args {
    const float* x; const int* pos; const float *ln_in_g, *ln_in_b, *w_in, *diff_lambda, *diff_norm_g, *conv_w, *mla_q_norm_g, *mla_kv_norm_g, *w_uq, *w_ukv, *w_o, *ln1_g, *ln1_b,
        *ffn_w_gate, *ffn_w_up, *ffn_conv_w, *ffn_w_down, *ln2_g, *ln2_b;
    float* out; unsigned char* ws; int ph_lo, ph_hi;
};
typedef const __attribute__((address_space(4))) Args* ArgP;
__device__ __forceinline__ void convert_weights(ArgP a, int l, unsigned char* ws, LAS float* scr, int gw, int NGW, int lane) {
    constexpr int I_IN = (DM / 64) * (PIN / 32), I_UQ = (CQR / 64) * (NUQ / 32), I_UKV = (CKVR / 64) * (NUKV / 32), I_O = (DM / 64) * (DM / 32), I_G = (DM / 64) * (DFF / 32), I_D = (DFF / 64) * (DM / 32);
    constexpr int NITEMS = I_IN + I_UQ + I_UKV + I_O + 2 * I_G + I_D;
    for (int it = gw; it < NITEMS; it += NGW) {
        int r = it;
        if (r < I_IN) { transpose_item<0>(a->w_in + (size_t)l * DM * PIN, DM, PIN, (bf16*)(ws + WS_WIN), 0, nullptr, scr, r, lane); continue; } r -= I_IN;
        if (r < I_UQ) { transpose_item<0>(a->w_uq + (size_t)l * CQR * NUQ, CQR, NUQ, (bf16*)(ws + WS_WUQ), 0, a->mla_q_norm_g + l * CQR, scr, r, lane); continue; } r -= I_UQ;
        if (r < I_UKV) { transpose_item<2>(a->w_ukv + (size_t)l * CKVR * NUKV, CKVR, NUKV, (bf16*)(ws + WS_WUKV), 0, a->mla_kv_norm_g + l * CKVR, scr, r, lane); continue; } r -= I_UKV;
        if (r < I_O) { transpose_item<0>(a->w_o + (size_t)l * DM * DM, DM, DM, (bf16*)(ws + WS_WO), 0, nullptr, scr, r, lane); continue; } r -= I_O;
        if (r < I_G) { transpose_item<1>(a->ffn_w_gate + (size_t)l * DM * DFF, DM, DFF, (bf16*)(ws + WS_WGU), 0, nullptr, scr, r, lane); continue; } r -= I_G;
        if (r < I_G) { transpose_item<1>(a->ffn_w_up + (size_t)l * DM * DFF, DM, DFF, (bf16*)(ws + WS_WGU), 1, nullptr, scr, r, lane); continue; } r -= I_G;
        transpose_item<0>(a->ffn_w_down + (size_t)l * DFF * DM, DFF, DM, (bf16*)(ws + WS_WDN), 0, nullptr, scr, r, lane);
    }
}
template <bool FINAL> __device__ __forceinline__ void ln_row(const float* xin, float* hout, bf16* hb, float* rs2, const float* __restrict__ g, const float* __restrict__ b, int lane) {
    const f32x4* xr = (const f32x4*)xin + lane;
    f32x4 v[8]; float s = 0.f;
#pragma unroll
    for (int j = 0; j < 8; ++j) { v[j] = xr[64 * j]; s += (v[j].x + v[j].y) + (v[j].z + v[j].w); }
    const float mean = wave_sum(s) * (1.f / DM); float s2 = 0.f;
#pragma unroll
    for (int j = 0; j < 8; ++j) { v[j] = v[j] - mean; s2 += (v[j].x * v[j].x + v[j].y * v[j].y) + (v[j].z * v[j].z + v[j].w * v[j].w); }
    const float rstd = 1.f / sqrtf(wave_sum(s2) * (1.f / DM) + LN_EPS);
    if (!FINAL && lane == 0) { rs2[0] = mean; rs2[1] = rstd; }
    f32x4* ho = (f32x4*)hout + lane; v2u* o8 = (v2u*)hb + lane;
#pragma unroll
    for (int j = 0; j < 8; ++j) { const f32x4 gg = ((const f32x4*)g)[64 * j + lane], bb = ((const f32x4*)b)[64 * j + lane]; const f32x4 y = v[j] * rstd * gg + bb;
        if (FINAL) ho[64 * j] = y; else { v2u w; w.x = pk2(y.x, y.y); w.y = pk2(y.z, y.w); o8[64 * j] = w; } }
}
__device__ __forceinline__ void sincos_f32(float x, float& sn, float& cs) {
    const float k = __builtin_rintf(x * 0.636619772f);
    float y = __builtin_fmaf(-k, 1.570796371e+00f, x); y = __builtin_fmaf(-k, -4.371138829e-08f, y);
    const float y2 = y * y;
    float sp = 2.86567956e-6f; sp = sp * y2 - 1.98559923e-4f; sp = sp * y2 + 8.33338592e-3f; sp = sp * y2 - 1.66666672e-1f; const float sy = __builtin_fmaf(y * y2, sp, y);
    float cp = 2.44677067e-5f; cp = cp * y2 - 1.38877297e-3f; cp = cp * y2 + 4.16666567e-2f; cp = cp * y2 - 0.5f; const float cy = __builtin_fmaf(y2, cp, 1.0f);
    const int q = (int)k & 3;
    const float s_ = (q & 1) ? cy : sy, c_ = (q & 1) ? sy : cy;
    sn = (q & 2) ? -s_ : s_; cs = ((q + 1) & 2) ? -c_ : c_;
}
__device__ __forceinline__ float inv_freq16(int j) {
    float v = 1.000000000e+00f;
    v = j == 1 ? 5.623413324e-01f : v; v = j == 2 ? 3.162277639e-01f : v; v = j == 3 ? 1.778279394e-01f : v; v = j == 4 ? 1.000000015e-01f : v; v = j == 5 ? 5.623413250e-02f : v;
    v = j == 6 ? 3.162277490e-02f : v; v = j == 7 ? 1.778279431e-02f : v; v = j == 8 ? 9.999999776e-03f : v; v = j == 9 ? 5.623413250e-03f : v; v = j == 10 ? 3.162277630e-03f : v;
    v = j == 11 ? 1.778279431e-03f : v; v = j == 12 ? 1.000000047e-03f : v; v = j == 13 ? 5.623413017e-04f : v; v = j == 14 ? 3.162277571e-04f : v; v = j == 15 ? 1.778279402e-04f : v;
    return v;
}

#define XB_TMO      128
#define XB_XCNT(j)  (256  + 64 * (j))
#define XB_XSUB(j)  (1280 + 64 * (j))
#define XB_XGEN(j)  (2304 + 64 * (j))
#define XB_TOP      3328
#define XB_TOPGEN   3392
#define XCD_BAR_WORDS 3456
#define XB_SPIN_CAP (1u << 18)

__device__ __forceinline__ unsigned xb_ld(unsigned* p)              { return __hip_atomic_load(p, __ATOMIC_RELAXED, __HIP_MEMORY_SCOPE_AGENT); }
__device__ __forceinline__ unsigned xb_add(unsigned* p, unsigned v) { return __hip_atomic_fetch_add(p, v, __ATOMIC_RELAXED, __HIP_MEMORY_SCOPE_AGENT); }
__device__ __forceinline__ unsigned xb_xcc_id() { return (unsigned)__builtin_amdgcn_s_getreg((3 << 11) | 20) & 0xFu; }
#define XB_SPIN(cond, bar) do { unsigned _sp = 0; while (cond) { __builtin_amdgcn_s_sleep(1); \
    if ((++_sp & 255u) == 0u) { if (xb_ld(&(bar)[XB_TMO])) break; if (_sp > XB_SPIN_CAP) { atomicAdd(&(bar)[XB_TMO], 1u); break; } } } } while (0)

struct XcdBarrier {
    unsigned* bar; unsigned x;
    volatile LAS unsigned* st;
};

__device__ __forceinline__ XcdBarrier xcd_barrier_post(unsigned* bar, volatile LAS unsigned* st) {
    XcdBarrier b; b.bar = bar; b.x = xb_xcc_id(); b.st = st;
    if (threadIdx.x == 0) (void)xb_add(&bar[XB_XCNT(b.x)], 1u);
    return b;
}
__device__ __forceinline__ void xcd_barrier_complete(unsigned* bar, unsigned x, unsigned& nloc, unsigned& nx) {
    const unsigned G = gridDim.x * gridDim.y * gridDim.z;
    unsigned sum, cnt, mine, sp = 0u;
    for (;;) {
        sum = 0u; cnt = 0u; mine = 0u;
#pragma unroll
        for (unsigned j = 0; j < 16; ++j) { const unsigned c = xb_ld(&bar[XB_XCNT(j)]); sum += c; cnt += (c > 0u) ? 1u : 0u; mine = (j == x) ? c : mine; }
        if (sum == G) break;
        __builtin_amdgcn_s_sleep(1);
        if ((++sp & 255u) == 0u) { if (xb_ld(&bar[XB_TMO])) break; if (sp > XB_SPIN_CAP) { atomicAdd(&bar[XB_TMO], 1u); break; } }
    }
    nloc = mine > 0u ? mine : 1u; nx = cnt > 0u ? cnt : 1u;
}

__device__ __forceinline__ void xcd_barrier(const XcdBarrier& b) {
    asm volatile("s_waitcnt vmcnt(0)" ::: "memory");
    __syncthreads();
    if (threadIdx.x == 0) {
        unsigned* bar = b.bar;
        __builtin_amdgcn_s_waitcnt(0);
        unsigned nloc = b.st[0], nx = b.st[1];
        if (nloc == 0u) { xcd_barrier_complete(bar, b.x, nloc, nx); b.st[0] = nloc; b.st[1] = nx; }
        const unsigned old = xb_add(&bar[XB_XSUB(b.x)], 1u);
        const unsigned gen = old / nloc;
        if (old + 1u == (gen + 1u) * nloc) {
            __builtin_amdgcn_fence(__ATOMIC_RELEASE, "agent");
            asm volatile("s_waitcnt vmcnt(0)" ::: "memory");
            const unsigned og = xb_add(&bar[XB_TOP], 1u);
            const unsigned tg = og / nx;
            if (og + 1u == (tg + 1u) * nx) xb_add(&bar[XB_TOPGEN], 1u);
            else XB_SPIN(xb_ld(&bar[XB_TOPGEN]) == tg, bar);
            __builtin_amdgcn_fence(__ATOMIC_ACQUIRE, "agent");
            xb_add(&bar[XB_XGEN(b.x)], 1u);
            asm volatile("s_waitcnt vmcnt(0)" ::: "memory");
        } else {
            XB_SPIN(xb_ld(&bar[XB_XGEN(b.x)]) == gen, bar);
            __builtin_amdgcn_fence(__ATOMIC_ACQUIRE, "agent");
            asm volatile("s_waitcnt vmcnt(0)" ::: "memory");
        }
    }
    __syncthreads();
}

constexpr int CW_BAR = 4096, CW_KN = 1024;
__device__ const unsigned short DIFF_ORDER[384] = {381,389,397,405,413,421,429,437,445,453,461,469,477,485,493,501,509,373,365,357,349,341,333,325,317,309,301,293,285,277,269,261,253,245,237,229,221,213,205,197,189,181,173,165,157,156,164,172,180,188,196,204,212,220,228,236,244,252,260,268,276,284,292,300,308,316,324,332,340,348,356,364,372,380,388,396,404,412,420,428,436,444,452,460,468,476,484,492,500,508,148,149,140,141,132,133,124,125,116,117,108,109,100,101,92,93,84,85,76,77,68,69,67,75,83,91,99,107,115,123,131,139,147,155,163,171,179,187,195,203,211,219,227,235,243,251,259,267,275,283,291,299,307,315,323,331,339,347,355,363,371,379,387,395,403,411,419,427,435,443,451,459,467,475,483,491,499,507,59,60,61,51,52,53,43,44,45,35,36,37,34,42,50,58,66,74,82,90,98,106,114,122,130,138,146,154,162,170,178,186,194,202,210,218,226,234,242,250,258,266,274,282,290,298,306,314,322,330,338,346,354,362,370,378,386,394,402,410,418,426,434,442,450,458,466,474,482,490,498,506,26,27,28,29,18,19,20,21,17,25,33,41,49,57,65,73,81,89,97,105,113,121,129,137,145,153,161,169,177,185,193,201,209,217,225,233,241,249,257,265,273,281,289,297,305,313,321,329,337,345,353,361,369,377,385,393,401,409,417,425,433,441,449,457,465,473,481,489,497,505,9,10,11,12,13,8,16,24,32,40,48,56,64,72,80,88,96,104,112,120,128,136,144,152,160,168,176,184,192,200,208,216,224,232,240,248,256,264,272,280,288,296,304,312,320,328,336,344,352,360,368,376,384,392,400,408,416,424,432,440,448,456,464,472,480,488,496,504,0,1,2,3,4,5};
__global__ void __launch_bounds__(NWAVES * 64, 2) mk_fwd(Args a) {
    extern __shared__ __attribute__((aligned(16))) unsigned char lds[];
    cg::grid_group grid = cg::this_grid();
    const int G = gridDim.x, NGW = G * NWAVES, NGT = G * NWAVES * 64;
    LAS unsigned char* ldsl = (LAS unsigned char*)lds;
    volatile LAS unsigned* MISC = (volatile LAS unsigned*)(ldsl + MISC_OFF);
    if (threadIdx.x < 32) MISC[threadIdx.x] = 0u;
    __syncthreads();

#ifndef PROBE_SUB
#define PROBE_SUB -1
#endif
    unsigned long long tacc = 0ull, pts0 = 0ull; (void)pts0;
    constexpr int NPROG = 1 + 9 * NLAYER + (PROBE_SUB >= 0 ? (PROBE_SUB >= 9 ? 1 : NLAYER) : 0);
    for (int pi = 0; pi < NPROG; ++pi) {
        int ph = pi, rep = 0;
        if (PROBE_SUB >= 9) { if (pi >= 1) { ph = pi - 1; rep = pi == 1; } }
        else if (PROBE_SUB >= 0) { constexpr int p0 = 1 + PROBE_SUB, p1 = 10 + PROBE_SUB;
            if (pi <= p0) ph = pi; else if (pi == p0 + 1) { ph = p0; rep = 1; } else if (pi <= p1 + 1) ph = pi - 1; else if (pi == p1 + 2) { ph = p1; rep = 1; } else ph = pi - 2; }
        ArgP ap = (ArgP)__builtin_amdgcn_kernarg_segment_ptr(); asm volatile("" : "+s"(ap));
        unsigned char* ws = ap->ws;
        float* hres = ap->out;
        bf16* hb = (bf16*)(ws + WS_HB);
        float* posf = (float*)(ws + WS_POSF); float* cost = (float*)(ws + WS_COS); float* sint = (float*)(ws + WS_SIN); float* ssq = (float*)(ws + WS_SSQ);
        unsigned* qctr = (unsigned*)(ws + WS_CTL);
        if (PROBE_SUB == 10 && pi == 1) { for (int e = 0; e < 10; ++e) { XcdBarrier xb_; xb_.bar = qctr + CW_BAR; xb_.x = xb_xcc_id(); xb_.st = MISC + 8; xcd_barrier(xb_); } continue; }
        if (ph == 0 && EN(0)) {
            int tid_ = threadIdx.x; asm volatile("" : "+v"(tid_)); const int tid = tid_, lane = tid & 63, wave = __builtin_amdgcn_readfirstlane(tid >> 6), gw = blockIdx.x * NWAVES + wave, gt = blockIdx.x * (NWAVES * 64) + tid; (void)gt; (void)gw; (void)lane;
            if (blockIdx.x == 0 && rep == 0) { if (tid < 16) __hip_atomic_store(qctr + 64 * tid, 0u, __ATOMIC_RELAXED, __HIP_MEMORY_SCOPE_AGENT);
                for (int i = tid; i < XCD_BAR_WORDS; i += NWAVES * 64) __hip_atomic_store(qctr + CW_BAR + i, 0u, __ATOMIC_RELAXED, __HIP_MEMORY_SCOPE_AGENT); }
            convert_weights(ap, 0, ws, (LAS float*)(ldsl + wave * 16384), gw, NGW, lane);
            for (int m = gw; m < S; m += NGW) ln_row<false>(ap->x + (size_t)m * DM, nullptr, hb + (size_t)m * DM, (float*)(ws + WS_RS) + 2 * m, ap->ln_in_g, ap->ln_in_b, lane);
            if (gw < S / 64) { float mx = (float)ap->pos[gw * 64 + lane];
#pragma unroll
                for (int off = 1; off < 64; off <<= 1) mx = fmaxf(mx, bperm_f(lane ^ off, mx));
                if (lane == 0) posf[att::S_TMAX_OFF + gw] = mx; }
            for (int i = gt; i < S * 16; i += NGT) { const int s = i >> 4, j = i & 15; const float p = (float)ap->pos[s];
                float sn, cs; sincos_f32(p * inv_freq16(j), sn, cs); cost[i] = cs; sint[i] = sn; if (j == 0) posf[s] = p; }
        } else {
            const int l = (ph - 1) / 9, sub = (ph - 1) % 9;
            const float lam_init = l == 0 ? 0.2f : 0.35550906759096927f;
            if (sub == 0 && EN(1)) {
                if (blockIdx.x == 0) {
                    const int lane = lane_id_v(); const bool w0 = __builtin_amdgcn_readfirstlane(threadIdx.x >> 6) == 0;
                    if (w0 && lane < 12) __hip_atomic_store(qctr + CW_KN + lane, 0u, __ATOMIC_RELAXED, __HIP_MEMORY_SCOPE_AGENT);
                    if (w0) { float carry = -3.0e38f;
                        for (int j = 0; j < 4; ++j) { float v = posf[att::S_TMAX_OFF + 64 * j + lane];
#pragma unroll
                            for (int off = 1; off < 64; off <<= 1) { const float t = bperm_f(lane >= off ? lane - off : lane, v); v = lane >= off ? fmaxf(v, t) : v; }
                            v = fmaxf(v, carry); posf[att::S_PMAX_OFF + 64 * j + lane] = v; carry = bperm_f(63, v); } }
                }
                pg8::Gemm g{hb, (const bf16*)(ws + WS_WIN), S, PINP, DM}; pg8::StaticOrder so; so.init(S, PINP, G, (int)blockIdx.x);
                pg8::EpiProj E{(bf16*)(ws + WS_AQ), (bf16*)(ws + WS_AK), (bf16*)(ws + WS_AV), (bf16*)(ws + WS_BH), (bf16*)(ws + WS_BB), (bf16*)(ws + WS_BC), (bf16*)(ws + WS_CQ), (bf16*)(ws + WS_CKV), (bf16*)(ws + WS_CKR), ssq};
                pg8::gemm_phase<pg8::EpiProj, pg8::StaticOrder, true, true>(ldsl, g, so, E);
            } else if (sub == 1 && EN(2)) {
                int tid_ = threadIdx.x; asm volatile("" : "+v"(tid_)); const int tid = tid_, lane = tid & 63, wave = __builtin_amdgcn_readfirstlane(tid >> 6), gw = blockIdx.x * NWAVES + wave, gt = blockIdx.x * (NWAVES * 64) + tid; (void)gt; (void)gw; (void)lane;
                const bf16* ckr = (const bf16*)(ws + WS_CKR); bf16* km = (bf16*)(ws + WS_KM);
                for (int s0 = gw * 4; s0 < S; s0 += NGW * 4) { const int s = s0 + (lane >> 4), j = lane & 15;
                    const float x1 = bf2f(ckr[s * 32 + j]), x2 = bf2f(ckr[s * 32 + 16 + j]), c = cost[s * 16 + j], sn = sint[s * 16 + j];
                    const unsigned short o1 = (unsigned short)f2bf(x1 * c - x2 * sn), o2 = (unsigned short)f2bf(x2 * c + x1 * sn);
#pragma unroll
                    for (int h = 0; h < 6; ++h) { km[(size_t)s * NUQ + h * 96 + 64 + j] = o1; km[(size_t)s * NUQ + h * 96 + 80 + j] = o2; } }
                { const bf16* Bh = (const bf16*)(ws + WS_BH); const bf16* Bb = (const bf16*)(ws + WS_BB); const bf16* Bc = (const bf16*)(ws + WS_BC); const float* cw = ap->conv_w + (size_t)l * 3 * 512;
                  const int c = lane * 8; float w[3][8];
#pragma unroll
                  for (int i = 0; i < 3; ++i) { const f32x4 u0 = *(const f32x4*)(cw + i * 512 + c), u1 = *(const f32x4*)(cw + i * 512 + c + 4); w[i][0] = u0.x; w[i][1] = u0.y; w[i][2] = u0.z; w[i][3] = u0.w; w[i][4] = u1.x; w[i][5] = u1.y; w[i][6] = u1.z; w[i][7] = u1.w; }
                  for (int t = gw; t < S; t += NGW) {
                      float acc[8] = {0.f, 0.f, 0.f, 0.f, 0.f, 0.f, 0.f, 0.f};
#pragma unroll
                      for (int i = 0; i < 3; ++i) { const int tt = t - 2 + i; if (tt < 0) continue;
                          const v4u hv = *(const v4u*)(Bh + (size_t)tt * 512 + c), cv = *(const v4u*)(Bc + (size_t)tt * 512 + c);
                          acc[0] += w[i][0] * bflo(hv.x) * bflo(cv.x); acc[1] += w[i][1] * bfhi(hv.x) * bfhi(cv.x); acc[2] += w[i][2] * bflo(hv.y) * bflo(cv.y); acc[3] += w[i][3] * bfhi(hv.y) * bfhi(cv.y);
                          acc[4] += w[i][4] * bflo(hv.z) * bflo(cv.z); acc[5] += w[i][5] * bfhi(hv.z) * bfhi(cv.z); acc[6] += w[i][6] * bflo(hv.w) * bflo(cv.w); acc[7] += w[i][7] * bfhi(hv.w) * bfhi(cv.w); }
                      const v4u bv = *(const v4u*)(Bb + (size_t)t * 512 + c); v4u o;
                      o.x = pk2(acc[0] * bflo(bv.x), acc[1] * bfhi(bv.x)); o.y = pk2(acc[2] * bflo(bv.y), acc[3] * bfhi(bv.y)); o.z = pk2(acc[4] * bflo(bv.z), acc[5] * bfhi(bv.z)); o.w = pk2(acc[6] * bflo(bv.w), acc[7] * bfhi(bv.w));
                      *(v4u*)(hb + (size_t)t * DM + 768 + c) = o; } }
                { const bf16* Ak = (const bf16*)(ws + WS_AK); float m0 = 0.f, m1 = 0.f;
                  for (int t = gw; t < S; t += NGW) {
                      const v4u a0 = *(const v4u*)(Ak + (size_t)t * 768 + lane * 8); v4u a1 = {0u, 0u, 0u, 0u}; if (lane < 32) a1 = *(const v4u*)(Ak + (size_t)t * 768 + 512 + lane * 8);
                      float s0 = bflo(a0.x) * bflo(a0.x) + bfhi(a0.x) * bfhi(a0.x) + bflo(a0.y) * bflo(a0.y) + bfhi(a0.y) * bfhi(a0.y) + bflo(a0.z) * bflo(a0.z) + bfhi(a0.z) * bfhi(a0.z) + bflo(a0.w) * bflo(a0.w) + bfhi(a0.w) * bfhi(a0.w);
                      float s1 = bflo(a1.x) * bflo(a1.x) + bfhi(a1.x) * bfhi(a1.x) + bflo(a1.y) * bflo(a1.y) + bfhi(a1.y) * bfhi(a1.y) + bflo(a1.z) * bflo(a1.z) + bfhi(a1.z) * bfhi(a1.z) + bflo(a1.w) * bflo(a1.w) + bfhi(a1.w) * bfhi(a1.w);
#pragma unroll
                      for (int off = 1; off < 8; off <<= 1) { s0 += bperm_f(lane ^ off, s0); s1 += bperm_f(lane ^ off, s1); }
                      m0 = fmaxf(m0, s0); m1 = fmaxf(m1, s1); }
                  if ((lane & 7) == 0) { __hip_atomic_fetch_max(qctr + CW_KN + (lane >> 3), __float_as_uint(m0), __ATOMIC_RELAXED, __HIP_MEMORY_SCOPE_AGENT);
                      if (lane < 32) __hip_atomic_fetch_max(qctr + CW_KN + 8 + (lane >> 3), __float_as_uint(m1), __ATOMIC_RELAXED, __HIP_MEMORY_SCOPE_AGENT); } }
                { pg8::Gemm g{(const bf16*)(ws + WS_CQ), (const bf16*)(ws + WS_WUQ), S, NUQP, CQR}; pg8::StaticOrder so; so.init(S, NUQP, G, (int)blockIdx.x);
                  pg8::EpiQm E{(bf16*)(ws + WS_QM), ssq, cost, sint};
                  pg8::gemm_phase<pg8::EpiQm, pg8::StaticOrder, true, true>(ldsl, g, so, E); }
                { pg8::Gemm g{(const bf16*)(ws + WS_CKV), (const bf16*)(ws + WS_WUKV), S, NUKVP, CKVR}; pg8::StaticOrder so; so.init(S, NUKVP, G, (int)blockIdx.x);
                  pg8::EpiKv E{km, (bf16*)(ws + WS_VC), ssq};
                  pg8::gemm_phase<pg8::EpiKv, pg8::StaticOrder, true, true>(ldsl, g, so, E); }
            } else if (sub == 2 && EN(3)) {
                float lam; { const int lane = lane_id_v(); const float* dl = ap->diff_lambda + (size_t)l * 256;
                  lam = __expf(wave_sum(dl[lane] * dl[64 + lane])) - __expf(wave_sum(dl[128 + lane] * dl[192 + lane])) + lam_init; }
                if (!ATT_NO_MLA) for (;;) {
                    PTS_BEG(9); if (threadIdx.x == 0) MISC[0] = __hip_atomic_fetch_add(qctr + 64 * (8 + l + 2 * rep), 1u, __ATOMIC_RELAXED, __HIP_MEMORY_SCOPE_AGENT);
                    __syncthreads(); const unsigned u = MISC[0]; __syncthreads(); PTS_END(9);
                    if (u >= 48u) break;
                    const int qb = 63 - (int)(u / 6u), h = (int)(u % 6u), q0 = qb * 256;
                    att::f32x16 o[4];
                    ATT_CALL_M((LAS char*)ldsl, (const bf16*)(ws + WS_QM) + h * 96, NUQ, (const bf16*)(ws + WS_KM) + h * 96, NUQ, (const bf16*)(ws + WS_VC) + h * 128, 768, posf, q0, 0.f, 0.f, o, tacc);
                    const int ln3 = lane_id_v(), r32 = ln3 & 31, hi = ln3 >> 5, wv3 = __builtin_amdgcn_readfirstlane(threadIdx.x >> 6);
                    att::store_o_bf16(o, (rep ? (bf16*)(ws + WS_BH) : hb) + (size_t)(q0 + wv3 * 32) * DM + 1280 + h * 128, DM, r32, hi);
                }
                if (!ATT_NO_DIFF) for (;;) {
                    PTS_BEG(9); if (threadIdx.x == 0) MISC[0] = __hip_atomic_fetch_add(qctr + 64 * (2 * l + 4 * rep), 1u, __ATOMIC_RELAXED, __HIP_MEMORY_SCOPE_AGENT);
                    __syncthreads(); const unsigned u = MISC[0]; __syncthreads(); PTS_END(9);
                    if (u >= 384u) break;
                    const unsigned id = DIFF_ORDER[u]; const int qb = (int)(id >> 3), h = (int)(id & 7u), q0 = qb * 256;
                    att::f32x16 o[4];
                    const float nslope = -LOG2E * __builtin_amdgcn_exp2f(-8.0f * (float)(h + 1) / 6.0f);
                    for (int mp = 0; mp < 2; ++mp) {
                        ATT_CALL_D((LAS char*)ldsl, (const bf16*)(ws + WS_AQ) + h * 128 + mp * 64, 768, (const bf16*)(ws + WS_AK) + h * 128 + mp * 64, 768, (const bf16*)(ws + WS_AV) + h * 128, 768, posf, q0, nslope, sqrtf(__uint_as_float(__hip_atomic_load(qctr + CW_KN + 2 * h + mp, __ATOMIC_RELAXED, __HIP_MEMORY_SCOPE_AGENT))) * 1.0001f, o, tacc);
                        const int ln2 = lane_id_v(), wv2 = __builtin_amdgcn_readfirstlane(threadIdx.x >> 6);
                        float* st = (float*)(ws + WS_STASH) + (((size_t)blockIdx.x * NWAVES + wv2) * 64 + ln2) * 64;
                        if (mp == 0) {
#pragma unroll
                            for (int d0 = 0; d0 < 4; ++d0)
#pragma unroll
                                for (int r = 0; r < 16; r += 4) *(f32x4*)(st + d0 * 16 + r) = (f32x4){o[d0][r], o[d0][r + 1], o[d0][r + 2], o[d0][r + 3]};
                        } else {
                            asm volatile("s_waitcnt vmcnt(0)" ::: "memory");
#pragma unroll
                            for (int d0 = 0; d0 < 4; ++d0)
#pragma unroll
                                for (int r = 0; r < 16; r += 4) { const f32x4 sv = *(const f32x4*)(st + d0 * 16 + r);
#pragma unroll
                                    for (int i = 0; i < 4; ++i) o[d0][r + i] = sv[i] - lam * o[d0][r + i]; }
                        }
                    }
                    const int ln3 = lane_id_v(), r32 = ln3 & 31, hi = ln3 >> 5, wv3 = __builtin_amdgcn_readfirstlane(threadIdx.x >> 6);
                    const float* dng = ap->diff_norm_g + (size_t)l * 128; float gc[4];
#pragma unroll
                    for (int d0 = 0; d0 < 4; ++d0) gc[d0] = dng[d0 * 32 + r32] * (1.0f - lam_init);
#pragma unroll
                    for (int r = 0; r < 16; ++r) { float ss = (o[0][r] * o[0][r] + o[1][r] * o[1][r]) + (o[2][r] * o[2][r] + o[3][r] * o[3][r]);
                        ss += bperm_f(ln3 ^ 1, ss); ss += bperm_f(ln3 ^ 2, ss); ss += bperm_f(ln3 ^ 4, ss); ss += bperm_f(ln3 ^ 8, ss); ss += bperm_f(ln3 ^ 16, ss);
                        const float rs = 1.0f / sqrtf(ss * (1.0f / 128.0f) + RMS_EPS);
#pragma unroll
                        for (int d0 = 0; d0 < 4; ++d0) o[d0][r] *= rs * gc[d0]; }
                    att::store_o_bf16(o, (rep ? (bf16*)(ws + WS_BH) : hb) + (size_t)(q0 + wv3 * 32) * DM + h * 128, DM, r32, hi);
                }
                if (!ATT_NO_MLA) for (;;) {
                    PTS_BEG(9); if (threadIdx.x == 0) MISC[0] = __hip_atomic_fetch_add(qctr + 64 * (2 * l + 1 + 4 * rep), 1u, __ATOMIC_RELAXED, __HIP_MEMORY_SCOPE_AGENT);
                    __syncthreads(); const unsigned u = MISC[0]; __syncthreads(); PTS_END(9);
                    if (u >= 336u) break;
                    const int qb = 63 - (int)((u + 48u) / 6u), h = (int)((u + 48u) % 6u), q0 = qb * 256;
                    att::f32x16 o[4];
                    ATT_CALL_M((LAS char*)ldsl, (const bf16*)(ws + WS_QM) + h * 96, NUQ, (const bf16*)(ws + WS_KM) + h * 96, NUQ, (const bf16*)(ws + WS_VC) + h * 128, 768, posf, q0, 0.f, 0.f, o, tacc);
                    const int ln3 = lane_id_v(), r32 = ln3 & 31, hi = ln3 >> 5, wv3 = __builtin_amdgcn_readfirstlane(threadIdx.x >> 6);
                    att::store_o_bf16(o, (rep ? (bf16*)(ws + WS_BH) : hb) + (size_t)(q0 + wv3 * 32) * DM + 1280 + h * 128, DM, r32, hi);
                }
            } else if (sub == 3 && EN(4)) {
                pg8::Gemm g{hb, (const bf16*)(ws + WS_WO), S, DM, DM}; pg8::StaticOrder so; so.init(S, DM, G, (int)blockIdx.x);
                pg8::EpiResid E{l == 0 ? ap->x : (const float*)hres, hres, (const float*)(ws + WS_RS), l == 0 ? ap->ln_in_g : ap->ln2_g + (size_t)(l - 1) * DM, l == 0 ? ap->ln_in_b : ap->ln2_b + (size_t)(l - 1) * DM};
                pg8::gemm_phase<pg8::EpiResid, pg8::StaticOrder, true, true>(ldsl, g, so, E);
            } else if ((sub == 4 || sub == 8) && EN(5)) {
                int tid_ = threadIdx.x; asm volatile("" : "+v"(tid_)); const int tid = tid_, lane = tid & 63, wave = __builtin_amdgcn_readfirstlane(tid >> 6), gw = blockIdx.x * NWAVES + wave, gt = blockIdx.x * (NWAVES * 64) + tid; (void)gt; (void)gw; (void)lane;
                int phl_ = ph; asm volatile("" : "+s"(phl_));
                const int l2 = (phl_ - 1) / 9, sub2 = (phl_ - 1) - 9 * l2;
                const float* g_ = (sub2 == 4 ? ap->ln1_g : ap->ln2_g) + (size_t)l2 * DM; const float* b_ = (sub2 == 4 ? ap->ln1_b : ap->ln2_b) + (size_t)l2 * DM;
                if (phl_ == 9 * NLAYER) { for (int m = gw; m < S; m += NGW) ln_row<true>(hres + (size_t)m * DM, hres + (size_t)m * DM, nullptr, nullptr, g_, b_, lane); }
                else { for (int m = gw; m < S; m += NGW) ln_row<false>(hres + (size_t)m * DM, nullptr, hb + (size_t)m * DM, (float*)(ws + WS_RS) + 2 * m, g_, b_, lane); }
                if (sub2 == 8 && l2 + 1 < NLAYER) convert_weights(ap, l2 + 1, ws, (LAS float*)(ldsl + wave * 16384), gw, NGW, lane);
            } else if (sub == 5 && EN(6)) {
                pg8::Gemm g{hb, (const bf16*)(ws + WS_WGU), S, 2 * DFF, DM}; pg8::StaticOrder so; so.init(S, 2 * DFF, G, (int)blockIdx.x);
                pg8::EpiGateUp E{(bf16*)(ws + WS_A), ap->ffn_conv_w + (size_t)l * 3 * DFF, (float*)(ws + WS_GS), (float*)(ws + WS_US)};
                pg8::gemm_phase<pg8::EpiGateUp, pg8::StaticOrder, true, true>(ldsl, g, so, E);
            } else if (sub == 6 && EN(7)) {
                int tid_ = threadIdx.x; asm volatile("" : "+v"(tid_)); const int tid = tid_, lane = tid & 63, wave = __builtin_amdgcn_readfirstlane(tid >> 6), gw = blockIdx.x * NWAVES + wave, gt = blockIdx.x * (NWAVES * 64) + tid; (void)gt; (void)gw; (void)lane;
                const float* cw = ap->ffn_conv_w + (size_t)l * 3 * DFF; const float* GS = (const float*)(ws + WS_GS); const float* US = (const float*)(ws + WS_US); bf16* A = (bf16*)(ws + WS_A);
                for (int i = gt; i < (S / 64) * DFF; i += NGT) { const int span = i / DFF, ch = i - span * DFF;
                    const float gm2 = span ? GS[((size_t)(span - 1) * 4 + 2) * DFF + ch] : 0.f, gm1 = span ? GS[((size_t)(span - 1) * 4 + 3) * DFF + ch] : 0.f;
                    const float g0 = GS[((size_t)span * 4 + 0) * DFF + ch], g1 = GS[((size_t)span * 4 + 1) * DFF + ch], u0 = US[((size_t)span * 2 + 0) * DFF + ch], u1 = US[((size_t)span * 2 + 1) * DFF + ch];
                    const float w0 = cw[ch], w1 = cw[DFF + ch], w2 = cw[2 * DFF + ch];
                    const float c0 = w0 * gm2 + w1 * gm1 + w2 * g0, c1 = w0 * gm1 + w1 * g0 + w2 * g1;
                    A[(size_t)(span * 64) * DFF + ch] = (bf16)f2bf(c0 * u0 / (1.0f + __expf(-c0)));
                    A[(size_t)(span * 64 + 1) * DFF + ch] = (bf16)f2bf(c1 * u1 / (1.0f + __expf(-c1))); }
            } else if (sub == 7 && EN(8)) {
                pg8::Gemm g{(const bf16*)(ws + WS_A), (const bf16*)(ws + WS_WDN), S, DM, DFF}; pg8::StaticOrder so; so.init(S, DM, G, (int)blockIdx.x);
                pg8::EpiResid E{hres, hres, (const float*)(ws + WS_RS), ap->ln1_g + (size_t)l * DM, ap->ln1_b + (size_t)l * DM};
                pg8::gemm_phase<pg8::EpiResid, pg8::StaticOrder, true, true>(ldsl, g, so, E);
            }
        }
        if (pi + 1 < NPROG) {
            if (pi == 0) { grid.sync(); (void)xcd_barrier_post(qctr + CW_BAR, MISC + 8); }
            else { XcdBarrier xb_; xb_.bar = qctr + CW_BAR; xb_.x = xb_xcc_id(); xb_.st = MISC + 8; xcd_barrier(xb_); }
        }
    }
    if (PROBE_TSEC != 0 && blockIdx.x == 0 && __builtin_amdgcn_readfirstlane(threadIdx.x >> 6) == PROBE_WAVE) {
        const unsigned long long t0 = __builtin_readcyclecounter(); while (__builtin_readcyclecounter() - t0 < tacc) __builtin_amdgcn_s_sleep(1); }
}

extern "C" void kernel_launch(void* const* d_in, const int* in_sizes, int n_in, void* d_out, int out_size, void* d_ws, size_t ws_size, hipStream_t stream) {
    static int grid = 0;
    if (grid == 0) {
        if (n_in != 21 || in_sizes[0] != S * DM || out_size != S * DM || ws_size < WS_END) { fprintf(stderr, "kernel_launch: unexpected shapes (n_in %d, in0 %d, out %d, ws %zu < %zu)\n", n_in, n_in > 0 ? in_sizes[0] : -1, out_size, ws_size, (size_t)WS_END); grid = -1; return; }
        int dev = 0, cus = 0, per_cu = 0;
        if (hipGetDevice(&dev) != hipSuccess || hipDeviceGetAttribute(&cus, hipDeviceAttributeMultiprocessorCount, dev) != hipSuccess) { grid = -1; return; }
        if (hipFuncSetAttribute((const void*)mk_fwd, hipFuncAttributeMaxDynamicSharedMemorySize, LDS_BYTES) != hipSuccess) { fprintf(stderr, "kernel_launch: hipFuncSetAttribute failed\n"); grid = -1; return; }
        if (hipOccupancyMaxActiveBlocksPerMultiprocessor(&per_cu, (const void*)mk_fwd, NWAVES * 64, LDS_BYTES) != hipSuccess || per_cu < 1) { fprintf(stderr, "kernel_launch: occupancy query says %d\n", per_cu); per_cu = 1; }
        (void)hipGetLastError();
        grid = cus * per_cu;
    }
    if (grid < 0) return;
    Args a{};
    a.x = (const float*)d_in[0]; a.pos = (const int*)d_in[1]; a.ln_in_g = (const float*)d_in[2]; a.ln_in_b = (const float*)d_in[3]; a.w_in = (const float*)d_in[4]; a.diff_lambda = (const float*)d_in[5];
    a.diff_norm_g = (const float*)d_in[6]; a.conv_w = (const float*)d_in[7]; a.mla_q_norm_g = (const float*)d_in[8]; a.mla_kv_norm_g = (const float*)d_in[9]; a.w_uq = (const float*)d_in[10]; a.w_ukv = (const float*)d_in[11];
    a.w_o = (const float*)d_in[12]; a.ln1_g = (const float*)d_in[13]; a.ln1_b = (const float*)d_in[14]; a.ffn_w_gate = (const float*)d_in[15]; a.ffn_w_up = (const float*)d_in[16]; a.ffn_conv_w = (const float*)d_in[17];
    a.ffn_w_down = (const float*)d_in[18]; a.ln2_g = (const float*)d_in[19]; a.ln2_b = (const float*)d_in[20];
    a.out = (float*)d_out; a.ws = (unsigned char*)d_ws; a.ph_lo = 0; a.ph_hi = 1 + 9 * NLAYER;
    void* args[] = {&a};
    const hipError_t e = hipLaunchCooperativeKernel((const void*)mk_fwd, dim3(grid), dim3(NWAVES * 64), args, LDS_BYTES, stream);
    if (e != hipSuccess) fprintf(stderr, "kernel_launch: cooperative launch failed: %s (grid %d)\n", hipGetErrorString(e), grid);
}
```

```cpp
#define PROBE_SUB -1
#define PROBE_VAR 0
#define PROBE_TSEC 0
#define PROBE_WAVE 0
#include <hip/hip_runtime.h>
#include <hip/hip_cooperative_groups.h>
#include <cstdio>
#include <cstdint>
namespace cg = cooperative_groups;

constexpr int S = 16384, DM = 2048, NLAYER = 2, PIN = 4640, PINP = 4864, DFF = 5632;
constexpr int CQR = 512, CKVR = 256, NUQ = 576, NUQP = 768, NUKV = 1152, NUKVP = 1280;
constexpr float LN_EPS = 1e-5f, RMS_EPS = 1e-6f;
constexpr float ALPHA_DN = 1.4142135623730951f;
constexpr float LOG2E = 1.4426950408889634f;
constexpr float QSCALE_A = 0.125f * LOG2E;
constexpr float QSCALE_C = 0.10206207261596577f * LOG2E;
__device__ __forceinline__ int lane_id_v() { int l; asm volatile("v_mbcnt_lo_u32_b32 %0, -1, 0\n\tv_mbcnt_hi_u32_b32 %0, -1, %0" : "=v"(l)); return l; }
__device__ __forceinline__ float bperm_f(int src_lane, float v) { return __builtin_bit_cast(float, __builtin_amdgcn_ds_bpermute(src_lane << 2, __builtin_bit_cast(int, v))); }
namespace pg8 {
#define PG8_LAS __attribute__((address_space(3)))
typedef unsigned short bf16_t;
typedef short bf16x8 __attribute__((ext_vector_type(8)));
typedef float f32x4 __attribute__((ext_vector_type(4)));
typedef unsigned u32x4 __attribute__((ext_vector_type(4)));
constexpr int BM = 256, BK = 64, HALF = 128, HTB = HALF * BK * 2  , STAGE_BYTES = 8 * HTB, NXCD = 8, WGM = 8;

__host__ __device__ __forceinline__ int lds_byte(int r, int c) { const int st = (r >> 4) * 2 + (c >> 5), rr = r & 15, cc = c & 31, ob = rr * 64 + cc * 2; return st * 1024 + (ob ^ (((ob >> 9) & 1) << 5)); }
__host__ __device__ __forceinline__ void stage_rc(int b, int& R, int& C) { const int st = b / 1024, sb = b % 1024, swz = sb ^ (((sb >> 9) & 1) << 5); R = (st >> 1) * 16 + swz / 64; C = (st & 1) * 32 + (swz % 64) / 2; }
__host__ __device__ __forceinline__ int perm32(int rho) { const int n = rho >> 4, i = rho & 15; return 8 * (i >> 2) + 4 * n + (i & 3); }

struct Unit { int pm, pn; };
struct Gemm { const bf16_t* A; const bf16_t* Bt; int M, N, K; };

struct StaticOrder {
    int nM, nN, nwg, G, c;
    __host__ __device__ void init(int M, int N, int G_, int c_) { nM = M / BM; nN = N / BM; nwg = nM * nN; G = G_; c = c_; }
    __host__ __device__ bool next(int i, Unit& u) const {
        const long L = (long)i * G + c; if (L >= nwg) return false;
        int wgid = (int)L; { const int q = nwg / NXCD, r = nwg % NXCD, xcd = wgid % NXCD, off = wgid / NXCD; wgid = (xcd < r ? xcd * (q + 1) : r * (q + 1) + (xcd - r) * q) + off; }
        const int nig = WGM * nN, gid = wgid / nig, fm = gid * WGM, gsz = (nM - fm) < WGM ? (nM - fm) : WGM;
        u.pm = fm + ((wgid % nig) % gsz); u.pn = (wgid % nig) / gsz; return true;
    }
    __device__ __forceinline__ void a_ready(const Unit&) const {}
    __device__ __forceinline__ void done(const Unit&) const {}
};

__device__ __forceinline__ unsigned cvt_pk_bf16(float lo, float hi) { unsigned r; asm volatile("v_cvt_pk_bf16_f32 %0, %1, %2" : "=v"(r) : "v"(lo), "v"(hi)); return r; }
typedef float f32x2 __attribute__((ext_vector_type(2)));
template <class Epi, class Sched, bool ALIGN_EPI = false, bool SP2 = false>
__device__ __forceinline__ void gemm_phase(PG8_LAS unsigned char* lds, const Gemm g, const Sched& S, const Epi& E) {
    int tid_ = threadIdx.x; asm volatile("" : "+v"(tid_));
    const int tid = tid_, wid = __builtin_amdgcn_readfirstlane(tid >> 6), lane = tid & 63, wr = wid >> 2, wc = wid & 3, fr = lane & 15, fq = lane >> 4;
    const int K = g.K, nt = K / BK;
    unsigned voffA[2], voffB[2];
#pragma unroll
    for (int i = 0; i < 2; ++i) { int R, C; stage_rc(tid * 16 + i * 8192, R, C); const int Rb = Epi::PERM ? ((R & ~31) + perm32(R & 31)) : R;
        voffA[i] = (unsigned)(R * K + C) * 2u; voffB[i] = (unsigned)(Rb * K + C) * 2u; }
    const size_t kstep = (size_t)(BK * 2);
    const size_t hstep = (size_t)HALF * K * 2;
    const size_t tstep = 2 * hstep;
    const unsigned ldsw = (unsigned)wid * 1024u;
    const int aoff = lds_byte(wr * 64 + fr, fq * 8), boff = lds_byte(wc * 32 + fr, fq * 8);
#define PG8_SA(b, h) (((b) * 2 + (h)) * HTB)
#define PG8_SB(b, h) ((4 + (b) * 2 + (h)) * HTB)
#define PG8_STAGE(bufoff, gbase, voff) do { _Pragma("unroll") for (int _i = 0; _i < 2; ++_i) \
        __builtin_amdgcn_global_load_lds((const unsigned*)((const char*)(gbase) + (voff)[_i]), (PG8_LAS unsigned*)(lds + (bufoff) + ldsw + _i * 8192), 16, 0, 0); } while (0)
#define PG8_LDA(dst, b, h) do { _Pragma("unroll") for (int m = 0; m < 4; ++m) _Pragma("unroll") for (int k = 0; k < 2; ++k) dst[m][k] = *(const PG8_LAS bf16x8*)(lds + PG8_SA(b, h) + aoff + m * 2048 + k * 1024); } while (0)
#define PG8_LDB(dst, b, h) do { _Pragma("unroll") for (int n = 0; n < 2; ++n) _Pragma("unroll") for (int k = 0; k < 2; ++k) dst[n][k] = *(const PG8_LAS bf16x8*)(lds + PG8_SB(b, h) + boff + n * 2048 + k * 1024); } while (0)
#define PG8_MMA(ai, bj, At, Bt) do { __builtin_amdgcn_s_setprio(1); _Pragma("unroll") for (int m = 0; m < 4; ++m) _Pragma("unroll") for (int n = 0; n < 2; ++n) _Pragma("unroll") for (int k = 0; k < 2; ++k) \
        acc[ai][bj][m][n] = __builtin_amdgcn_mfma_f32_16x16x32_bf16(Bt[n][k], At[m][k], acc[ai][bj][m][n], 0, 0, 0); __builtin_amdgcn_s_setprio(0); } while (0)
#define PG8_WAIT_V(n) asm volatile("s_waitcnt vmcnt(" #n ")" ::: "memory")
#define PG8_WAIT_L(n) asm volatile("s_waitcnt lgkmcnt(" #n ")" ::: "memory")
#define PG8_BAR __builtin_amdgcn_s_barrier()
#define PG8_SCHED __builtin_amdgcn_sched_barrier(0)
    Unit cur, nxt; int ui = 0;
    if (!S.next(0, cur)) return;
    f32x4 acc[2][2][4][2];
#pragma unroll
    for (int a = 0; a < 2; ++a)
#pragma unroll
        for (int b = 0; b < 2; ++b)
#pragma unroll
            for (int m = 0; m < 4; ++m)
#pragma unroll
                for (int n = 0; n < 2; ++n) acc[a][b][m][n] = (f32x4){0.f, 0.f, 0.f, 0.f};
    bf16x8 At[4][2], B0[2][2], B1[2][2];
    const char* cA = (const char*)g.A + (size_t)cur.pm * tstep; const char* cB = (const char*)g.Bt + (size_t)cur.pn * tstep;
    S.a_ready(cur);
    if constexpr (SP2) {
        PG8_STAGE(PG8_SB(0, 0), cB, voffB); PG8_STAGE(PG8_SB(0, 1), cB + hstep, voffB); PG8_STAGE(PG8_SA(0, 0), cA, voffA); PG8_STAGE(PG8_SA(0, 1), cA + hstep, voffA);
        if (wr == 1) PG8_BAR;
        PG8_WAIT_V(2); PG8_BAR;
        PG8_STAGE(PG8_SB(1, 0), cB + kstep, voffB); PG8_STAGE(PG8_SA(1, 0), cA + kstep, voffA); PG8_STAGE(PG8_SB(1, 1), cB + hstep + kstep, voffB);
        PG8_WAIT_V(6); PG8_BAR;
    } else {
        PG8_STAGE(PG8_SB(0, 0), cB, voffB); PG8_STAGE(PG8_SA(0, 0), cA, voffA); PG8_STAGE(PG8_SB(0, 1), cB + hstep, voffB); PG8_STAGE(PG8_SA(0, 1), cA + hstep, voffA);
        if (wr == 1) PG8_BAR;
        PG8_WAIT_V(4); PG8_BAR;
        PG8_STAGE(PG8_SB(1, 0), cB + kstep, voffB); PG8_STAGE(PG8_SA(1, 0), cA + kstep, voffA); PG8_STAGE(PG8_SB(1, 1), cB + hstep + kstep, voffB);
        PG8_WAIT_V(6); PG8_BAR;
    }
    for (;;) {
        const bool has_next = S.next(ui + 1, nxt);
        const char* nA = has_next ? (const char*)g.A + (size_t)nxt.pm * tstep : cA; const char* nB = has_next ? (const char*)g.Bt + (size_t)nxt.pn * tstep : cB;
        for (int t = 0; t < nt; t += 2) {
            const bool last = (t == nt - 2);
            const char* a1 = cA + (size_t)(t + 1) * kstep;
            const char* a2 = last ? nA : cA + (size_t)(t + 2) * kstep; const char* b2 = last ? nB : cB + (size_t)(t + 2) * kstep;
            const char* a3 = a2 + kstep; const char* b3 = b2 + kstep;
            if (last && has_next) S.a_ready(nxt);
            if constexpr (SP2) {
            PG8_LDB(B0, 0, 0); PG8_LDB(B1, 0, 1); PG8_SCHED; PG8_LDA(At, 0, 0); PG8_STAGE(PG8_SA(1, 1), a1 + hstep, voffA);
            PG8_WAIT_V(8); PG8_WAIT_L(0); PG8_BAR; PG8_MMA(0, 0, At, B0); PG8_MMA(0, 1, At, B1); PG8_BAR; PG8_SCHED;
            PG8_LDA(At, 0, 1); PG8_STAGE(PG8_SB(0, 0), b2, voffB); PG8_STAGE(PG8_SB(0, 1), b2 + hstep, voffB); PG8_STAGE(PG8_SA(0, 0), a2, voffA);
            PG8_WAIT_V(8); PG8_WAIT_L(0); PG8_BAR; PG8_MMA(1, 0, At, B0); PG8_MMA(1, 1, At, B1); PG8_BAR; PG8_SCHED;
            PG8_LDB(B0, 1, 0); PG8_LDB(B1, 1, 1); PG8_SCHED; PG8_LDA(At, 1, 0); PG8_STAGE(PG8_SA(0, 1), a2 + hstep, voffA);
            PG8_WAIT_V(8); PG8_WAIT_L(0); PG8_BAR; PG8_MMA(0, 0, At, B0); PG8_MMA(0, 1, At, B1); PG8_BAR; PG8_SCHED;
            PG8_LDA(At, 1, 1); PG8_STAGE(PG8_SB(1, 0), b3, voffB); PG8_STAGE(PG8_SB(1, 1), b3 + hstep, voffB); PG8_STAGE(PG8_SA(1, 0), a3, voffA);
            PG8_WAIT_V(8); PG8_WAIT_L(0); PG8_BAR; PG8_MMA(1, 0, At, B0); PG8_MMA(1, 1, At, B1); PG8_BAR; PG8_SCHED;
            } else {
            PG8_LDB(B0, 0, 0); PG8_SCHED; PG8_LDA(At, 0, 0); PG8_STAGE(PG8_SA(1, 1), a1 + hstep, voffA);
            PG8_WAIT_L(8); PG8_BAR; PG8_WAIT_L(0); PG8_MMA(0, 0, At, B0); PG8_BAR; PG8_SCHED;
            PG8_LDB(B1, 0, 1); PG8_STAGE(PG8_SB(0, 0), b2, voffB);
            PG8_BAR; PG8_WAIT_L(0); PG8_MMA(0, 1, At, B1); PG8_BAR;
            PG8_LDA(At, 0, 1); PG8_STAGE(PG8_SA(0, 0), a2, voffA);
            PG8_BAR; PG8_WAIT_L(0); PG8_MMA(1, 0, At, B0); PG8_BAR; PG8_SCHED;
            PG8_STAGE(PG8_SB(0, 1), b2 + hstep, voffB);
            PG8_WAIT_V(6); PG8_BAR; PG8_MMA(1, 1, At, B1); PG8_BAR;
            PG8_LDB(B0, 1, 0); PG8_SCHED; PG8_LDA(At, 1, 0); PG8_STAGE(PG8_SA(0, 1), a2 + hstep, voffA);
            PG8_WAIT_L(8); PG8_BAR; PG8_WAIT_L(0); PG8_MMA(0, 0, At, B0); PG8_BAR; PG8_SCHED;
            PG8_LDB(B1, 1, 1); PG8_STAGE(PG8_SB(1, 0), b3, voffB);
            PG8_BAR; PG8_WAIT_L(0); PG8_MMA(0, 1, At, B1); PG8_BAR;
            PG8_LDA(At, 1, 1); PG8_STAGE(PG8_SA(1, 0), a3, voffA);
            PG8_BAR; PG8_WAIT_L(0); PG8_MMA(1, 0, At, B0); PG8_BAR; PG8_SCHED;
            PG8_STAGE(PG8_SB(1, 1), b3 + hstep, voffB);
            PG8_WAIT_V(6); PG8_BAR; PG8_MMA(1, 1, At, B1); PG8_BAR;
            }
        }
        if constexpr (ALIGN_EPI) { if (wr == 0) PG8_BAR; }
        if constexpr (!Epi::AFTER_DRAIN) { E(acc, cur, wr, wc, fr, fq); S.done(cur); }
        if (!has_next) break;
#pragma unroll
        for (int a = 0; a < 2; ++a)
#pragma unroll
            for (int b = 0; b < 2; ++b)
#pragma unroll
                for (int m = 0; m < 4; ++m)
#pragma unroll
                    for (int n = 0; n < 2; ++n) acc[a][b][m][n] = (f32x4){0.f, 0.f, 0.f, 0.f};
        cur = nxt; cA = nA; cB = nB; ++ui;
        if constexpr (ALIGN_EPI) { if (wr == 1) PG8_BAR; }
    }
    PG8_WAIT_V(0);
    if constexpr (!ALIGN_EPI) { if (wr == 0) PG8_BAR; }
    PG8_BAR;
    if constexpr (Epi::AFTER_DRAIN) { E.fused(acc, cur, wr, wc, fr, fq, lds, wid, lane); S.done(cur); }
#undef PG8_SA
#undef PG8_SB
#undef PG8_STAGE
#undef PG8_LDA
#undef PG8_LDB
#undef PG8_MMA
#undef PG8_WAIT_V
#undef PG8_WAIT_L
#undef PG8_BAR
#undef PG8_SCHED
}
}

namespace pg8 {
__device__ __forceinline__ u32x4 pack8(const f32x4 a, const f32x4 b, float sc) {
    u32x4 w; w.x = cvt_pk_bf16(a[0] * sc, a[1] * sc); w.y = cvt_pk_bf16(a[2] * sc, a[3] * sc); w.z = cvt_pk_bf16(b[0] * sc, b[1] * sc); w.w = cvt_pk_bf16(b[2] * sc, b[3] * sc); return w;
}
struct EpiProj {
    static constexpr bool PERM = true, AFTER_DRAIN = false;
    bf16_t *Aq, *Ak, *Av, *Bh, *Bb, *Bc, *cq, *ckv, *ckr; float* ssq;
    __device__ __forceinline__ void operator()(const f32x4 (&acc)[2][2][4][2], const Unit& u, int wr, int wc, int fr_, int fq_) const {
        const int ln_ = lane_id_v(), fr = ln_ & 15, fq = ln_ >> 4; (void)fr_; (void)fq_;
        const int pn = u.pn; bf16_t* base; int ldc, colt, ssqi = -1, valid = 256; float sc = 1.f;
        if (pn < 3) { base = Aq; ldc = 768; colt = pn * 256; sc = QSCALE_A; }
        else if (pn < 6) { base = Ak; ldc = 768; colt = (pn - 3) * 256; }
        else if (pn < 9) { base = Av; ldc = 768; colt = (pn - 6) * 256; }
        else if (pn < 11) { base = Bh; ldc = 512; colt = (pn - 9) * 256; }
        else if (pn < 13) { base = Bb; ldc = 512; colt = (pn - 11) * 256; }
        else if (pn < 15) { base = Bc; ldc = 512; colt = (pn - 13) * 256; }
        else if (pn < 17) { base = cq; ldc = 512; colt = (pn - 15) * 256; ssqi = (pn - 15) * 4 + wc; }
        else if (pn < 18) { base = ckv; ldc = 256; colt = 0; ssqi = 8 + wc; }
        else { base = ckr; ldc = 32; colt = 0; valid = 32; }
        const int row0 = u.pm * BM + wr * 64 + fr, cl = wc * 32 + 8 * fq;
#pragma unroll
        for (int ai = 0; ai < 2; ++ai)
#pragma unroll
            for (int m = 0; m < 4; ++m) {
                const int row = row0 + ai * HALF + m * 16; bf16_t* rowp = base + (size_t)row * ldc + colt + cl;
                float q = 0.f;
#pragma unroll
                for (int bj = 0; bj < 2; ++bj) {
                    const f32x4 v0 = acc[ai][bj][m][0], v1 = acc[ai][bj][m][1];
                    q += (v0[0] * v0[0] + v0[1] * v0[1]) + (v0[2] * v0[2] + v0[3] * v0[3]) + (v1[0] * v1[0] + v1[1] * v1[1]) + (v1[2] * v1[2] + v1[3] * v1[3]);
                    if (cl + bj * HALF < valid) *(u32x4*)(rowp + bj * HALF) = pack8(v0, v1, sc);
                }
                if (ssqi >= 0) { q += bperm_f(ln_ ^ 16, q); q += bperm_f(ln_ ^ 32, q); if (fq == 0) ssq[(size_t)row * 12 + ssqi] = q; }
            }
    }
};
struct EpiQm {
    static constexpr bool PERM = true, AFTER_DRAIN = false;
    bf16_t* qm; const float* ssq; const float* cost; const float* sint;
    __device__ __forceinline__ void operator()(const f32x4 (&acc)[2][2][4][2], const Unit& u, int wr, int wc, int fr_, int fq_) const {
        const int ln_ = lane_id_v(), fr = ln_ & 15, fq = ln_ >> 4; (void)fr_; (void)fq_;
        const int row0 = u.pm * BM + wr * 64 + fr;
#pragma unroll
        for (int ai = 0; ai < 2; ++ai)
#pragma unroll
            for (int m = 0; m < 4; ++m) {
                const int row = row0 + ai * HALF + m * 16;
                const f32x4 s0 = *(const f32x4*)(ssq + (size_t)row * 12), s1 = *(const f32x4*)(ssq + (size_t)row * 12 + 4);
                const float rq = 1.0f / sqrtf((((s0[0] + s0[1]) + (s0[2] + s0[3])) + ((s1[0] + s1[1]) + (s1[2] + s1[3]))) * (1.0f / CQR) + RMS_EPS);
#pragma unroll
                for (int bj = 0; bj < 2; ++bj) {
                    const int g32 = u.pn * 8 + bj * 4 + wc;
                    if (g32 >= NUQ / 32) continue;
                    f32x4 v0 = acc[ai][bj][m][0] * rq, v1 = acc[ai][bj][m][1] * rq;
                    if (g32 % 3 == 2) {
                        f32x4 p0, p1;
#pragma unroll
                        for (int i = 0; i < 4; ++i) { p0[i] = bperm_f(ln_ ^ 32, v0[i]); p1[i] = bperm_f(ln_ ^ 32, v1[i]); }
                        const int j0 = (fq & 1) * 8;
                        const f32x4 c0 = *(const f32x4*)(cost + (size_t)row * 16 + j0), c1 = *(const f32x4*)(cost + (size_t)row * 16 + j0 + 4);
                        f32x4 n0 = *(const f32x4*)(sint + (size_t)row * 16 + j0), n1 = *(const f32x4*)(sint + (size_t)row * 16 + j0 + 4);
                        if (fq < 2) { n0 = -n0; n1 = -n1; }
                        v0 = v0 * c0 + p0 * n0; v1 = v1 * c1 + p1 * n1;
                    }
                    *(u32x4*)(qm + (size_t)row * NUQ + g32 * 32 + 8 * fq) = pack8(v0, v1, QSCALE_C);
                }
            }
    }
};
struct EpiKv {
    static constexpr bool PERM = true, AFTER_DRAIN = false;
    bf16_t* km; bf16_t* vc; const float* ssq;
    __device__ __forceinline__ void operator()(const f32x4 (&acc)[2][2][4][2], const Unit& u, int wr, int wc, int fr_, int fq_) const {
        const int ln_ = lane_id_v(), fr = ln_ & 15, fq = ln_ >> 4; (void)fr_; (void)fq_;
        const int row0 = u.pm * BM + wr * 64 + fr;
#pragma unroll
        for (int ai = 0; ai < 2; ++ai)
#pragma unroll
            for (int m = 0; m < 4; ++m) {
                const int row = row0 + ai * HALF + m * 16;
                const f32x4 s0 = *(const f32x4*)(ssq + (size_t)row * 12 + 8);
                const float rk = 1.0f / sqrtf(((s0[0] + s0[1]) + (s0[2] + s0[3])) * (1.0f / CKVR) + RMS_EPS);
#pragma unroll
                for (int bj = 0; bj < 2; ++bj) {
                    const int c8 = u.pn * 256 + bj * HALF + wc * 32 + 8 * fq;
                    if (c8 >= NUKV) continue;
                    bf16_t* dst = (c8 < 384) ? km + (size_t)row * NUQ + (c8 >> 6) * 96 + (c8 & 63) : vc + (size_t)row * 768 + (c8 - 384);
                    *(u32x4*)dst = pack8(acc[ai][bj][m][0], acc[ai][bj][m][1], rk);
                }
            }
    }
};
struct EpiResid {
    static constexpr bool PERM = false, AFTER_DRAIN = false;
    const float* src; float* out; const float* rs; const float* g; const float* b;
    __device__ __forceinline__ void operator()(const f32x4 (&acc)[2][2][4][2], const Unit& u, int wr, int wc, int fr_, int fq_) const {
        const int ln_ = lane_id_v(), fr = ln_ & 15, fq = ln_ >> 4; (void)fr_; (void)fq_;
        const int row0 = u.pm * BM + wr * 64 + fr, col0 = u.pn * BM + wc * 32 + 4 * fq;
#pragma unroll
        for (int bj = 0; bj < 2; ++bj)
#pragma unroll
            for (int n = 0; n < 2; ++n) {
                const int col = col0 + bj * HALF + n * 16;
                const f32x4 gv = *(const f32x4*)(g + col), bv = *(const f32x4*)(b + col);
#pragma unroll
                for (int ai = 0; ai < 2; ++ai)
#pragma unroll
                    for (int m = 0; m < 4; ++m) {
                        const size_t row = (size_t)(row0 + ai * HALF + m * 16);
                        const f32x4 t = *(const f32x4*)(src + row * DM + col); const f32x2 st = *(const f32x2*)(rs + row * 2);
                        const f32x4 h = (t - st.x) * st.y * gv + bv;
                        *(f32x4*)(out + row * DM + col) = h * ALPHA_DN + acc[ai][bj][m][n];
                    }
                asm volatile("" ::: "memory");
            }
    }
};
struct EpiGateUp {
    static constexpr bool PERM = true, AFTER_DRAIN = false;
    bf16_t* a; const float* cw; float* GS; float* US;
    __device__ __forceinline__ void operator()(const f32x4 (&acc)[2][2][4][2], const Unit& u, int wr, int wc, int fr_, int fq_) const {
        const int ln_ = lane_id_v(), fr = ln_ & 15, fq = ln_ >> 4; (void)fr_; (void)fq_;
        const int ch0 = u.pn * 128 + wc * 32 + 8 * fq, lane = fq * 16 + fr;
        const int src1 = (lane & 48) | ((fr - 1) & 15), src2 = (lane & 48) | ((fr - 2) & 15);
        f32x4 w0[2], w1[2], w2[2];
#pragma unroll
        for (int n = 0; n < 2; ++n) { w0[n] = *(const f32x4*)(cw + ch0 + 4 * n); w1[n] = *(const f32x4*)(cw + DFF + ch0 + 4 * n); w2[n] = *(const f32x4*)(cw + 2 * DFF + ch0 + 4 * n); }
#pragma unroll
        for (int ai = 0; ai < 2; ++ai) {
            const int span = u.pm * 4 + ai * 2 + wr;
            f32x4 q1[2] = {(f32x4){0.f, 0.f, 0.f, 0.f}, (f32x4){0.f, 0.f, 0.f, 0.f}}, q2[2] = {(f32x4){0.f, 0.f, 0.f, 0.f}, (f32x4){0.f, 0.f, 0.f, 0.f}};
#pragma unroll
            for (int m = 0; m < 4; ++m) {
                f32x4 o[2];
#pragma unroll
                for (int n = 0; n < 2; ++n) {
                    const f32x4 g = acc[ai][0][m][n], up = acc[ai][1][m][n]; f32x4 s1, s2;
#pragma unroll
                    for (int i = 0; i < 4; ++i) { s1[i] = bperm_f(src1, g[i]); s2[i] = bperm_f(src2, g[i]); }
                    f32x4 p1, p2;
#pragma unroll
                    for (int i = 0; i < 4; ++i) { p1[i] = fr >= 1 ? s1[i] : q1[n][i]; p2[i] = fr >= 2 ? s2[i] : q2[n][i]; }
                    q1[n] = s1; q2[n] = s2;
                    const f32x4 cv = w0[n] * p2 + w1[n] * p1 + w2[n] * g;
#pragma unroll
                    for (int i = 0; i < 4; ++i) o[n][i] = cv[i] * up[i] * __builtin_amdgcn_rcpf(1.0f + __builtin_amdgcn_exp2f(-LOG2E * cv[i]));
                    if (m == 0 && fr < 2) { *(f32x4*)(GS + ((size_t)span * 4 + fr) * DFF + ch0 + 4 * n) = g; *(f32x4*)(US + ((size_t)span * 2 + fr) * DFF + ch0 + 4 * n) = up; }
                    if (m == 3 && fr >= 14) *(f32x4*)(GS + ((size_t)span * 4 + fr - 12) * DFF + ch0 + 4 * n) = g;
                }
                const int row = u.pm * BM + ai * HALF + wr * 64 + m * 16 + fr;
                *(u32x4*)(a + (size_t)row * DFF + ch0) = pack8(o[0], o[1], 1.0f);
            }
        }
    }
};
}

namespace att {
typedef unsigned short bf16_t;
typedef short bf16x8 __attribute__((ext_vector_type(8)));
typedef short s16x4 __attribute__((ext_vector_type(4)));
typedef float f32x16 __attribute__((ext_vector_type(16)));
typedef float f32x4 __attribute__((ext_vector_type(4)));
typedef unsigned u32x4 __attribute__((ext_vector_type(4)));
#define SBAR() __builtin_amdgcn_sched_barrier(0)
#define ALAS __attribute__((address_space(3)))
constexpr int SHM_V = 64 * 128 * 2, SHM_KMAX = 64 * (96 * 2 + 16);
constexpr int L_V = 0, L_K = 2 * SHM_V, L_POS = L_K + 2 * SHM_KMAX, L_WS = L_POS + 2 * 80 * 4, L_XCH = L_WS + 8 * 64 * 4, L_END = L_XCH + 8 * 2 * 4;
#ifndef PROBE_TSEC
#define PROBE_TSEC 0
#endif
#ifndef PROBE_WAVE
#define PROBE_WAVE 0
#endif
constexpr float THR = 8.f;
constexpr int S_TMAX_OFF = 16384, S_PMAX_OFF = 16384 + 256;
constexpr float SKIP_T = 32.f;
__device__ __forceinline__ int v_st(int k, int c) { const int kk = (k & ~0xC) | ((k & 4) << 1) | ((k & 8) >> 1); return ((kk >> 3) * 4 + (c >> 5)) * 512 + ((kk & 7) * 32 + (c & 31)) * 2; }
__device__ __forceinline__ int v_rd_base(int lane) { return ((lane & 3) << 3) | (((lane >> 2) & 3) << 6) | (((lane >> 4) & 1) << 5) | (((lane >> 5) & 1) << 8); }
constexpr int v_rd_off(int d0, int ks, int half) { return d0 * 512 + ks * 4096 + half * 2048; }
__device__ __forceinline__ int crow(int r, int hi) { return (r & 3) + 8 * (r >> 2) + 4 * hi; }
__device__ __forceinline__ unsigned cvtpk(float lo, float hi) { unsigned r; asm volatile("v_cvt_pk_bf16_f32 %0, %1, %2" : "=v"(r) : "v"(lo), "v"(hi)); return r; }

template <int DQK, bool ALIBI>
__device__ __forceinline__ void qkt(f32x16& p0, f32x16& p1, const ALAS char* kb, const bf16x8* qr, const ALAS float* pk, float tmax, float rowc, float m_reg, float qmin, const f32x16& negm, int hi) {
    constexpr int KP = DQK * 2 + 16;
    if (ALIBI) {
        if (tmax <= qmin) {
            const float base = rowc - m_reg;
#pragma unroll
            for (int g = 0; g < 4; ++g) {
                const f32x4 k0 = *(const ALAS f32x4*)(pk + 8 * g + 4 * hi), k1 = *(const ALAS f32x4*)(pk + 32 + 8 * g + 4 * hi);
#pragma unroll
                for (int i = 0; i < 4; ++i) { p0[4 * g + i] = base + k0[i]; p1[4 * g + i] = base + k1[i]; }
            }
        } else {
#pragma unroll
            for (int g = 0; g < 4; ++g) {
                const f32x4 k0 = *(const ALAS f32x4*)(pk + 8 * g + 4 * hi), k1 = *(const ALAS f32x4*)(pk + 32 + 8 * g + 4 * hi);
#pragma unroll
                for (int i = 0; i < 4; ++i) { p0[4 * g + i] = -fabsf(rowc + k0[i]) - m_reg; p1[4 * g + i] = -fabsf(rowc + k1[i]) - m_reg; }
            }
        }
    }
#pragma unroll
    for (int d0 = 0; d0 < DQK / 16; ++d0) {
        const bf16x8 b0 = *(const ALAS bf16x8*)(kb + d0 * 32);
        const bf16x8 b1 = *(const ALAS bf16x8*)(kb + 32 * KP + d0 * 32);
        if (!ALIBI && d0 == 0) { p0 = __builtin_amdgcn_mfma_f32_32x32x16_bf16(b0, qr[0], negm, 0, 0, 0); p1 = __builtin_amdgcn_mfma_f32_32x32x16_bf16(b1, qr[0], negm, 0, 0, 0); }
        else { p0 = __builtin_amdgcn_mfma_f32_32x32x16_bf16(b0, qr[d0], p0, 0, 0, 0); p1 = __builtin_amdgcn_mfma_f32_32x32x16_bf16(b1, qr[d0], p1, 0, 0, 0); } }
}
__device__ __forceinline__ void pv_tile(f32x16* o, int vb, bf16x8 pa0, bf16x8 pa1, bf16x8 pa2, bf16x8 pa3) {
#define TRRD(dst, off) asm volatile("ds_read_b64_tr_b16 %0, %1 offset:%2" : "=&v"(dst) : "v"(vb), "i"(off) : "memory")
#define PV_D0(d0) do { s16x4 l0, l1, l2, l3, h0, h1, h2, h3; constexpr int b_ = v_rd_off(d0, 0, 0); \
        TRRD(l0, b_); TRRD(h0, b_ + 2048); TRRD(l1, b_ + 4096); TRRD(h1, b_ + 6144); TRRD(l2, b_ + 8192); TRRD(h2, b_ + 10240); TRRD(l3, b_ + 12288); TRRD(h3, b_ + 14336); \
        asm volatile("s_waitcnt lgkmcnt(0)" ::: "memory"); SBAR();   \
        o[d0] = __builtin_amdgcn_mfma_f32_32x32x16_bf16(pa0, (bf16x8){l0[0], l0[1], l0[2], l0[3], h0[0], h0[1], h0[2], h0[3]}, o[d0], 0, 0, 0);   \
        o[d0] = __builtin_amdgcn_mfma_f32_32x32x16_bf16(pa1, (bf16x8){l1[0], l1[1], l1[2], l1[3], h1[0], h1[1], h1[2], h1[3]}, o[d0], 0, 0, 0);   \
        o[d0] = __builtin_amdgcn_mfma_f32_32x32x16_bf16(pa2, (bf16x8){l2[0], l2[1], l2[2], l2[3], h2[0], h2[1], h2[2], h2[3]}, o[d0], 0, 0, 0);   \
        o[d0] = __builtin_amdgcn_mfma_f32_32x32x16_bf16(pa3, (bf16x8){l3[0], l3[1], l3[2], l3[3], h3[0], h3[1], h3[2], h3[3]}, o[d0], 0, 0, 0); } while (0)
    PV_D0(0); PV_D0(1); PV_D0(2); PV_D0(3);
#undef PV_D0
#undef TRRD
}
template <int DQK, bool ALIBI, int VAR = 0>
__device__ __forceinline__ void attn_pass(ALAS char* lds, const bf16_t* __restrict__ Qh, int ldq, const bf16_t* __restrict__ Kh, int ldk, const bf16_t* __restrict__ Vh, int ldv,
                                          const float* __restrict__ posf, int q0, float nslope, float kn, f32x16 (&o)[4], unsigned long long& tacc) {
    constexpr int ND = DQK / 16, CH = DQK / 8, KP = DQK * 2 + 16, SHM_K = 64 * KP;
    int tid_ = threadIdx.x; asm volatile("" : "+v"(tid_));
    const int tid = tid_, wid = __builtin_amdgcn_readfirstlane(tid >> 6), lane = tid & 63, r32 = lane & 31, hi = lane >> 5, grp = wid >> 2;
    int NTE = (q0 + 256) / 64;
    const int NT = (q0 + 256) / 64, nact = q0 / 64 + (wid >> 1) + 1, kfirst = NT - nact;
    ALAS char* V_lds = lds + L_V; ALAS char* K_lds = lds + L_K; ALAS float* pos_lds = (ALAS float*)(lds + L_POS); ALAS float* ws = (ALAS float*)(lds + L_WS) + wid * 64; ALAS float* li_l = ws; ALAS float* al_l = ws + 32; ALAS float* xch = (ALAS float*)(lds + L_XCH);
    bf16x8 qr[ND];
#pragma unroll
    for (int d0 = 0; d0 < ND; ++d0) qr[d0] = *(const bf16x8*)(Qh + (size_t)(q0 + wid * 32 + r32) * ldq + d0 * 16 + hi * 8);
    float rowc = 0.f, qmin = 0.f;
    if (ALIBI) { const float pq = posf[q0 + wid * 32 + r32]; rowc = nslope * pq; qmin = pq;
#pragma unroll
        for (int off = 1; off < 32; off <<= 1) qmin = fminf(qmin, bperm_f(lane ^ off, qmin)); }
    const int k0key = tid / CH, k0ch = tid - k0key * CH; const int i1 = tid + 512; const bool has1 = (CH == 12) && (tid < 256); const int k1key = i1 / CH, k1ch = i1 - k1key * CH;
    const int sr = tid >> 4, sc = (tid & 15) * 8, vst0 = v_st(sr, sc), vst1 = v_st(32 + sr, sc);
    const int vb0 = (int)(unsigned)(uintptr_t)V_lds + v_rd_base(lane);
    const ALAS char* kfr = K_lds + r32 * KP + hi * 16;
    bf16x8 st_k0, st_k1 = {}, st_v0, st_v1; float st_p = 0.f;
#define VMW() asm volatile("s_waitcnt vmcnt(0)" ::: "memory")
#define LBAR() do { TS_BEG(4); asm volatile("s_waitcnt lgkmcnt(0)\n\ts_barrier" ::: "memory"); TS_END(4); } while (0)
#define TI(k) (NT - 1 - (k))
#define SLOAD_K(t) do { const int kb_ = (t) * 64; st_k0 = *(const bf16x8*)(Kh + (size_t)(kb_ + k0key) * ldk + k0ch * 8); if (CH == 12) { if (has1) st_k1 = *(const bf16x8*)(Kh + (size_t)(kb_ + k1key) * ldk + k1ch * 8); } \
        if (ALIBI) { if (tid < 64) st_p = posf[kb_ + tid]; } } while (0)
#define SLOAD_V(t) do { const int kb_ = (t) * 64; st_v0 = *(const bf16x8*)(Vh + (size_t)(kb_ + sr) * ldv + sc); st_v1 = *(const bf16x8*)(Vh + (size_t)(kb_ + 32 + sr) * ldv + sc); } while (0)
#define SWRITE_K(bf) do { *(ALAS bf16x8*)(K_lds + (bf) * SHM_K + k0key * KP + k0ch * 16) = st_k0; if (CH == 12) { if (has1) *(ALAS bf16x8*)(K_lds + (bf) * SHM_K + k1key * KP + k1ch * 16) = st_k1; } \
        if (ALIBI) { if (tid < 64) pos_lds[(bf) * 80 + tid] = -nslope * st_p; } } while (0)
#define SWRITE_V(bf) do { *(ALAS bf16x8*)(V_lds + (bf) * SHM_V + vst0) = st_v0; *(ALAS bf16x8*)(V_lds + (bf) * SHM_V + vst1) = st_v1; } while (0)
    unsigned long long ts0_ = 0ull; (void)ts0_;
#define TS_BEG(id) do { if (PROBE_TSEC == (id) && wid == PROBE_WAVE) { ts0_ = __builtin_readcyclecounter(); } } while (0)
#define TS_END(id) do { if (PROBE_TSEC == (id) && wid == PROBE_WAVE) { tacc += __builtin_readcyclecounter() - ts0_; } } while (0)
    float m_reg = 0.f, l_reg = 0.f;
#pragma unroll
    for (int d0 = 0; d0 < 4; ++d0) o[d0] = f32x16{};
    f32x16 p0 = f32x16{}, p1 = f32x16{}, negm = f32x16{}; bf16x8 pa0 = {}, pa1 = {}, pa2 = {}, pa3 = {};
#define MBLOCK(k) do { if (VAR == 2) break; TS_BEG(2); SBAR(); \
        float tmx_ = 0.f; if (ALIBI) { const int kq_ = (k) < NT ? (k) : NT - 1; tmx_ = posf[S_TMAX_OFF + TI(kq_)]; } \
        if ((k) >= 1 && (k) - 1 >= kfirst) pv_tile(o, vb0 + (((k) - 1) & 1) * SHM_V, pa0, pa1, pa2, pa3); SBAR(); \
        if ((k) < NTE && (k) >= kfirst) qkt<DQK, ALIBI>(p0, p1, kfr + ((k) & 1) * SHM_K, qr, pos_lds + ((k) & 1) * 80, tmx_, rowc, m_reg, qmin, negm, hi); SBAR(); TS_END(2); } while (0)
#define VBLOCK(k) do { if (VAR != 1 && (k) >= kfirst) { TS_BEG(3); SBAR(); \
        float pmax = fmaxf(fmaxf(p0[0], p0[1]), p1[0]); \
        _Pragma("unroll") for (int r = 2; r < 16; r += 2) pmax = fmaxf(fmaxf(pmax, p0[r]), p0[r + 1]); \
        _Pragma("unroll") for (int r = 1; r < 15; r += 2) pmax = fmaxf(fmaxf(pmax, p1[r]), p1[r + 1]); \
        pmax = fmaxf(pmax, p1[15]); \
        { auto rr = __builtin_amdgcn_permlane32_swap(__float_as_uint(pmax), __float_as_uint(pmax), false, false); pmax = fmaxf(__uint_as_float(rr[0]), __uint_as_float(rr[1])); } \
        const bool first = (k) == kfirst; \
        if (first || !__all(pmax <= THR)) { \
            const float delta = first ? pmax : fmaxf(pmax, 0.f); m_reg += delta; \
            _Pragma("unroll") for (int r = 0; r < 16; ++r) { p0[r] -= delta; p1[r] -= delta; } \
            if (!ALIBI) { _Pragma("unroll") for (int r = 0; r < 16; ++r) negm[r] = -m_reg; } \
            { const float alpha = first ? 1.0f : __builtin_amdgcn_exp2f(-delta); l_reg *= alpha; \
                if (hi == 0) al_l[r32] = alpha; asm volatile("s_waitcnt lgkmcnt(0)" ::: "memory"); \
                _Pragma("unroll") for (int d_ = 0; d_ < 4; ++d_) _Pragma("unroll") for (int r = 0; r < 16; ++r) o[d_][r] *= al_l[crow(r, hi)]; } } \
        _Pragma("unroll") for (int r = 0; r < 16; ++r) { p0[r] = __builtin_amdgcn_exp2f(p0[r]); p1[r] = __builtin_amdgcn_exp2f(p1[r]); } \
        float ps = 0.f; \
        _Pragma("unroll") for (int r = 0; r < 16; ++r) ps += p0[r]; \
        _Pragma("unroll") for (int r = 0; r < 16; ++r) ps += p1[r]; \
        l_reg += ps; \
        PK4(p0, 0, pa0); PK4(p0, 8, pa1); PK4(p1, 0, pa2); PK4(p1, 8, pa3); SBAR(); TS_END(3); } } while (0)
#define PK4(P, B_, OUT) do { unsigned a0 = cvtpk(P[B_+0], P[B_+1]), a1 = cvtpk(P[B_+2], P[B_+3]);                          \
        unsigned b0 = cvtpk(P[B_+4], P[B_+5]), b1 = cvtpk(P[B_+6], P[B_+7]);                                             \
        auto r0 = __builtin_amdgcn_permlane32_swap(a0, b0, false, false); auto r1 = __builtin_amdgcn_permlane32_swap(a1, b1, false, false); \
        u32x4 w = {r0[0], r1[0], r0[1], r1[1]}; OUT = *reinterpret_cast<bf16x8*>(&w); } while (0)
#define SKIP_DECIDE() do { float B_ = xch[0], Q_ = xch[1]; _Pragma("unroll") for (int w = 1; w < 8; ++w) { B_ = fmaxf(B_, xch[2 * w]); Q_ = fminf(Q_, xch[2 * w + 1]); } \
        int kst_ = NT; _Pragma("unroll") for (int j_ = 0; j_ < 4; ++j_) { const int kc_ = 4 + lane + 64 * j_; \
            if (kc_ < NT) { const float pm_ = posf[S_PMAX_OFF + TI(kc_)]; if (B_ + nslope * fmaxf(Q_ - pm_, 0.f) <= -SKIP_T) kst_ = kc_ < kst_ ? kc_ : kst_; } } \
        _Pragma("unroll") for (int off = 1; off < 64; off <<= 1) { const int o_ = __builtin_amdgcn_ds_bpermute((lane ^ off) << 2, kst_); kst_ = o_ < kst_ ? o_ : kst_; } \
        kst_ = __builtin_amdgcn_readfirstlane(kst_); NTE = (kst_ + 1) & ~1; if (NTE > NT) NTE = NT; } while (0)
    if (ALIBI) { float ss_ = 0.f, sd_ = 0.f; const bf16_t* krow_ = Kh + (size_t)(q0 + wid * 32 + r32) * ldk + hi * 8;
#pragma unroll
        for (int d0 = 0; d0 < ND; ++d0) { const bf16x8 kv_ = *(const bf16x8*)(krow_ + d0 * 16);
#pragma unroll
            for (int e = 0; e < 8; ++e) { const float x_ = __uint_as_float((unsigned)(unsigned short)qr[d0][e] << 16), y_ = __uint_as_float((unsigned)(unsigned short)kv_[e] << 16); ss_ = fmaf(x_, x_, ss_); sd_ = fmaf(x_, y_, sd_); } }
        { auto rr = __builtin_amdgcn_permlane32_swap(__float_as_uint(ss_), __float_as_uint(ss_), false, false); ss_ = __uint_as_float(rr[0]) + __uint_as_float(rr[1]); }
        { auto rr = __builtin_amdgcn_permlane32_swap(__float_as_uint(sd_), __float_as_uint(sd_), false, false); sd_ = __uint_as_float(rr[0]) + __uint_as_float(rr[1]); }
        float b_ = sqrtf(ss_) * 1.0001f * kn - sd_;
#pragma unroll
        for (int off = 1; off < 32; off <<= 1) b_ = fmaxf(b_, bperm_f(lane ^ off, b_));
        if (lane == 0) { xch[2 * wid] = b_; xch[2 * wid + 1] = qmin; } }
    SLOAD_K(TI(0)); VMW(); SWRITE_K(0); LBAR();
    if (ALIBI) SKIP_DECIDE();
#define STG_W(k, KB) do { if (VAR != 3 && (k) < NTE) { TS_BEG(6); VMW(); if ((k) + 1 < NTE) SWRITE_K(1 - (KB)); SWRITE_V(KB); TS_END(6); } } while (0)
#define STG_L(k) do { if (VAR != 3) { TS_BEG(5); if ((k) + 2 < NTE) SLOAD_K(TI((k) + 2)); if ((k) + 1 < NTE) SLOAD_V(TI((k) + 1)); TS_END(5); } } while (0)
    if (1 < NT) SLOAD_K(TI(1));
    SLOAD_V(TI(0));
    if (grp == 0) {
#define BODY_A(k) do { \
            MBLOCK(k); LBAR(); \
            STG_W(k, 0); STG_L(k); if ((k) < NTE) VBLOCK(k); LBAR(); \
            if ((k) + 1 <= NTE) { \
            MBLOCK((k) + 1); LBAR(); \
            STG_W((k) + 1, 1); STG_L((k) + 1); if ((k) + 1 < NTE) VBLOCK((k) + 1); LBAR(); } } while (0)
        for (int k = 0; k <= NTE; k += 2) BODY_A(k);
#undef BODY_A
    } else {
#define BODY_B(k) do { \
            STG_W(k, 0); STG_L(k); if ((k) >= 1) VBLOCK((k) - 1); LBAR(); \
            MBLOCK(k); LBAR(); \
            if ((k) + 1 <= NTE) { \
            STG_W((k) + 1, 1); STG_L((k) + 1); VBLOCK(k); LBAR(); \
            MBLOCK((k) + 1); LBAR(); } } while (0)
        for (int k = 0; k <= NTE; k += 2) BODY_B(k);
#undef BODY_B
    }
#undef STG_W
#undef SKIP_DECIDE
#undef STG_L
    { auto rr = __builtin_amdgcn_permlane32_swap(__float_as_uint(l_reg), __float_as_uint(l_reg), false, false); l_reg = __uint_as_float(rr[0]) + __uint_as_float(rr[1]); }
    if (hi == 0) li_l[r32] = l_reg; asm volatile("s_waitcnt lgkmcnt(0)" ::: "memory");
#pragma unroll
    for (int r = 0; r < 16; ++r) { const float rl = __builtin_amdgcn_rcpf(li_l[crow(r, hi)]);
#pragma unroll
        for (int d0 = 0; d0 < 4; ++d0) o[d0][r] *= rl; }
#undef PK4
#undef VBLOCK
#undef MBLOCK
#undef SWRITE_V
#undef SWRITE_K
#undef SLOAD_V
#undef SLOAD_K
#undef TI
#undef VMW
#undef LBAR
#undef TS_BEG
#undef TS_END
}
__device__ __forceinline__ void store_o_bf16(const f32x16 (&o)[4], bf16_t* Ow  , int ldo, int r32, int hi) {
#pragma unroll
    for (int r = 0; r < 16; ++r) { const int orow = crow(r, hi);
#pragma unroll
        for (int d0 = 0; d0 < 4; ++d0) { const float v = o[d0][r]; const float vn = bperm_f((hi * 32 + r32) ^ 1, v);
            if ((r32 & 1) == 0) *(unsigned*)(Ow + (size_t)orow * ldo + d0 * 32 + r32) = cvtpk(v, vn); } }
}
#undef SBAR
}

#define LAS __attribute__((address_space(3)))
typedef unsigned short bf16;
typedef unsigned v4u __attribute__((ext_vector_type(4)));
typedef unsigned v2u __attribute__((ext_vector_type(2)));
typedef float f32x4 __attribute__((ext_vector_type(4)));
#ifndef ATT_NO_DIFF
#define ATT_NO_DIFF 0
#endif
#ifndef ATT_NO_MLA
#define ATT_NO_MLA 0
#endif
#ifndef ALIBI_ON
#define ALIBI_ON true
#endif
#ifndef PROBE_VAR
#define PROBE_VAR 0
#endif
#define PTS_BEG(id) do { if (PROBE_TSEC == (id) && __builtin_amdgcn_readfirstlane(threadIdx.x >> 6) == PROBE_WAVE) pts0 = __builtin_readcyclecounter(); } while (0)
#define PTS_END(id) do { if (PROBE_TSEC == (id) && __builtin_amdgcn_readfirstlane(threadIdx.x >> 6) == PROBE_WAVE) tacc += __builtin_readcyclecounter() - pts0; } while (0)
#define ATT_CALL_D(...) do { PTS_BEG(7); if (PROBE_VAR == 0 || rep == 0) att::attn_pass<64, ALIBI_ON, 0>(__VA_ARGS__); else att::attn_pass<64, ALIBI_ON, PROBE_VAR>(__VA_ARGS__); PTS_END(7); } while (0)
#define ATT_CALL_M(...) do { PTS_BEG(7); if (PROBE_VAR == 0 || rep == 0) att::attn_pass<96, false, 0>(__VA_ARGS__); else att::attn_pass<96, false, PROBE_VAR>(__VA_ARGS__); PTS_END(7); } while (0)
#ifndef PHMASK
#define PHMASK 0x1ff
#endif
#define EN(k) (((PHMASK) >> (k)) & 1)
constexpr int NWAVES = 8;
constexpr int RING_BYTES = 131072, MISC_OFF = RING_BYTES, LDS_BYTES = 147456;
static_assert(att::L_END <= RING_BYTES, "attention LDS");
constexpr size_t MiB = 1u << 20;
constexpr size_t WS_CTL = 0, WS_WIN = 1 * MiB, WS_WUQ = 20 * MiB, WS_WUKV = 21 * MiB, WS_WO = 22 * MiB, WS_WGU = 30 * MiB, WS_WDN = 74 * MiB;
constexpr size_t WS_POSF = 96 * MiB, WS_COS = 97 * MiB, WS_SIN = 98 * MiB, WS_SSQ = 99 * MiB, WS_HB = 100 * MiB, WS_SCR = 164 * MiB;
constexpr size_t WS_AQ = WS_SCR, WS_AK = WS_SCR + 24 * MiB, WS_AV = WS_SCR + 48 * MiB, WS_BH = WS_SCR + 72 * MiB, WS_BB = WS_SCR + 88 * MiB, WS_BC = WS_SCR + 104 * MiB,
                 WS_CQ = WS_SCR + 120 * MiB, WS_CKV = WS_SCR + 136 * MiB, WS_CKR = WS_SCR + 144 * MiB, WS_QM = WS_SCR + 146 * MiB, WS_KM = WS_SCR + 164 * MiB, WS_VC = WS_SCR + 182 * MiB,
                 WS_STASH = WS_SCR + 206 * MiB;
constexpr size_t WS_RS = WS_SSQ + 800 * 1024;
constexpr size_t WS_A = WS_SCR, WS_GS = WS_SCR + 176 * MiB, WS_US = WS_SCR + 198 * MiB;
constexpr size_t WS_END = WS_SCR + 238 * MiB;
static_assert(WS_WIN + (size_t)PINP * DM * 2 <= WS_WUQ && WS_WGU + (size_t)2 * DFF * DM * 2 <= WS_WDN && WS_WDN + (size_t)DM * DFF * 2 <= WS_POSF, "weight map");
static_assert((size_t)S * DFF * 2 <= 176 * MiB && (size_t)(S / 64) * 4 * DFF * 4 <= 22 * MiB && (size_t)(S / 64) * 2 * DFF * 4 <= 11 * MiB, "ffn map");

__device__ __forceinline__ unsigned f2bf(float f) { unsigned u = __builtin_bit_cast(unsigned, f); return (u + 0x7fffu + ((u >> 16) & 1u)) >> 16; }
__device__ __forceinline__ unsigned pk2(float lo, float hi) { return f2bf(lo) | (f2bf(hi) << 16); }
__device__ __forceinline__ float bf2f(unsigned short b) { return __builtin_bit_cast(float, (unsigned)b << 16); }
__device__ __forceinline__ float bflo(unsigned w) { return __builtin_bit_cast(float, w << 16); }
__device__ __forceinline__ float bfhi(unsigned w) { return __builtin_bit_cast(float, w & 0xffff0000u); }
__device__ __forceinline__ float wave_sum(float v) {
    const int ln = lane_id_v();
#pragma unroll
    for (int o = 1; o < 64; o <<= 1) v += bperm_f(ln ^ o, v);
    return v;
}
template <int MODE> __device__ __forceinline__ int dst_row(int n, int up) {
    if (MODE == 1) return ((n >> 7) << 8) + (n & 127) + up * 128;
    if (MODE == 2) { const int h = n / 192, w = n - h * 192; return w < 64 ? h * 64 + w : 384 + h * 128 + (w - 64); }
    return n;
}
template <int MODE> __device__ __forceinline__ void transpose_item(const float* __restrict__ W, int K, int N, bf16* __restrict__ WT, int up, const float* __restrict__ rs, LAS float* scr, int item, int lane) {
    const int nblk = N / 32, kb = item / nblk, nb = item - kb * nblk, k0 = 64 * kb, n0 = 32 * nb;
#pragma unroll 8
    for (int i = 0; i < 32; ++i) { const int kk = 2 * i + (lane >> 5); float v = W[(size_t)(k0 + kk) * N + n0 + (lane & 31)]; if (rs) v *= rs[k0 + kk]; scr[kk * 33 + (lane & 31)] = v; }
    asm volatile("s_waitcnt lgkmcnt(0)" ::: "memory");
    const int c = lane & 7;
#pragma unroll
    for (int j = 0; j < 4; ++j) { const int n = (lane >> 3) + 8 * j; const LAS float* s = scr + (8 * c) * 33 + n;
        v4u o; o.x = pk2(s[0 * 33], s[1 * 33]); o.y = pk2(s[2 * 33], s[3 * 33]); o.z = pk2(s[4 * 33], s[5 * 33]); o.w = pk2(s[6 * 33], s[7 * 33]);
        *(v4u*)(WT + (size_t)dst_row<MODE>(n0 + n, up) * K + k0 + 8 * c) = o; }
    asm volatile("s_waitcnt lgkmcnt(0)" ::: "memory");
}
struct Args {
    const float* x; const int* pos; const float *ln_in_g, *ln_in_b, *w_in, *diff_lambda, *diff_norm_g, *conv_w, *mla_q_norm_g, *mla_kv_norm_g, *w_uq, *w_ukv, *w_o, *ln1_g, *ln1_b,
        *ffn_w_gate, *ffn_w_up, *ffn_conv_w, *ffn_w_down, *ln2_g, *ln2_b;
    float* out; unsigned char* ws; int ph_lo, ph_hi;
};
typedef const __attribute__((address_space(4))) Args* ArgP;
__device__ __forceinline__ void convert_weights(ArgP a, int l, unsigned char* ws, LAS float* scr, int gw, int NGW, int lane) {
    constexpr int I_IN = (DM / 64) * (PIN / 32), I_UQ = (CQR / 64) * (NUQ / 32), I_UKV = (CKVR / 64) * (NUKV / 32), I_O = (DM / 64) * (DM / 32), I_G = (DM / 64) * (DFF / 32), I_D = (DFF / 64) * (DM / 32);
    constexpr int NITEMS = I_IN + I_UQ + I_UKV + I_O + 2 * I_G + I_D;
    for (int it = gw; it < NITEMS; it += NGW) {
        int r = it;
        if (r < I_IN) { transpose_item<0>(a->w_in + (size_t)l * DM * PIN, DM, PIN, (bf16*)(ws + WS_WIN), 0, nullptr, scr, r, lane); continue; } r -= I_IN;
        if (r < I_UQ) { transpose_item<0>(a->w_uq + (size_t)l * CQR * NUQ, CQR, NUQ, (bf16*)(ws + WS_WUQ), 0, a->mla_q_norm_g + l * CQR, scr, r, lane); continue; } r -= I_UQ;
        if (r < I_UKV) { transpose_item<2>(a->w_ukv + (size_t)l * CKVR * NUKV, CKVR, NUKV, (bf16*)(ws + WS_WUKV), 0, a->mla_kv_norm_g + l * CKVR, scr, r, lane); continue; } r -= I_UKV;
        if (r < I_O) { transpose_item<0>(a->w_o + (size_t)l * DM * DM, DM, DM, (bf16*)(ws + WS_WO), 0, nullptr, scr, r, lane); continue; } r -= I_O;
        if (r < I_G) { transpose_item<1>(a->ffn_w_gate + (size_t)l * DM * DFF, DM, DFF, (bf16*)(ws + WS_WGU), 0, nullptr, scr, r, lane); continue; } r -= I_G;
        if (r < I_G) { transpose_item<1>(a->ffn_w_up + (size_t)l * DM * DFF, DM, DFF, (bf16*)(ws + WS_WGU), 1, nullptr, scr, r, lane); continue; } r -= I_G;
        transpose_item<0>(a->ffn_w_down + (size_t)l * DFF * DM, DFF, DM, (bf16*)(ws + WS_WDN), 0, nullptr, scr, r, lane);
    }
}
template <bool FINAL> __device__ __forceinline__ void ln_row(const float* xin, float* hout, bf16* hb, float* rs2, const float* __restrict__ g, const float* __restrict__ b, int lane) {
    const f32x4* xr = (const f32x4*)xin + lane;
    f32x4 v[8]; float s = 0.f;
#pragma unroll
    for (int j = 0; j < 8; ++j) { v[j] = xr[64 * j]; s += (v[j].x + v[j].y) + (v[j].z + v[j].w); }
    const float mean = wave_sum(s) * (1.f / DM); float s2 = 0.f;
#pragma unroll
    for (int j = 0; j < 8; ++j) { v[j] = v[j] - mean; s2 += (v[j].x * v[j].x + v[j].y * v[j].y) + (v[j].z * v[j].z + v[j].w * v[j].w); }
    const float rstd = 1.f / sqrtf(wave_sum(s2) * (1.f / DM) + LN_EPS);
    if (!FINAL && lane == 0) { rs2[0] = mean; rs2[1] = rstd; }
    f32x4* ho = (f32x4*)hout + lane; v2u* o8 = (v2u*)hb + lane;
#pragma unroll
    for (int j = 0; j < 8; ++j) { const f32x4 gg = ((const f32x4*)g)[64 * j + lane], bb = ((const f32x4*)b)[64 * j + lane]; const f32x4 y = v[j] * rstd * gg + bb;
        if (FINAL) ho[64 * j] = y; else { v2u w; w.x = pk2(y.x, y.y); w.y = pk2(y.z, y.w); o8[64 * j] = w; } }
}
__device__ __forceinline__ void sincos_f32(float x, float& sn, float& cs) {
    const float k = __builtin_rintf(x * 0.636619772f);
    float y = __builtin_fmaf(-k, 1.570796371e+00f, x); y = __builtin_fmaf(-k, -4.371138829e-08f, y);
    const float y2 = y * y;
    float sp = 2.86567956e-6f; sp = sp * y2 - 1.98559923e-4f; sp = sp * y2 + 8.33338592e-3f; sp = sp * y2 - 1.66666672e-1f; const float sy = __builtin_fmaf(y * y2, sp, y);
    float cp = 2.44677067e-5f; cp = cp * y2 - 1.38877297e-3f; cp = cp * y2 + 4.16666567e-2f; cp = cp * y2 - 0.5f; const float cy = __builtin_fmaf(y2, cp, 1.0f);
    const int q = (int)k & 3;
    const float s_ = (q & 1) ? cy : sy, c_ = (q & 1) ? sy : cy;
    sn = (q & 2) ? -s_ : s_; cs = ((q + 1) & 2) ? -c_ : c_;
}
__device__ __forceinline__ float inv_freq16(int j) {
    float v = 1.000000000e+00f;
    v = j == 1 ? 5.623413324e-01f : v; v = j == 2 ? 3.162277639e-01f : v; v = j == 3 ? 1.778279394e-01f : v; v = j == 4 ? 1.000000015e-01f : v; v = j == 5 ? 5.623413250e-02f : v;
    v = j == 6 ? 3.162277490e-02f : v; v = j == 7 ? 1.778279431e-02f : v; v = j == 8 ? 9.999999776e-03f : v; v = j == 9 ? 5.623413250e-03f : v; v = j == 10 ? 3.162277630e-03f : v;
    v = j == 11 ? 1.778279431e-03f : v; v = j == 12 ? 1.000000047e-03f : v; v = j == 13 ? 5.623413017e-04f : v; v = j == 14 ? 3.162277571e-04f : v; v = j == 15 ? 1.778279402e-04f : v;
    return v;
}

#define XB_TMO      128
#define XB_XCNT(j)  (256  + 64 * (j))
#define XB_XSUB(j)  (1280 + 64 * (j))
#define XB_XGEN(j)  (2304 + 64 * (j))
#define XB_TOP      3328
#define XB_TOPGEN   3392
#define XCD_BAR_WORDS 3456
#define XB_SPIN_CAP (1u << 18)

__device__ __forceinline__ unsigned xb_ld(unsigned* p)              { return __hip_atomic_load(p, __ATOMIC_RELAXED, __HIP_MEMORY_SCOPE_AGENT); }
__device__ __forceinline__ unsigned xb_add(unsigned* p, unsigned v) { return __hip_atomic_fetch_add(p, v, __ATOMIC_RELAXED, __HIP_MEMORY_SCOPE_AGENT); }
__device__ __forceinline__ unsigned xb_xcc_id() { return (unsigned)__builtin_amdgcn_s_getreg((3 << 11) | 20) & 0xFu; }
#define XB_SPIN(cond, bar) do { unsigned _sp = 0; while (cond) { __builtin_amdgcn_s_sleep(1); \
    if ((++_sp & 255u) == 0u) { if (xb_ld(&(bar)[XB_TMO])) break; if (_sp > XB_SPIN_CAP) { atomicAdd(&(bar)[XB_TMO], 1u); break; } } } } while (0)

struct XcdBarrier {
    unsigned* bar; unsigned x;
    volatile LAS unsigned* st;
};

__device__ __forceinline__ XcdBarrier xcd_barrier_post(unsigned* bar, volatile LAS unsigned* st) {
    XcdBarrier b; b.bar = bar; b.x = xb_xcc_id(); b.st = st;
    if (threadIdx.x == 0) (void)xb_add(&bar[XB_XCNT(b.x)], 1u);
    return b;
}
__device__ __forceinline__ void xcd_barrier_complete(unsigned* bar, unsigned x, unsigned& nloc, unsigned& nx) {
    const unsigned G = gridDim.x * gridDim.y * gridDim.z;
    unsigned sum, cnt, mine, sp = 0u;
    for (;;) {
        sum = 0u; cnt = 0u; mine = 0u;
#pragma unroll
        for (unsigned j = 0; j < 16; ++j) { const unsigned c = xb_ld(&bar[XB_XCNT(j)]); sum += c; cnt += (c > 0u) ? 1u : 0u; mine = (j == x) ? c : mine; }
        if (sum == G) break;
        __builtin_amdgcn_s_sleep(1);
        if ((++sp & 255u) == 0u) { if (xb_ld(&bar[XB_TMO])) break; if (sp > XB_SPIN_CAP) { atomicAdd(&bar[XB_TMO], 1u); break; } }
    }
    nloc = mine > 0u ? mine : 1u; nx = cnt > 0u ? cnt : 1u;
}

__device__ __forceinline__ void xcd_barrier(const XcdBarrier& b) {
    asm volatile("s_waitcnt vmcnt(0)" ::: "memory");
    __syncthreads();
    if (threadIdx.x == 0) {
        unsigned* bar = b.bar;
        __builtin_amdgcn_s_waitcnt(0);
        unsigned nloc = b.st[0], nx = b.st[1];
        if (nloc == 0u) { xcd_barrier_complete(bar, b.x, nloc, nx); b.st[0] = nloc; b.st[1] = nx; }
        const unsigned old = xb_add(&bar[XB_XSUB(b.x)], 1u);
        const unsigned gen = old / nloc;
        if (old + 1u == (gen + 1u) * nloc) {
            __builtin_amdgcn_fence(__ATOMIC_RELEASE, "agent");
            asm volatile("s_waitcnt vmcnt(0)" ::: "memory");
            const unsigned og = xb_add(&bar[XB_TOP], 1u);
            const unsigned tg = og / nx;
            if (og + 1u == (tg + 1u) * nx) xb_add(&bar[XB_TOPGEN], 1u);
            else XB_SPIN(xb_ld(&bar[XB_TOPGEN]) == tg, bar);
            __builtin_amdgcn_fence(__ATOMIC_ACQUIRE, "agent");
            xb_add(&bar[XB_XGEN(b.x)], 1u);
            asm volatile("s_waitcnt vmcnt(0)" ::: "memory");
        } else {
            XB_SPIN(xb_ld(&bar[XB_XGEN(b.x)]) == gen, bar);
            __builtin_amdgcn_fence(__ATOMIC_ACQUIRE, "agent");
            asm volatile("s_waitcnt vmcnt(0)" ::: "memory");
        }
    }
    __syncthreads();
}

constexpr int CW_BAR = 4096, CW_KN = 1024;
__device__ const unsigned short DIFF_ORDER[384] = {317,325,333,341,349,357,365,373,381,389,397,405,413,421,429,437,445,453,461,469,477,485,493,501,509,309,301,293,285,277,269,261,253,245,237,229,221,213,205,197,189,181,173,165,157,149,141,133,132,140,148,156,164,172,180,188,196,204,212,220,228,236,244,252,260,268,276,284,292,300,308,316,324,332,340,348,356,364,372,380,388,396,404,412,420,428,436,444,452,460,468,476,484,492,500,508,124,125,116,117,108,109,100,101,92,93,84,85,76,77,68,69,60,61,59,67,75,83,91,99,107,115,123,131,139,147,155,163,171,179,187,195,203,211,219,227,235,243,251,259,267,275,283,291,299,307,315,323,331,339,347,355,363,371,379,387,395,403,411,419,427,435,443,451,459,467,475,483,491,499,507,51,52,53,43,44,45,35,36,37,27,28,29,26,34,42,50,58,66,74,82,90,98,106,114,122,130,138,146,154,162,170,178,186,194,202,210,218,226,234,242,250,258,266,274,282,290,298,306,314,322,330,338,346,354,362,370,378,386,394,402,410,418,426,434,442,450,458,466,474,482,490,498,506,18,19,20,21,9,10,11,12,13,17,25,33,41,49,57,65,73,81,89,97,105,113,121,129,137,145,153,161,169,177,185,193,201,209,217,225,233,241,249,257,265,273,281,289,297,305,313,321,329,337,345,353,361,369,377,385,393,401,409,417,425,433,441,449,457,465,473,481,489,497,505,8,16,24,32,40,48,56,64,72,80,88,96,104,112,120,128,136,144,152,160,168,176,184,192,200,208,216,224,232,240,248,256,264,272,280,288,296,304,312,320,328,336,344,352,360,368,376,384,392,400,408,416,424,432,440,448,456,464,472,480,488,496,504,0,1,2,3,4,5};
__global__ void __launch_bounds__(NWAVES * 64, 2) mk_fwd(Args a) {
    extern __shared__ __attribute__((aligned(16))) unsigned char lds[];
    cg::grid_group grid = cg::this_grid();
    const int G = gridDim.x, NGW = G * NWAVES, NGT = G * NWAVES * 64;
    LAS unsigned char* ldsl = (LAS unsigned char*)lds;
    volatile LAS unsigned* MISC = (volatile LAS unsigned*)(ldsl + MISC_OFF);
    if (threadIdx.x < 32) MISC[threadIdx.x] = 0u;
    __syncthreads();

#ifndef PROBE_SUB
#define PROBE_SUB -1
#endif
    unsigned long long tacc = 0ull, pts0 = 0ull; (void)pts0;
    constexpr int NPROG = 1 + 9 * NLAYER + (PROBE_SUB >= 0 ? (PROBE_SUB >= 9 ? 1 : NLAYER) : 0);
    for (int pi = 0; pi < NPROG; ++pi) {
        int ph = pi, rep = 0;
        if (PROBE_SUB >= 9) { if (pi >= 1) { ph = pi - 1; rep = pi == 1; } }
        else if (PROBE_SUB >= 0) { constexpr int p0 = 1 + PROBE_SUB, p1 = 10 + PROBE_SUB;
            if (pi <= p0) ph = pi; else if (pi == p0 + 1) { ph = p0; rep = 1; } else if (pi <= p1 + 1) ph = pi - 1; else if (pi == p1 + 2) { ph = p1; rep = 1; } else ph = pi - 2; }
        ArgP ap = (ArgP)__builtin_amdgcn_kernarg_segment_ptr(); asm volatile("" : "+s"(ap));
        unsigned char* ws = ap->ws;
        float* hres = ap->out;
        bf16* hb = (bf16*)(ws + WS_HB);
        float* posf = (float*)(ws + WS_POSF); float* cost = (float*)(ws + WS_COS); float* sint = (float*)(ws + WS_SIN); float* ssq = (float*)(ws + WS_SSQ);
        unsigned* qctr = (unsigned*)(ws + WS_CTL);
        if (PROBE_SUB == 10 && pi == 1) { for (int e = 0; e < 10; ++e) { XcdBarrier xb_; xb_.bar = qctr + CW_BAR; xb_.x = xb_xcc_id(); xb_.st = MISC + 8; xcd_barrier(xb_); } continue; }
        if (ph == 0 && EN(0)) {
            int tid_ = threadIdx.x; asm volatile("" : "+v"(tid_)); const int tid = tid_, lane = tid & 63, wave = __builtin_amdgcn_readfirstlane(tid >> 6), gw = blockIdx.x * NWAVES + wave, gt = blockIdx.x * (NWAVES * 64) + tid; (void)gt; (void)gw; (void)lane;
            if (blockIdx.x == 0 && rep == 0) { if (tid < 16) __hip_atomic_store(qctr + 64 * tid, 0u, __ATOMIC_RELAXED, __HIP_MEMORY_SCOPE_AGENT);
                for (int i = tid; i < XCD_BAR_WORDS; i += NWAVES * 64) __hip_atomic_store(qctr + CW_BAR + i, 0u, __ATOMIC_RELAXED, __HIP_MEMORY_SCOPE_AGENT); }
            convert_weights(ap, 0, ws, (LAS float*)(ldsl + wave * 16384), gw, NGW, lane);
            for (int m = gw; m < S; m += NGW) ln_row<false>(ap->x + (size_t)m * DM, nullptr, hb + (size_t)m * DM, (float*)(ws + WS_RS) + 2 * m, ap->ln_in_g, ap->ln_in_b, lane);
            if (gw < S / 64) { float mx = (float)ap->pos[gw * 64 + lane];
#pragma unroll
                for (int off = 1; off < 64; off <<= 1) mx = fmaxf(mx, bperm_f(lane ^ off, mx));
                if (lane == 0) posf[att::S_TMAX_OFF + gw] = mx; }
            for (int i = gt; i < S * 16; i += NGT) { const int s = i >> 4, j = i & 15; const float p = (float)ap->pos[s];
                float sn, cs; sincos_f32(p * inv_freq16(j), sn, cs); cost[i] = cs; sint[i] = sn; if (j == 0) posf[s] = p; }
        } else {
            const int l = (ph - 1) / 9, sub = (ph - 1) % 9;
            const float lam_init = l == 0 ? 0.2f : 0.35550906759096927f;
            if (sub == 0 && EN(1)) {
                if (blockIdx.x == 0) {
                    const int lane = lane_id_v(); const bool w0 = __builtin_amdgcn_readfirstlane(threadIdx.x >> 6) == 0;
                    if (w0 && lane < 12) __hip_atomic_store(qctr + CW_KN + lane, 0u, __ATOMIC_RELAXED, __HIP_MEMORY_SCOPE_AGENT);
                    if (w0) { float carry = -3.0e38f;
                        for (int j = 0; j < 4; ++j) { float v = posf[att::S_TMAX_OFF + 64 * j + lane];
#pragma unroll
                            for (int off = 1; off < 64; off <<= 1) { const float t = bperm_f(lane >= off ? lane - off : lane, v); v = lane >= off ? fmaxf(v, t) : v; }
                            v = fmaxf(v, carry); posf[att::S_PMAX_OFF + 64 * j + lane] = v; carry = bperm_f(63, v); } }
                }
                pg8::Gemm g{hb, (const bf16*)(ws + WS_WIN), S, PINP, DM}; pg8::StaticOrder so; so.init(S, PINP, G, (int)blockIdx.x);
                pg8::EpiProj E{(bf16*)(ws + WS_AQ), (bf16*)(ws + WS_AK), (bf16*)(ws + WS_AV), (bf16*)(ws + WS_BH), (bf16*)(ws + WS_BB), (bf16*)(ws + WS_BC), (bf16*)(ws + WS_CQ), (bf16*)(ws + WS_CKV), (bf16*)(ws + WS_CKR), ssq};
                pg8::gemm_phase<pg8::EpiProj, pg8::StaticOrder, true, true>(ldsl, g, so, E);
            } else if (sub == 1 && EN(2)) {
                int tid_ = threadIdx.x; asm volatile("" : "+v"(tid_)); const int tid = tid_, lane = tid & 63, wave = __builtin_amdgcn_readfirstlane(tid >> 6), gw = blockIdx.x * NWAVES + wave, gt = blockIdx.x * (NWAVES * 64) + tid; (void)gt; (void)gw; (void)lane;
                const bf16* ckr = (const bf16*)(ws + WS_CKR); bf16* km = (bf16*)(ws + WS_KM);
                for (int s0 = gw * 4; s0 < S; s0 += NGW * 4) { const int s = s0 + (lane >> 4), j = lane & 15;
                    const float x1 = bf2f(ckr[s * 32 + j]), x2 = bf2f(ckr[s * 32 + 16 + j]), c = cost[s * 16 + j], sn = sint[s * 16 + j];
                    const unsigned short o1 = (unsigned short)f2bf(x1 * c - x2 * sn), o2 = (unsigned short)f2bf(x2 * c + x1 * sn);
#pragma unroll
                    for (int h = 0; h < 6; ++h) { km[(size_t)s * NUQ + h * 96 + 64 + j] = o1; km[(size_t)s * NUQ + h * 96 + 80 + j] = o2; } }
                { const bf16* Bh = (const bf16*)(ws + WS_BH); const bf16* Bb = (const bf16*)(ws + WS_BB); const bf16* Bc = (const bf16*)(ws + WS_BC); const float* cw = ap->conv_w + (size_t)l * 3 * 512;
                  const int c = lane * 8; float w[3][8];
#pragma unroll
                  for (int i = 0; i < 3; ++i) { const f32x4 u0 = *(const f32x4*)(cw + i * 512 + c), u1 = *(const f32x4*)(cw + i * 512 + c + 4); w[i][0] = u0.x; w[i][1] = u0.y; w[i][2] = u0.z; w[i][3] = u0.w; w[i][4] = u1.x; w[i][5] = u1.y; w[i][6] = u1.z; w[i][7] = u1.w; }
                  for (int t = gw; t < S; t += NGW) {
                      float acc[8] = {0.f, 0.f, 0.f, 0.f, 0.f, 0.f, 0.f, 0.f};
#pragma unroll
                      for (int i = 0; i < 3; ++i) { const int tt = t - 2 + i; if (tt < 0) continue;
                          const v4u hv = *(const v4u*)(Bh + (size_t)tt * 512 + c), cv = *(const v4u*)(Bc + (size_t)tt * 512 + c);
                          acc[0] += w[i][0] * bflo(hv.x) * bflo(cv.x); acc[1] += w[i][1] * bfhi(hv.x) * bfhi(cv.x); acc[2] += w[i][2] * bflo(hv.y) * bflo(cv.y); acc[3] += w[i][3] * bfhi(hv.y) * bfhi(cv.y);
                          acc[4] += w[i][4] * bflo(hv.z) * bflo(cv.z); acc[5] += w[i][5] * bfhi(hv.z) * bfhi(cv.z); acc[6] += w[i][6] * bflo(hv.w) * bflo(cv.w); acc[7] += w[i][7] * bfhi(hv.w) * bfhi(cv.w); }
                      const v4u bv = *(const v4u*)(Bb + (size_t)t * 512 + c); v4u o;
                      o.x = pk2(acc[0] * bflo(bv.x), acc[1] * bfhi(bv.x)); o.y = pk2(acc[2] * bflo(bv.y), acc[3] * bfhi(bv.y)); o.z = pk2(acc[4] * bflo(bv.z), acc[5] * bfhi(bv.z)); o.w = pk2(acc[6] * bflo(bv.w), acc[7] * bfhi(bv.w));
                      *(v4u*)(hb + (size_t)t * DM + 768 + c) = o; } }
                { const bf16* Ak = (const bf16*)(ws + WS_AK); float m0 = 0.f, m1 = 0.f;
                  for (int t = gw; t < S; t += NGW) {
                      const v4u a0 = *(const v4u*)(Ak + (size_t)t * 768 + lane * 8); v4u a1 = {0u, 0u, 0u, 0u}; if (lane < 32) a1 = *(const v4u*)(Ak + (size_t)t * 768 + 512 + lane * 8);
                      float s0 = bflo(a0.x) * bflo(a0.x) + bfhi(a0.x) * bfhi(a0.x) + bflo(a0.y) * bflo(a0.y) + bfhi(a0.y) * bfhi(a0.y) + bflo(a0.z) * bflo(a0.z) + bfhi(a0.z) * bfhi(a0.z) + bflo(a0.w) * bflo(a0.w) + bfhi(a0.w) * bfhi(a0.w);
                      float s1 = bflo(a1.x) * bflo(a1.x) + bfhi(a1.x) * bfhi(a1.x) + bflo(a1.y) * bflo(a1.y) + bfhi(a1.y) * bfhi(a1.y) + bflo(a1.z) * bflo(a1.z) + bfhi(a1.z) * bfhi(a1.z) + bflo(a1.w) * bflo(a1.w) + bfhi(a1.w) * bfhi(a1.w);
#pragma unroll
                      for (int off = 1; off < 8; off <<= 1) { s0 += bperm_f(lane ^ off, s0); s1 += bperm_f(lane ^ off, s1); }
                      m0 = fmaxf(m0, s0); m1 = fmaxf(m1, s1); }
                  if ((lane & 7) == 0) { __hip_atomic_fetch_max(qctr + CW_KN + (lane >> 3), __float_as_uint(m0), __ATOMIC_RELAXED, __HIP_MEMORY_SCOPE_AGENT);
                      if (lane < 32) __hip_atomic_fetch_max(qctr + CW_KN + 8 + (lane >> 3), __float_as_uint(m1), __ATOMIC_RELAXED, __HIP_MEMORY_SCOPE_AGENT); } }
                { pg8::Gemm g{(const bf16*)(ws + WS_CQ), (const bf16*)(ws + WS_WUQ), S, NUQP, CQR}; pg8::StaticOrder so; so.init(S, NUQP, G, (int)blockIdx.x);
                  pg8::EpiQm E{(bf16*)(ws + WS_QM), ssq, cost, sint};
                  pg8::gemm_phase<pg8::EpiQm, pg8::StaticOrder, true, true>(ldsl, g, so, E); }
                { pg8::Gemm g{(const bf16*)(ws + WS_CKV), (const bf16*)(ws + WS_WUKV), S, NUKVP, CKVR}; pg8::StaticOrder so; so.init(S, NUKVP, G, (int)blockIdx.x);
                  pg8::EpiKv E{km, (bf16*)(ws + WS_VC), ssq};
                  pg8::gemm_phase<pg8::EpiKv, pg8::StaticOrder, true, true>(ldsl, g, so, E); }
            } else if (sub == 2 && EN(3)) {
                float lam; { const int lane = lane_id_v(); const float* dl = ap->diff_lambda + (size_t)l * 256;
                  lam = __expf(wave_sum(dl[lane] * dl[64 + lane])) - __expf(wave_sum(dl[128 + lane] * dl[192 + lane])) + lam_init; }
                if (!ATT_NO_MLA) for (;;) {
                    PTS_BEG(9); if (threadIdx.x == 0) MISC[0] = __hip_atomic_fetch_add(qctr + 64 * (8 + l + 2 * rep), 1u, __ATOMIC_RELAXED, __HIP_MEMORY_SCOPE_AGENT);
                    __syncthreads(); const unsigned u = MISC[0]; __syncthreads(); PTS_END(9);
                    if (u >= 48u) break;
                    const int qb = 63 - (int)(u / 6u), h = (int)(u % 6u), q0 = qb * 256;
                    att::f32x16 o[4];
                    ATT_CALL_M((LAS char*)ldsl, (const bf16*)(ws + WS_QM) + h * 96, NUQ, (const bf16*)(ws + WS_KM) + h * 96, NUQ, (const bf16*)(ws + WS_VC) + h * 128, 768, posf, q0, 0.f, 0.f, o, tacc);
                    const int ln3 = lane_id_v(), r32 = ln3 & 31, hi = ln3 >> 5, wv3 = __builtin_amdgcn_readfirstlane(threadIdx.x >> 6);
                    att::store_o_bf16(o, (rep ? (bf16*)(ws + WS_BH) : hb) + (size_t)(q0 + wv3 * 32) * DM + 1280 + h * 128, DM, r32, hi);
                }
                if (!ATT_NO_DIFF) for (;;) {
                    PTS_BEG(9); if (threadIdx.x == 0) MISC[0] = __hip_atomic_fetch_add(qctr + 64 * (2 * l + 4 * rep), 1u, __ATOMIC_RELAXED, __HIP_MEMORY_SCOPE_AGENT);
                    __syncthreads(); const unsigned u = MISC[0]; __syncthreads(); PTS_END(9);
                    if (u >= 384u) break;
                    const unsigned id = DIFF_ORDER[u]; const int qb = (int)(id >> 3), h = (int)(id & 7u), q0 = qb * 256;
                    att::f32x16 o[4];
                    const float nslope = -LOG2E * __builtin_amdgcn_exp2f(-8.0f * (float)(h + 1) / 6.0f);
                    for (int mp = 0; mp < 2; ++mp) {
                        ATT_CALL_D((LAS char*)ldsl, (const bf16*)(ws + WS_AQ) + h * 128 + mp * 64, 768, (const bf16*)(ws + WS_AK) + h * 128 + mp * 64, 768, (const bf16*)(ws + WS_AV) + h * 128, 768, posf, q0, nslope, sqrtf(__uint_as_float(__hip_atomic_load(qctr + CW_KN + 2 * h + mp, __ATOMIC_RELAXED, __HIP_MEMORY_SCOPE_AGENT))) * 1.0001f, o, tacc);
                        const int ln2 = lane_id_v(), wv2 = __builtin_amdgcn_readfirstlane(threadIdx.x >> 6);
                        float* st = (float*)(ws + WS_STASH) + (((size_t)blockIdx.x * NWAVES + wv2) * 64 + ln2) * 64;
                        if (mp == 0) {
#pragma unroll
                            for (int d0 = 0; d0 < 4; ++d0)
#pragma unroll
                                for (int r = 0; r < 16; r += 4) *(f32x4*)(st + d0 * 16 + r) = (f32x4){o[d0][r], o[d0][r + 1], o[d0][r + 2], o[d0][r + 3]};
                        } else {
                            asm volatile("s_waitcnt vmcnt(0)" ::: "memory");
#pragma unroll
                            for (int d0 = 0; d0 < 4; ++d0)
#pragma unroll
                                for (int r = 0; r < 16; r += 4) { const f32x4 sv = *(const f32x4*)(st + d0 * 16 + r);
#pragma unroll
                                    for (int i = 0; i < 4; ++i) o[d0][r + i] = sv[i] - lam * o[d0][r + i]; }
                        }
                    }
                    const int ln3 = lane_id_v(), r32 = ln3 & 31, hi = ln3 >> 5, wv3 = __builtin_amdgcn_readfirstlane(threadIdx.x >> 6);
                    const float* dng = ap->diff_norm_g + (size_t)l * 128; float gc[4];
#pragma unroll
                    for (int d0 = 0; d0 < 4; ++d0) gc[d0] = dng[d0 * 32 + r32] * (1.0f - lam_init);
#pragma unroll
                    for (int r = 0; r < 16; ++r) { float ss = (o[0][r] * o[0][r] + o[1][r] * o[1][r]) + (o[2][r] * o[2][r] + o[3][r] * o[3][r]);
                        ss += bperm_f(ln3 ^ 1, ss); ss += bperm_f(ln3 ^ 2, ss); ss += bperm_f(ln3 ^ 4, ss); ss += bperm_f(ln3 ^ 8, ss); ss += bperm_f(ln3 ^ 16, ss);
                        const float rs = 1.0f / sqrtf(ss * (1.0f / 128.0f) + RMS_EPS);
#pragma unroll
                        for (int d0 = 0; d0 < 4; ++d0) o[d0][r] *= rs * gc[d0]; }
                    att::store_o_bf16(o, (rep ? (bf16*)(ws + WS_BH) : hb) + (size_t)(q0 + wv3 * 32) * DM + h * 128, DM, r32, hi);
                }
                if (!ATT_NO_MLA) for (;;) {
                    PTS_BEG(9); if (threadIdx.x == 0) MISC[0] = __hip_atomic_fetch_add(qctr + 64 * (2 * l + 1 + 4 * rep), 1u, __ATOMIC_RELAXED, __HIP_MEMORY_SCOPE_AGENT);
                    __syncthreads(); const unsigned u = MISC[0]; __syncthreads(); PTS_END(9);
                    if (u >= 336u) break;
                    const int qb = 63 - (int)((u + 48u) / 6u), h = (int)((u + 48u) % 6u), q0 = qb * 256;
                    att::f32x16 o[4];
                    ATT_CALL_M((LAS char*)ldsl, (const bf16*)(ws + WS_QM) + h * 96, NUQ, (const bf16*)(ws + WS_KM) + h * 96, NUQ, (const bf16*)(ws + WS_VC) + h * 128, 768, posf, q0, 0.f, 0.f, o, tacc);
                    const int ln3 = lane_id_v(), r32 = ln3 & 31, hi = ln3 >> 5, wv3 = __builtin_amdgcn_readfirstlane(threadIdx.x >> 6);
                    att::store_o_bf16(o, (rep ? (bf16*)(ws + WS_BH) : hb) + (size_t)(q0 + wv3 * 32) * DM + 1280 + h * 128, DM, r32, hi);
                }
            } else if (sub == 3 && EN(4)) {
                pg8::Gemm g{hb, (const bf16*)(ws + WS_WO), S, DM, DM}; pg8::StaticOrder so; so.init(S, DM, G, (int)blockIdx.x);
                pg8::EpiResid E{l == 0 ? ap->x : (const float*)hres, hres, (const float*)(ws + WS_RS), l == 0 ? ap->ln_in_g : ap->ln2_g + (size_t)(l - 1) * DM, l == 0 ? ap->ln_in_b : ap->ln2_b + (size_t)(l - 1) * DM};
                pg8::gemm_phase<pg8::EpiResid, pg8::StaticOrder, true, true>(ldsl, g, so, E);
            } else if ((sub == 4 || sub == 8) && EN(5)) {
                int tid_ = threadIdx.x; asm volatile("" : "+v"(tid_)); const int tid = tid_, lane = tid & 63, wave = __builtin_amdgcn_readfirstlane(tid >> 6), gw = blockIdx.x * NWAVES + wave, gt = blockIdx.x * (NWAVES * 64) + tid; (void)gt; (void)gw; (void)lane;
                int phl_ = ph; asm volatile("" : "+s"(phl_));
                const int l2 = (phl_ - 1) / 9, sub2 = (phl_ - 1) - 9 * l2;
                const float* g_ = (sub2 == 4 ? ap->ln1_g : ap->ln2_g) + (size_t)l2 * DM; const float* b_ = (sub2 == 4 ? ap->ln1_b : ap->ln2_b) + (size_t)l2 * DM;
                if (phl_ == 9 * NLAYER) { for (int m = gw; m < S; m += NGW) ln_row<true>(hres + (size_t)m * DM, hres + (size_t)m * DM, nullptr, nullptr, g_, b_, lane); }
                else { for (int m = gw; m < S; m += NGW) ln_row<false>(hres + (size_t)m * DM, nullptr, hb + (size_t)m * DM, (float*)(ws + WS_RS) + 2 * m, g_, b_, lane); }
                if (sub2 == 8 && l2 + 1 < NLAYER) convert_weights(ap, l2 + 1, ws, (LAS float*)(ldsl + wave * 16384), gw, NGW, lane);
            } else if (sub == 5 && EN(6)) {
                pg8::Gemm g{hb, (const bf16*)(ws + WS_WGU), S, 2 * DFF, DM}; pg8::StaticOrder so; so.init(S, 2 * DFF, G, (int)blockIdx.x);
                pg8::EpiGateUp E{(bf16*)(ws + WS_A), ap->ffn_conv_w + (size_t)l * 3 * DFF, (float*)(ws + WS_GS), (float*)(ws + WS_US)};
                pg8::gemm_phase<pg8::EpiGateUp, pg8::StaticOrder, true, true>(ldsl, g, so, E);
            } else if (sub == 6 && EN(7)) {
                int tid_ = threadIdx.x; asm volatile("" : "+v"(tid_)); const int tid = tid_, lane = tid & 63, wave = __builtin_amdgcn_readfirstlane(tid >> 6), gw = blockIdx.x * NWAVES + wave, gt = blockIdx.x * (NWAVES * 64) + tid; (void)gt; (void)gw; (void)lane;
                const float* cw = ap->ffn_conv_w + (size_t)l * 3 * DFF; const float* GS = (const float*)(ws + WS_GS); const float* US = (const float*)(ws + WS_US); bf16* A = (bf16*)(ws + WS_A);
                for (int i = gt; i < (S / 64) * DFF; i += NGT) { const int span = i / DFF, ch = i - span * DFF;
                    const float gm2 = span ? GS[((size_t)(span - 1) * 4 + 2) * DFF + ch] : 0.f, gm1 = span ? GS[((size_t)(span - 1) * 4 + 3) * DFF + ch] : 0.f;
                    const float g0 = GS[((size_t)span * 4 + 0) * DFF + ch], g1 = GS[((size_t)span * 4 + 1) * DFF + ch], u0 = US[((size_t)span * 2 + 0) * DFF + ch], u1 = US[((size_t)span * 2 + 1) * DFF + ch];
                    const float w0 = cw[ch], w1 = cw[DFF + ch], w2 = cw[2 * DFF + ch];
                    const float c0 = w0 * gm2 + w1 * gm1 + w2 * g0, c1 = w0 * gm1 + w1 * g0 + w2 * g1;
                    A[(size_t)(span * 64) * DFF + ch] = (bf16)f2bf(c0 * u0 / (1.0f + __expf(-c0)));
                    A[(size_t)(span * 64 + 1) * DFF + ch] = (bf16)f2bf(c1 * u1 / (1.0f + __expf(-c1))); }
            } else if (sub == 7 && EN(8)) {
                pg8::Gemm g{(const bf16*)(ws + WS_A), (const bf16*)(ws + WS_WDN), S, DM, DFF}; pg8::StaticOrder so; so.init(S, DM, G, (int)blockIdx.x);
                pg8::EpiResid E{hres, hres, (const float*)(ws + WS_RS), ap->ln1_g + (size_t)l * DM, ap->ln1_b + (size_t)l * DM};
                pg8::gemm_phase<pg8::EpiResid, pg8::StaticOrder, true, true>(ldsl, g, so, E);
            }
        }
        if (pi + 1 < NPROG) {
            if (pi == 0) { grid.sync(); (void)xcd_barrier_post(qctr + CW_BAR, MISC + 8); }
            else { XcdBarrier xb_; xb_.bar = qctr + CW_BAR; xb_.x = xb_xcc_id(); xb_.st = MISC + 8; xcd_barrier(xb_); }
        }
    }
    if (PROBE_TSEC != 0 && blockIdx.x == 0 && __builtin_amdgcn_readfirstlane(threadIdx.x >> 6) == PROBE_WAVE) {
        const unsigned long long t0 = __builtin_readcyclecounter(); while (__builtin_readcyclecounter() - t0 < tacc) __builtin_amdgcn_s_sleep(1); }
}

extern "C" void kernel_launch(void* const* d_in, const int* in_sizes, int n_in, void* d_out, int out_size, void* d_ws, size_t ws_size, hipStream_t stream) {
    static int grid = 0;
    if (grid == 0) {
        if (n_in != 21 || in_sizes[0] != S * DM || out_size != S * DM || ws_size < WS_END) { fprintf(stderr, "kernel_launch: unexpected shapes (n_in %d, in0 %d, out %d, ws %zu < %zu)\n", n_in, n_in > 0 ? in_sizes[0] : -1, out_size, ws_size, (size_t)WS_END); grid = -1; return; }
        int dev = 0, cus = 0, per_cu = 0;
        if (hipGetDevice(&dev) != hipSuccess || hipDeviceGetAttribute(&cus, hipDeviceAttributeMultiprocessorCount, dev) != hipSuccess) { grid = -1; return; }
        if (hipFuncSetAttribute((const void*)mk_fwd, hipFuncAttributeMaxDynamicSharedMemorySize, LDS_BYTES) != hipSuccess) { fprintf(stderr, "kernel_launch: hipFuncSetAttribute failed\n"); grid = -1; return; }
        if (hipOccupancyMaxActiveBlocksPerMultiprocessor(&per_cu, (const void*)mk_fwd, NWAVES * 64, LDS_BYTES) != hipSuccess || per_cu < 1) { fprintf(stderr, "kernel_launch: occupancy query says %d\n", per_cu); per_cu = 1; }
        (void)hipGetLastError();
        grid = cus * per_cu;
    }
    if (grid < 0) return;
    Args a{};
    a.x = (const float*)d_in[0]; a.pos = (const int*)d_in[1]; a.ln_in_g = (const float*)d_in[2]; a.ln_in_b = (const float*)d_in[3]; a.w_in = (const float*)d_in[4]; a.diff_lambda = (const float*)d_in[5];
    a.diff_norm_g = (const float*)d_in[6]; a.conv_w = (const float*)d_in[7]; a.mla_q_norm_g = (const float*)d_in[8]; a.mla_kv_norm_g = (const float*)d_in[9]; a.w_uq = (const float*)d_in[10]; a.w_ukv = (const float*)d_in[11];
    a.w_o = (const float*)d_in[12]; a.ln1_g = (const float*)d_in[13]; a.ln1_b = (const float*)d_in[14]; a.ffn_w_gate = (const float*)d_in[15]; a.ffn_w_up = (const float*)d_in[16]; a.ffn_conv_w = (const float*)d_in[17];
    a.ffn_w_down = (const float*)d_in[18]; a.ln2_g = (const float*)d_in[19]; a.ln2_b = (const float*)d_in[20];
    a.out = (float*)d_out; a.ws = (unsigned char*)d_ws; a.ph_lo = 0; a.ph_hi = 1 + 9 * NLAYER;
    void* args[] = {&a};
    const hipError_t e = hipLaunchCooperativeKernel((const void*)mk_fwd, dim3(grid), dim3(NWAVES * 64), args, LDS_BYTES, stream);
    if (e != hipSuccess) fprintf(stderr, "kernel_launch: cooperative launch failed: %s (grid %d)\n", hipGetErrorString(e), grid);
}
```
